# Optimizing an MI355X kernel written in HIP

```python
import math
import jax, jax.numpy as jnp
from jax import lax
import numpy as np

D_MODEL = 1024
BATCH = 4
SEQ = 8192
DEPTH = 1

CHUNK = 64
MEM_LEN = 256
W_A = D_MODEL
CONV_A = 3
W_B = D_MODEL
CONV_B = 31
W_X = D_MODEL
N_HEADS_X = 4
HEAD_DIM_X = W_X // N_HEADS_X
EPS = 1e-6

SPLIT_SIZES = (
    W_A, W_A, W_A, W_A,
    W_B, W_B, W_B,
    W_X, W_X,
    D_MODEL, D_MODEL, D_MODEL,
)
IN_COLS = sum(SPLIT_SIZES)
SPLIT_POINTS = tuple(int(v) for v in np.cumsum(SPLIT_SIZES)[:-1])

kernel_name = "hybrid_shortconv_conformer_memxattn_gated"


def rmsnorm(x, g):
    xf = x.astype(jnp.float32)
    y = xf * lax.rsqrt(jnp.mean(xf * xf, axis=-1, keepdims=True) + EPS)
    return (y * g.astype(jnp.float32)).astype(x.dtype)


def layernorm(x, g, b):
    xf = x.astype(jnp.float32)
    mu = jnp.mean(xf, axis=-1, keepdims=True)
    xc = xf - mu
    var = jnp.mean(xc * xc, axis=-1, keepdims=True)
    y = xc * lax.rsqrt(var + EPS) * g.astype(jnp.float32) + b.astype(jnp.float32)
    return y.astype(x.dtype)


def causal_dwconv(x, w):
    k = w.shape[0]
    return lax.conv_general_dilated(
        x, w.astype(x.dtype)[:, None, :],
        window_strides=(1,), padding=[(k - 1, 0)],
        dimension_numbers=("NWC", "WIO", "NWC"),
        feature_group_count=x.shape[-1])


def memory_cross_attention(q, mem_n, w_kv):
    b, s, _ = q.shape
    kv = jnp.einsum("bmd,de->bme", mem_n, w_kv)
    k, v = jnp.split(kv, 2, axis=-1)
    qh = q.reshape(b, s, N_HEADS_X, HEAD_DIM_X)
    kh = k.reshape(b, -1, N_HEADS_X, HEAD_DIM_X)
    vh = v.reshape(b, -1, N_HEADS_X, HEAD_DIM_X)
    scores = jnp.einsum("bshd,bmhd->bhsm", qh, kh).astype(jnp.float32) * (HEAD_DIM_X ** -0.5)
    probs = jax.nn.softmax(scores, axis=-1).astype(q.dtype)
    o = jnp.einsum("bhsm,bmhd->bshd", probs, vh)
    return o.reshape(b, s, W_X)


def setup_inputs(seed: int = 0) -> dict:
    key = jax.random.key(seed)
    ks = jax.random.split(key, 20)
    f32 = jnp.float32
    nrm = lambda k, shape: jax.random.normal(k, shape, f32)
    return {
        "x": nrm(ks[0], (BATCH, SEQ, D_MODEL)),
        "mem": nrm(ks[1], (BATCH, MEM_LEN, D_MODEL)),
        "norm_g": 1.0 + 0.02 * nrm(ks[2], (DEPTH, D_MODEL)),
        "w_in": nrm(ks[3], (DEPTH, D_MODEL, IN_COLS)) * D_MODEL ** -0.5,
        "conv_a_w": nrm(ks[4], (DEPTH, CONV_A, W_A)) * CONV_A ** -0.5,
        "w_out_a": nrm(ks[5], (DEPTH, W_A, D_MODEL)) * W_A ** -0.5,
        "conv_b_w": nrm(ks[6], (DEPTH, CONV_B, W_B)) * CONV_B ** -0.5,
        "conv_b_b": 0.02 * nrm(ks[7], (DEPTH, W_B)),
        "ln_b_g": 1.0 + 0.02 * nrm(ks[8], (DEPTH, W_B)),
        "ln_b_b": 0.02 * nrm(ks[9], (DEPTH, W_B)),
        "w_out_b": nrm(ks[10], (DEPTH, W_B, D_MODEL)) * W_B ** -0.5,
        "mem_norm_g": 1.0 + 0.02 * nrm(ks[11], (DEPTH, D_MODEL)),
        "w_kv": nrm(ks[12], (DEPTH, D_MODEL, 2 * W_X)) * D_MODEL ** -0.5,
        "w_out_x": nrm(ks[13], (DEPTH, W_X, D_MODEL)) * W_X ** -0.5,
        "w_o": nrm(ks[14], (DEPTH, D_MODEL, D_MODEL)) * D_MODEL ** -0.5,
        "final_g": 1.0 + 0.02 * nrm(ks[15], (D_MODEL,)),
    }


def reference(x, mem, norm_g, w_in, conv_a_w, w_out_a, conv_b_w, conv_b_b,
              ln_b_g, ln_b_b, w_out_b, mem_norm_g, w_kv, w_out_x, w_o, final_g):
    h = x
    for l in range(DEPTH):
        u = rmsnorm(h, norm_g[l])
        proj = jnp.einsum("bsd,de->bse", u, w_in[l])
        (b_a, c_a, xin_a, z_a,
         val_b, gate_b, z_b,
         q_x, z_x,
         g_a, g_b, g_x) = jnp.split(proj, SPLIT_POINTS, axis=-1)

        ya = b_a * causal_dwconv(c_a * xin_a, conv_a_w[l])
        ya = jnp.einsum("bsc,cd->bsd", jax.nn.silu(z_a) * ya, w_out_a[l])

        yb = val_b * jax.nn.sigmoid(gate_b)
        yb = causal_dwconv(yb, conv_b_w[l]) + conv_b_b[l].astype(yb.dtype)
        yb = jax.nn.silu(layernorm(yb, ln_b_g[l], ln_b_b[l]))
        yb = jnp.einsum("bsc,cd->bsd", jax.nn.silu(z_b) * yb, w_out_b[l])

        mem_n = rmsnorm(mem, mem_norm_g[l])
        yx = memory_cross_attention(q_x, mem_n, w_kv[l])
        yx = jnp.einsum("bsc,cd->bsd", jax.nn.silu(z_x) * yx, w_out_x[l])

        merged = jax.nn.sigmoid(g_a) * ya + jax.nn.sigmoid(g_b) * yb + jax.nn.sigmoid(g_x) * yx
        h = h + jnp.einsum("bsd,de->bse", merged, w_o[l])
    return rmsnorm(h, final_g)
```

```cpp
#include <hip/hip_runtime.h>
#include <cstdio>

#define LAS __attribute__((address_space(3)))
typedef unsigned short bf16_t;
typedef short bf16x8 __attribute__((ext_vector_type(8)));
typedef float f32x4 __attribute__((ext_vector_type(4)));
typedef float f32x2 __attribute__((ext_vector_type(2)));
typedef unsigned u32x4 __attribute__((ext_vector_type(4)));
typedef unsigned u32x2 __attribute__((ext_vector_type(2)));

constexpr int BM = 256, BK = 64, HALF = 128, HTB = HALF * BK * 2, STAGE_BYTES = 8 * HTB;
constexpr int LDS_BYTES = 147456;
constexpr int NTOK = 32768, DM = 1024, SEQ = 8192;
constexpr float EPS = 1e-6f;
constexpr size_t MiB = 1u << 20;
constexpr size_t TILE = (size_t)256 * 1024 * 2;
constexpr size_t WS_WIN = 0, WS_WOUT = 24 * MiB, WS_WO = 30 * MiB, WS_WKV = 32 * MiB, WS_MEMN = 36 * MiB, WS_KB = 38 * MiB, WS_VT = 40 * MiB;
constexpr size_t WS_ROWSS = 42 * MiB, WS_RSUM = 42 * MiB + 131072, WS_PAT = 43 * MiB, WS_GAH = 45 * MiB;
constexpr size_t WS_BAR = 47 * MiB;
constexpr size_t WS_HA = 48 * MiB, WS_SZB = 112 * MiB, WS_SZX = 176 * MiB, WS_GLU = 240 * MiB, WS_Q = 304 * MiB, WS_SGA = 368 * MiB, WS_SGB = 432 * MiB, WS_END = 496 * MiB;
constexpr size_t OUT_U = 0, OUT_SGX = 64 * MiB;

#define XB_TMO      128
#define XB_XCNT(j)  (256  + 64 * (j))
#define XB_XSUB(j)  (1280 + 64 * (j))
#define XB_XGEN(j)  (2304 + 64 * (j))
#define XB_TOP      3328
#define XB_TOPGEN   3392
#define XCD_BAR_WORDS 3456
#define XB_SPIN_CAP (1u << 18)

__device__ __forceinline__ unsigned xb_ld(unsigned* p)              { return __hip_atomic_load(p, __ATOMIC_RELAXED, __HIP_MEMORY_SCOPE_AGENT); }
__device__ __forceinline__ unsigned xb_add(unsigned* p, unsigned v) { return __hip_atomic_fetch_add(p, v, __ATOMIC_RELAXED, __HIP_MEMORY_SCOPE_AGENT); }
__device__ __forceinline__ unsigned xb_xcc_id() { return (unsigned)__builtin_amdgcn_s_getreg((3 << 11) | 20) & 0xFu; }
#define XB_SPIN(cond, bar) do { unsigned _sp = 0; while (cond) { __builtin_amdgcn_s_sleep(1); \
    if ((++_sp & 255u) == 0u) { if (xb_ld(&(bar)[XB_TMO])) break; if (_sp > XB_SPIN_CAP) { atomicAdd(&(bar)[XB_TMO], 1u); break; } } } } while (0)

struct XcdBarrier {
    unsigned* bar; unsigned x;
    volatile LAS unsigned* st;
};

__device__ __forceinline__ XcdBarrier xcd_barrier_post(unsigned* bar, volatile LAS unsigned* st) {
    XcdBarrier b; b.bar = bar; b.x = xb_xcc_id(); b.st = st;
    if (threadIdx.x == 0) (void)xb_add(&bar[XB_XCNT(b.x)], 1u);
    return b;
}
__device__ __forceinline__ void xcd_barrier_complete(unsigned* bar, unsigned x, unsigned& nloc, unsigned& nx) {
    const unsigned G = gridDim.x * gridDim.y * gridDim.z;
    unsigned sum, cnt, mine, sp = 0u;
    for (;;) {
        sum = 0u; cnt = 0u; mine = 0u;
#pragma unroll
        for (unsigned j = 0; j < 16; ++j) { const unsigned c = xb_ld(&bar[XB_XCNT(j)]); sum += c; cnt += (c > 0u) ? 1u : 0u; mine = (j == x) ? c : mine; }
        if (sum == G) break;
        __builtin_amdgcn_s_sleep(1);
        if ((++sp & 255u) == 0u) { if (xb_ld(&bar[XB_TMO])) break; if (sp > XB_SPIN_CAP) { atomicAdd(&bar[XB_TMO], 1u); break; } }
    }
    nloc = mine > 0u ? mine : 1u; nx = cnt > 0u ? cnt : 1u;
}

__device__ __forceinline__ void xcd_barrier(const XcdBarrier& b) {
    asm volatile("s_waitcnt vmcnt(0)" ::: "memory");
    __syncthreads();
    if (threadIdx.x == 0) {
        unsigned* bar = b.bar;
        __builtin_amdgcn_s_waitcnt(0);
        unsigned nloc = b.st[0], nx = b.st[1];
        if (nloc == 0u) { xcd_barrier_complete(bar, b.x, nloc, nx); b.st[0] = nloc; b.st[1] = nx; }
        const unsigned old = xb_add(&bar[XB_XSUB(b.x)], 1u);
        const unsigned gen = old / nloc;
        if (old + 1u == (gen + 1u) * nloc) {
            __builtin_amdgcn_fence(__ATOMIC_RELEASE, "agent");
            asm volatile("s_waitcnt vmcnt(0)" ::: "memory");
            const unsigned og = xb_add(&bar[XB_TOP], 1u);
            const unsigned tg = og / nx;
            if (og + 1u == (tg + 1u) * nx) xb_add(&bar[XB_TOPGEN], 1u);
            else XB_SPIN(xb_ld(&bar[XB_TOPGEN]) == tg, bar);
            __builtin_amdgcn_fence(__ATOMIC_ACQUIRE, "agent");
            xb_add(&bar[XB_XGEN(b.x)], 1u);
            asm volatile("s_waitcnt vmcnt(0)" ::: "memory");
        } else {
            XB_SPIN(xb_ld(&bar[XB_XGEN(b.x)]) == gen, bar);
            __builtin_amdgcn_fence(__ATOMIC_ACQUIRE, "agent");
            asm volatile("s_waitcnt vmcnt(0)" ::: "memory");
        }
    }
    __syncthreads();
}

#define GRID_SYNC() xcd_barrier(xb)

struct Params { const float* in[16]; float* out; unsigned char* ws; };

typedef __bf16 bf16x2_t __attribute__((ext_vector_type(2)));
__device__ __forceinline__ unsigned pk_bf16(float lo, float hi) { const f32x2 v = {lo, hi}; return __builtin_bit_cast(unsigned, __builtin_convertvector(v, bf16x2_t)); }
__device__ __forceinline__ float bf_lo(unsigned u) { return __uint_as_float(u << 16); }
__device__ __forceinline__ float bf_hi(unsigned u) { return __uint_as_float(u & 0xffff0000u); }
__device__ __forceinline__ float sigmoidf_(float x) { return __builtin_amdgcn_rcpf(1.0f + __builtin_amdgcn_exp2f(-1.44269504089f * x)); }
__device__ __forceinline__ float siluf_(float x) { return x * sigmoidf_(x); }
__device__ __forceinline__ u32x2 pk4(f32x4 v) { u32x2 r; r.x = pk_bf16(v[0], v[1]); r.y = pk_bf16(v[2], v[3]); return r; }
__device__ __forceinline__ f32x4 unpk4(u32x2 v) { return (f32x4){bf_lo(v.x), bf_hi(v.x), bf_lo(v.y), bf_hi(v.y)}; }
template <int CTRL> __device__ __forceinline__ float dppf(float old, float v) { return __int_as_float(__builtin_amdgcn_update_dpp(__float_as_int(old), __float_as_int(v), CTRL, 0xf, 0xf, false)); }
__device__ __forceinline__ float wave_sum(float v) {
#pragma unroll
    for (int o = 1; o < 64; o <<= 1) v += __shfl_xor(v, o);
    return v;
}

__device__ __forceinline__ int lds_byte(int r, int c) { const int st = (r >> 4) * 2 + (c >> 5), rr = r & 15, cc = c & 31, ob = rr * 64 + cc * 2; return st * 1024 + (ob ^ (((ob >> 9) & 1) << 5)); }
__device__ __forceinline__ void stage_rc(int b, int& R, int& C) { const int st = b / 1024, sb = b % 1024, swz = sb ^ (((sb >> 9) & 1) << 5); R = (st >> 1) * 16 + swz / 64; C = (st & 1) * 32 + (swz % 64) / 2; }

struct Unit { const char* A; const char* B; int pm, pn, kind; };
__device__ __forceinline__ size_t native_slot(int pm, int pn4, int w4, int ai, int m, int bj, int n, int lane) {
    return ((((size_t)(pm * 4 + pn4) * 8 + w4) * 32 + (((ai * 4 + m) * 2 + bj) * 2 + n)) * 64 + lane);
}

template <int WG = 8> __device__ __forceinline__ void remap_tile(int L, int nM, int nN, int& pm, int& pn) {
    const int nwg = nM * nN; int wgid = L;
    { const int q = nwg / 8, r = nwg % 8, xcd = wgid % 8, off = wgid / 8; wgid = (xcd < r ? xcd * (q + 1) : r * (q + 1) + (xcd - r) * q) + off; }
    const int nig = WG * nN, gid = wgid / nig, fm = gid * WG, gsz = (nM - fm) < WG ? (nM - fm) : WG;
    pm = fm + ((wgid % nig) % gsz); pn = (wgid % nig) / gsz;
}

template <class Epi, class Sched>
__device__ __forceinline__ void gemm_phase(LAS unsigned char* lds, const int lda, const int ldb, const int K, const Sched& S, const Epi& E) {
    int tid_ = threadIdx.x; asm volatile("" : "+v"(tid_));
    const int tid = tid_, wid = __builtin_amdgcn_readfirstlane(tid >> 6), lane = tid & 63, wr = wid >> 2, wc = wid & 3, fr = lane & 15, fq = lane >> 4;
    const int nt = K / BK;
    unsigned voffA[2], voffB[2];
#pragma unroll
    for (int i = 0; i < 2; ++i) { int R, C; stage_rc(tid * 16 + i * 8192, R, C); voffA[i] = (unsigned)(R * lda + C) * 2u; voffB[i] = (unsigned)(R * ldb + C) * 2u; }
    const size_t kstep = (size_t)(BK * 2);
    const size_t hstepA = (size_t)HALF * lda * 2, hstepB = (size_t)HALF * ldb * 2;
    const unsigned ldsw = (unsigned)wid * 1024u;
    const int aoff = lds_byte(wr * 64 + fr, fq * 8), boff = lds_byte(wc * 32 + fr, fq * 8);
#define GP_SA(b, h) (((b) * 2 + (h)) * HTB)
#define GP_SB(b, h) ((4 + (b) * 2 + (h)) * HTB)
#define GP_STAGE(bufoff, gbase, voff) do { _Pragma("unroll") for (int _i = 0; _i < 2; ++_i) \
        __builtin_amdgcn_global_load_lds((const unsigned*)((const char*)(gbase) + (voff)[_i]), (LAS unsigned*)(lds + (bufoff) + ldsw + _i * 8192), 16, 0, 0); } while (0)
#define GP_LDA(dst, b, h) do { _Pragma("unroll") for (int m = 0; m < 4; ++m) _Pragma("unroll") for (int k = 0; k < 2; ++k) dst[m][k] = *(const LAS bf16x8*)(lds + GP_SA(b, h) + aoff + m * 2048 + k * 1024); } while (0)
#define GP_LDB(dst, b, h) do { _Pragma("unroll") for (int n = 0; n < 2; ++n) _Pragma("unroll") for (int k = 0; k < 2; ++k) dst[n][k] = *(const LAS bf16x8*)(lds + GP_SB(b, h) + boff + n * 2048 + k * 1024); } while (0)
#define GP_MMA(ai, bj, At, Bt) do { __builtin_amdgcn_s_setprio(1); _Pragma("unroll") for (int m = 0; m < 4; ++m) _Pragma("unroll") for (int n = 0; n < 2; ++n) _Pragma("unroll") for (int k = 0; k < 2; ++k) \
        acc[ai][bj][m][n] = __builtin_amdgcn_mfma_f32_16x16x32_bf16(Bt[n][k], At[m][k], acc[ai][bj][m][n], 0, 0, 0); __builtin_amdgcn_s_setprio(0); } while (0)
#define GP_WAIT_V(n) asm volatile("s_waitcnt vmcnt(" #n ")" ::: "memory")
#define GP_WAIT_L(n) asm volatile("s_waitcnt lgkmcnt(" #n ")" ::: "memory")
#define GP_BAR __builtin_amdgcn_s_barrier()
#define GP_SCHED __builtin_amdgcn_sched_barrier(0)
    Unit cur, nxt; int ui = 0;
    if (!S.next(0, cur)) return;
    f32x4 acc[2][2][4][2];
#pragma unroll
    for (int a = 0; a < 2; ++a)
#pragma unroll
        for (int b = 0; b < 2; ++b)
#pragma unroll
            for (int m = 0; m < 4; ++m)
#pragma unroll
                for (int n = 0; n < 2; ++n) acc[a][b][m][n] = (f32x4){0.f, 0.f, 0.f, 0.f};
    bf16x8 At[4][2], B0[2][2], B1[2][2];
    const char* cA = cur.A; const char* cB = cur.B;
    GP_STAGE(GP_SB(0, 0), cB, voffB); GP_STAGE(GP_SB(0, 1), cB + hstepB, voffB); GP_STAGE(GP_SA(0, 0), cA, voffA); GP_STAGE(GP_SA(0, 1), cA + hstepA, voffA);
    if (wr == 1) GP_BAR;
    GP_WAIT_V(2); GP_BAR;
    GP_STAGE(GP_SB(1, 0), cB + kstep, voffB); GP_STAGE(GP_SA(1, 0), cA + kstep, voffA); GP_STAGE(GP_SB(1, 1), cB + hstepB + kstep, voffB);
    GP_WAIT_V(6); GP_BAR;
    for (;;) {
        const bool has_next = S.next(ui + 1, nxt);
        const char* nA = has_next ? nxt.A : cA; const char* nB = has_next ? nxt.B : cB;
        for (int t = 0; t < nt; t += 2) {
            const bool last = (t == nt - 2);
            const char* a1 = cA + (size_t)(t + 1) * kstep;
            const char* a2 = last ? nA : cA + (size_t)(t + 2) * kstep; const char* b2 = last ? nB : cB + (size_t)(t + 2) * kstep;
            const char* a3 = a2 + kstep; const char* b3 = b2 + kstep;
            GP_LDB(B0, 0, 0); GP_LDB(B1, 0, 1); GP_SCHED; GP_LDA(At, 0, 0); GP_STAGE(GP_SA(1, 1), a1 + hstepA, voffA);
            GP_WAIT_V(8); GP_WAIT_L(0); GP_BAR; GP_MMA(0, 0, At, B0); GP_MMA(0, 1, At, B1); GP_BAR; GP_SCHED;
            GP_LDA(At, 0, 1); GP_STAGE(GP_SB(0, 0), b2, voffB); GP_STAGE(GP_SB(0, 1), b2 + hstepB, voffB); GP_STAGE(GP_SA(0, 0), a2, voffA);
            GP_WAIT_V(8); GP_WAIT_L(0); GP_BAR; GP_MMA(1, 0, At, B0); GP_MMA(1, 1, At, B1); GP_BAR; GP_SCHED;
            GP_LDB(B0, 1, 0); GP_LDB(B1, 1, 1); GP_SCHED; GP_LDA(At, 1, 0); GP_STAGE(GP_SA(0, 1), a2 + hstepA, voffA);
            GP_WAIT_V(8); GP_WAIT_L(0); GP_BAR; GP_MMA(0, 0, At, B0); GP_MMA(0, 1, At, B1); GP_BAR; GP_SCHED;
            GP_LDA(At, 1, 1); GP_STAGE(GP_SB(1, 0), b3, voffB); GP_STAGE(GP_SB(1, 1), b3 + hstepB, voffB); GP_STAGE(GP_SA(1, 0), a3, voffA);
            GP_WAIT_V(8); GP_WAIT_L(0); GP_BAR; GP_MMA(1, 0, At, B0); GP_MMA(1, 1, At, B1); GP_BAR; GP_SCHED;
        }
        if (wr == 0) GP_BAR;
        E(acc, cur, wr, wc, fr, fq);
        if (!has_next) break;
#pragma unroll
        for (int a = 0; a < 2; ++a)
#pragma unroll
            for (int b = 0; b < 2; ++b)
#pragma unroll
                for (int m = 0; m < 4; ++m)
#pragma unroll
                    for (int n = 0; n < 2; ++n) acc[a][b][m][n] = (f32x4){0.f, 0.f, 0.f, 0.f};
        cur = nxt; cA = nA; cB = nB; ++ui;
        if (wr == 1) GP_BAR;
    }
    GP_WAIT_V(0);
    GP_BAR;
#undef GP_SA
#undef GP_SB
#undef GP_STAGE
#undef GP_LDA
#undef GP_LDB
#undef GP_MMA
#undef GP_WAIT_V
#undef GP_WAIT_L
#undef GP_BAR
#undef GP_SCHED
}

struct SchedP1 {
    const char *U, *Win, *Memn, *Wkv; int G, c;
    __device__ __forceinline__ bool next(int i, Unit& u) const {
        int L = i * G + c;
        if (L < 6144) { int pm, pn; remap_tile<4>(L, 128, 48, pm, pn); pn = (pn % 3) * 16 + pn / 3;     u.pm = pm; u.pn = pn; u.kind = pn >> 4; u.A = U + (size_t)pm * TILE; u.B = Win + (size_t)pn * TILE; return true; }
        L -= 6144; if (L >= 32) return false;
        if (L < 16) { u.pm = L >> 2; u.pn = L & 3; u.kind = 3; u.A = Memn + (size_t)u.pm * TILE; u.B = Wkv + (size_t)u.pn * TILE; }
        else { L -= 16; u.pm = L >> 2; u.pn = L & 3; u.kind = 4; u.A = Wkv + (size_t)(4 + u.pm) * TILE; u.B = Memn + (size_t)u.pn * TILE; }
        return true;
    }
};
struct SchedAttn {
    const char *Aq, *Bm; size_t bstride_b, bstride_h; int G, c;
    __device__ __forceinline__ bool next(int i, Unit& u) const {
        const int L = i * G + c; if (L >= 512) return false;
        u.pm = L >> 2; u.pn = L & 3; u.kind = 0;
        u.A = Aq + (size_t)u.pm * TILE + (size_t)u.pn * 512; u.B = Bm + (size_t)(u.pm >> 5) * bstride_b + (size_t)u.pn * bstride_h; return true;
    }
};
struct SchedOut {
    const char *H, *HXp, *W; int G, c;
    __device__ __forceinline__ bool next(int i, Unit& u) const {
        const int ti = i / 3, g = i - 3 * ti; const int L = ti * G + c; if (L >= 512) return false;
        int pm, pn; remap_tile(L, 128, 4, pm, pn); u.pm = pm; u.pn = pn; u.kind = g;
        if (g == 2) u.A = HXp + (size_t)pm * TILE; else u.A = H + ((size_t)g * 128 + pm) * TILE;
        u.B = W + ((size_t)g * 4 + pn) * TILE; return true;
    }
};
struct SchedWo {
    const char *A, *W; int G, c;
    __device__ __forceinline__ bool next(int i, Unit& u) const {
        const int L = i * G + c; if (L >= 512) return false;
        int pm, pn; remap_tile(L, 128, 4, pm, pn); u.pm = pm; u.pn = pn; u.kind = 0; u.A = A + (size_t)pm * TILE; u.B = W + (size_t)pn * TILE; return true;
    }
};

__device__ __forceinline__ int pf(int fq) { return (fq >> 1) | ((fq & 1) << 1); }
__device__ __forceinline__ void store_pair16(bf16_t* rowbase  , u32x2 a  , u32x2 b  , int fq) {
    const auto rx = __builtin_amdgcn_permlane32_swap(a.x, b.x, false, false), ry = __builtin_amdgcn_permlane32_swap(a.y, b.y, false, false);
    *(u32x4*)(rowbase + (size_t)((fq >> 1) * 16) * 1024 + (fq & 1) * 8) = (u32x4){rx[0], ry[0], rx[1], ry[1]};
}
struct EpiP1 {
    bf16_t *HA, *GLU, *SZB, *SZX, *Q, *SGA, *SGB, *SGX, *KB, *VT, *PAT, *GAH; const float* convw;
    __device__ __forceinline__ void operator()(const f32x4 (&acc)[2][2][4][2], const Unit& u, int wr, int wc, int fr, int fq) const {
        if (u.kind <= 2) {
            const int chw = (u.pn & 15) * 64 + wc * 16, ch = chw + pf(fq) * 4;
            const int rowb = u.pm * 256 + wr * 64 + fr;
            if (u.kind == 0) {
                const f32x4 w0 = *(const f32x4*)(convw + ch), w1 = *(const f32x4*)(convw + 1024 + ch), w2 = *(const f32x4*)(convw + 2048 + ch);
#pragma unroll
                for (int ai = 0; ai < 2; ++ai) {
                    const int blk = u.pm * 4 + ai * 2 + wr;
                    f32x4 pprev = (f32x4){0.f, 0.f, 0.f, 0.f}; u32x2 hv[4];
#pragma unroll
                    for (int m = 0; m < 4; ++m) {
                        const f32x4 Bv = acc[ai][0][m][0], Cv = acc[ai][0][m][1], Xv = acc[ai][1][m][0], Zv = acc[ai][1][m][1];
                        const f32x4 p = Cv * Xv; f32x4 ga, p1, p2;
#pragma unroll
                        for (int j = 0; j < 4; ++j) {
                            ga[j] = siluf_(Zv[j]) * Bv[j];
                            const float r1 = (m > 0) ? dppf<0x121>(0.f, pprev[j]) : 0.f, r2 = (m > 0) ? dppf<0x122>(0.f, pprev[j]) : 0.f;
                            p1[j] = dppf<0x111>(r1, p[j]); p2[j] = dppf<0x112>(r2, p[j]);
                        }
                        const f32x4 cv = w2 * p + w1 * p1 + w0 * p2;
                        hv[m] = pk4(ga * cv);
                        if (m == 3 && fr >= 14) *(u32x2*)(PAT + (size_t)(blk * 2 + (fr - 14)) * 1024 + ch) = pk4(p);
                        if (m == 0 && fr < 2) *(u32x2*)(GAH + (size_t)(blk * 2 + fr) * 1024 + ch) = pk4(ga);
                        pprev = p;
                    }
#pragma unroll
                    for (int pr = 0; pr < 2; ++pr) store_pair16(HA + (size_t)(rowb + ai * 128 + pr * 32) * 1024 + chw, hv[2 * pr], hv[2 * pr + 1], fq);
                }
            } else if (u.kind == 1) {
#pragma unroll
                for (int ai = 0; ai < 2; ++ai) {
                    u32x2 gv[4], zv[4];
#pragma unroll
                    for (int m = 0; m < 4; ++m) {
                        const f32x4 Vv = acc[ai][0][m][0], Gv = acc[ai][0][m][1], Zb = acc[ai][1][m][0], Zx = acc[ai][1][m][1]; f32x4 o0, o1, o2;
#pragma unroll
                        for (int j = 0; j < 4; ++j) { o0[j] = Vv[j] * sigmoidf_(Gv[j]); o1[j] = siluf_(Zb[j]); o2[j] = siluf_(Zx[j]); }
                        gv[m] = pk4(o0); zv[m] = pk4(o1);
                        { const int c = (u.pn & 3) * 64 + wc * 16;
                          ((u32x2*)SZX)[native_slot(u.pm, (u.pn & 15) >> 2, wr * 4 + ((c >> 5) & 3), ai, m, c >> 7, (c >> 4) & 1, pf(fq) * 16 + fr)] = pk4(o2); }
                    }
#pragma unroll
                    for (int pr = 0; pr < 2; ++pr) {
                        store_pair16(GLU + (size_t)(rowb + ai * 128 + pr * 32) * 1024 + chw, gv[2 * pr], gv[2 * pr + 1], fq);
                        store_pair16(SZB + (size_t)(rowb + ai * 128 + pr * 32) * 1024 + chw, zv[2 * pr], zv[2 * pr + 1], fq);
                    }
                }
            } else {
#pragma unroll
                for (int ai = 0; ai < 2; ++ai) {
                    u32x2 qv[4];
#pragma unroll
                    for (int m = 0; m < 4; ++m) {
                        const f32x4 Qv = acc[ai][0][m][0], Ga = acc[ai][0][m][1], Gb = acc[ai][1][m][0], Gx = acc[ai][1][m][1]; f32x4 o1, o2, o3;
#pragma unroll
                        for (int j = 0; j < 4; ++j) { o1[j] = sigmoidf_(Ga[j]); o2[j] = sigmoidf_(Gb[j]); o3[j] = sigmoidf_(Gx[j]); }
                        qv[m] = pk4(Qv * 0.0625f);
                        const int c = (u.pn & 3) * 64 + wc * 16;
                        const size_t ns = native_slot(u.pm, (u.pn & 15) >> 2, wr * 4 + ((c >> 5) & 3), ai, m, c >> 7, (c >> 4) & 1, pf(fq) * 16 + fr);
                        ((u32x2*)SGA)[ns] = pk4(o1); ((u32x2*)SGB)[ns] = pk4(o2); ((u32x2*)SGX)[ns] = pk4(o3);
                    }
#pragma unroll
                    for (int pr = 0; pr < 2; ++pr) store_pair16(Q + (size_t)(rowb + ai * 128 + pr * 32) * 1024 + chw, qv[2 * pr], qv[2 * pr + 1], fq);
                }
            }
        } else {
            const int r0 = wr * 64 + fr, c0 = wc * 32 + fq * 4;
#pragma unroll
            for (int ai = 0; ai < 2; ++ai)
#pragma unroll
                for (int m = 0; m < 4; ++m)
#pragma unroll
                    for (int bj = 0; bj < 2; ++bj)
#pragma unroll
                        for (int n = 0; n < 2; ++n) {
                            const int r = r0 + ai * 128 + m * 16, c = c0 + bj * 128 + n * 16;
                            if (u.kind == 3) *(u32x2*)(KB + (size_t)(u.pm * 256 + r) * 1024 + u.pn * 256 + c) = pk4(acc[ai][bj][m][n]);
                            else             *(u32x2*)(VT + ((size_t)u.pn * 1024 + u.pm * 256 + r) * 256 + c) = pk4(acc[ai][bj][m][n]);
                        }
        }
    }
};
struct EpiS {
    bf16_t* Q; float* RSUM;
    __device__ __forceinline__ void operator()(const f32x4 (&acc)[2][2][4][2], const Unit& u, int wr, int wc, int fr, int fq) const {
#pragma unroll
        for (int ai = 0; ai < 2; ++ai)
#pragma unroll
            for (int m = 0; m < 4; ++m) {
                const int row = u.pm * 256 + ai * 128 + wr * 64 + m * 16 + fr; float rs = 0.f;
#pragma unroll
                for (int bj = 0; bj < 2; ++bj)
#pragma unroll
                    for (int n = 0; n < 2; ++n) {
                        const f32x4 s = acc[ai][bj][m][n]; f32x4 e;
#pragma unroll
                        for (int j = 0; j < 4; ++j) e[j] = __builtin_amdgcn_exp2f(1.44269504089f * s[j]);
                        const u32x2 w = pk4(e); const f32x4 er = unpk4(w); rs += (er[0] + er[1]) + (er[2] + er[3]);
                        *(u32x2*)(Q + (size_t)row * 1024 + u.pn * 256 + bj * 128 + wc * 32 + n * 16 + fq * 4) = w;
                    }
                rs += __shfl_xor(rs, 16); rs += __shfl_xor(rs, 32);
                if (fq == 0) unsafeAtomicAdd(RSUM + row * 4 + u.pn, rs);
            }
    }
};
struct EpiPV {
    const bf16_t* SZXN; bf16_t* HX; const float* RSUM;
    __device__ __forceinline__ void operator()(const f32x4 (&acc)[2][2][4][2], const Unit& u, int wr, int wc, int fr, int fq) const {
        const int w4 = wr * 4 + wc, lane = fq * 16 + fr;
#pragma unroll
        for (int ai = 0; ai < 2; ++ai) {
            u32x2 z[4][2][2]; float rs[4];
#pragma unroll
            for (int m = 0; m < 4; ++m) {
                rs[m] = RSUM[(u.pm * 256 + ai * 128 + wr * 64 + m * 16 + fr) * 4 + u.pn];
#pragma unroll
                for (int bj = 0; bj < 2; ++bj)
#pragma unroll
                    for (int n = 0; n < 2; ++n) z[m][bj][n] = ((const u32x2*)SZXN)[native_slot(u.pm, u.pn, w4, ai, m, bj, n, lane)];
            }
#pragma unroll
            for (int m = 0; m < 4; ++m) {
                const int row = u.pm * 256 + ai * 128 + wr * 64 + m * 16 + fr; const float inv = __builtin_amdgcn_rcpf(rs[m]);
#pragma unroll
                for (int bj = 0; bj < 2; ++bj)
#pragma unroll
                    for (int n = 0; n < 2; ++n)
                        *(u32x2*)(HX + (size_t)row * 1024 + u.pn * 256 + bj * 128 + wc * 32 + n * 16 + fq * 4) = pk4(unpk4(z[m][bj][n]) * (acc[ai][bj][m][n] * inv));
            }
        }
    }
};
__device__ __forceinline__ void ld8(u32x2 (&d)[8], const u32x2* p) {
    asm volatile("global_load_dwordx2 %0, %1, off"             : "=v"(d[0]) : "v"(p) : "memory");
    asm volatile("global_load_dwordx2 %0, %1, off offset:512"  : "=v"(d[1]) : "v"(p) : "memory");
    asm volatile("global_load_dwordx2 %0, %1, off offset:1024" : "=v"(d[2]) : "v"(p) : "memory");
    asm volatile("global_load_dwordx2 %0, %1, off offset:1536" : "=v"(d[3]) : "v"(p) : "memory");
    asm volatile("global_load_dwordx2 %0, %1, off offset:2048" : "=v"(d[4]) : "v"(p) : "memory");
    asm volatile("global_load_dwordx2 %0, %1, off offset:2560" : "=v"(d[5]) : "v"(p) : "memory");
    asm volatile("global_load_dwordx2 %0, %1, off offset:3072" : "=v"(d[6]) : "v"(p) : "memory");
    asm volatile("global_load_dwordx2 %0, %1, off offset:3584" : "=v"(d[7]) : "v"(p) : "memory");
}
__device__ __forceinline__ void tie8(u32x2 (&d)[8]) { asm volatile("" : "+v"(d[0]), "+v"(d[1]), "+v"(d[2]), "+v"(d[3]), "+v"(d[4]), "+v"(d[5]), "+v"(d[6]), "+v"(d[7])); }

struct EpiOut {
    const bf16_t *SGA, *SGB, *SGX; bf16_t* PART; bf16_t* MERGED;
    template <int G> __device__ __forceinline__ void run(const f32x4 (&acc)[2][2][4][2], const Unit& u, const bf16_t* SG, int wr, int wc, int fr, int fq) const {
        const int w4 = wr * 4 + wc, lane = fq * 16 + fr;
        const size_t base0 = native_slot(u.pm, u.pn, w4, 0, 0, 0, 0, lane);
        const u32x2* sg = (const u32x2*)SG + base0; u32x2* part = (u32x2*)PART + base0;
        u32x2 gA[2][8], pA[2][8], gB[2][8], pB[2][8], rs[16];
        ld8(gA[0], sg); ld8(gA[1], sg + 512); if (G > 0) { ld8(pA[0], part); ld8(pA[1], part + 512); }
        asm volatile("s_waitcnt vmcnt(0)" ::: "memory");
        tie8(gA[0]); tie8(gA[1]); if (G > 0) { tie8(pA[0]); tie8(pA[1]); }
#pragma unroll
        for (int k = 0; k < 16; ++k) { const int m = k >> 2, bj = (k >> 1) & 1, n = k & 1;
            f32x4 t = unpk4(gA[k >> 3][k & 7]) * acc[0][bj][m][n]; if (G > 0) t += unpk4(pA[k >> 3][k & 7]); rs[k] = pk4(t); }
        ld8(gB[0], sg + 1024); ld8(gB[1], sg + 1536); if (G > 0) { ld8(pB[0], part + 1024); ld8(pB[1], part + 1536); }
#pragma unroll
        for (int k = 0; k < 16; ++k) { const int m = k >> 2, bj = (k >> 1) & 1, n = k & 1;
            if (G < 2) part[k * 64] = rs[k];
            else *(u32x2*)(MERGED + (size_t)(u.pm * 256 + wr * 64 + m * 16 + fr) * 1024 + u.pn * 256 + bj * 128 + wc * 32 + n * 16 + fq * 4) = rs[k]; }
        asm volatile("s_waitcnt vmcnt(8)" ::: "memory");
        tie8(gB[0]); tie8(gB[1]); if (G > 0) { tie8(pB[0]); tie8(pB[1]); }
#pragma unroll
        for (int k = 0; k < 16; ++k) { const int m = k >> 2, bj = (k >> 1) & 1, n = k & 1;
            f32x4 t = unpk4(gB[k >> 3][k & 7]) * acc[1][bj][m][n]; if (G > 0) t += unpk4(pB[k >> 3][k & 7]);
            if (G < 2) part[(16 + k) * 64] = pk4(t);
            else *(u32x2*)(MERGED + (size_t)(u.pm * 256 + 128 + wr * 64 + m * 16 + fr) * 1024 + u.pn * 256 + bj * 128 + wc * 32 + n * 16 + fq * 4) = pk4(t); }
    }
    __device__ __forceinline__ void operator()(const f32x4 (&acc)[2][2][4][2], const Unit& u, int wr, int wc, int fr, int fq) const {
        if (u.kind == 0) run<0>(acc, u, SGA, wr, wc, fr, fq);
        else if (u.kind == 1) run<1>(acc, u, SGB, wr, wc, fr, fq);
        else run<2>(acc, u, SGX, wr, wc, fr, fq);
    }
};
struct EpiWo {
    const float* X; bf16_t* HN; float* ROWSS;
    __device__ __forceinline__ void operator()(const f32x4 (&acc)[2][2][4][2], const Unit& u, int wr, int wc, int fr, int fq) const {
        const int w4 = wr * 4 + wc, lane = fq * 16 + fr;
#pragma unroll
        for (int ai = 0; ai < 2; ++ai) {
            f32x4 xv[4][2][2];
#pragma unroll
            for (int m = 0; m < 4; ++m)
#pragma unroll
                for (int bj = 0; bj < 2; ++bj)
#pragma unroll
                    for (int n = 0; n < 2; ++n)
                        xv[m][bj][n] = *(const f32x4*)(X + (size_t)(u.pm * 256 + ai * 128 + wr * 64 + m * 16 + fr) * 1024 + u.pn * 256 + bj * 128 + wc * 32 + n * 16 + fq * 4);
#pragma unroll
            for (int m = 0; m < 4; ++m) {
                const int row = u.pm * 256 + ai * 128 + wr * 64 + m * 16 + fr; float ss = 0.f;
#pragma unroll
                for (int bj = 0; bj < 2; ++bj)
#pragma unroll
                    for (int n = 0; n < 2; ++n) {
                        const u32x2 hw = pk4(xv[m][bj][n] + acc[ai][bj][m][n]); const f32x4 h = unpk4(hw);
                        ((u32x2*)HN)[native_slot(u.pm, u.pn, w4, ai, m, bj, n, lane)] = hw; ss += (h[0] * h[0] + h[1] * h[1]) + (h[2] * h[2] + h[3] * h[3]);
                    }
                ss += __shfl_xor(ss, 16); ss += __shfl_xor(ss, 32);
                if (fq == 0) unsafeAtomicAdd(ROWSS + row, ss);
            }
        }
    }
};

__device__ __forceinline__ int win_src_col(int R) {
    const int unit = R >> 8, rho = R & 255, kind = unit >> 4, cu = unit & 15;
    const int fqb = (rho >> 2) & 3;
    const int gi = ((rho >> 7) & 1) * 2 + ((rho >> 4) & 1), chl = ((rho >> 5) & 3) * 16 + (((fqb >> 1) | ((fqb & 1) << 1)) << 2) + (rho & 3);
    int base;
    if (kind == 0) base = gi * 1024;
    else if (kind == 1) base = (gi < 3) ? 4096 + gi * 1024 : 8192;
    else base = (gi == 0) ? 7168 : 9216 + (gi - 1) * 1024;
    return base + cu * 64 + chl;
}
__device__ __forceinline__ void p0_transpose_item(const float* W, int ldw, bf16_t* WT, int dst_row0, int k0, bool perm, LAS float* scr, int lane) {
    const int li = lane & 31; const int drow = dst_row0 + (perm ? ((li & 15) + ((li >> 4) << 5)) : li); const int scol = perm ? win_src_col(drow) : drow;
#pragma unroll
    for (int i = 0; i < 32; ++i) { const int kk = 2 * i + (lane >> 5); scr[kk * 33 + (lane & 31)] = W[(size_t)(k0 + kk) * ldw + scol]; }
    asm volatile("s_waitcnt lgkmcnt(0)" ::: "memory");
    const int c = lane & 7;
#pragma unroll
    for (int j = 0; j < 4; ++j) { const int n = (lane >> 3) + 8 * j; const LAS float* s = scr + (8 * c) * 33 + n;
        u32x4 o; o.x = pk_bf16(s[0 * 33], s[1 * 33]); o.y = pk_bf16(s[2 * 33], s[3 * 33]); o.z = pk_bf16(s[4 * 33], s[5 * 33]); o.w = pk_bf16(s[6 * 33], s[7 * 33]);
        const int orow = dst_row0 + (perm ? ((n & 15) + ((n >> 4) << 5)) : n);
        *(u32x4*)(WT + (size_t)orow * 1024 + k0 + 8 * c) = o; }
    asm volatile("s_waitcnt lgkmcnt(0)" ::: "memory");
}
__device__ __forceinline__ void rms_row_to_bf16(const float* xrow, const float* g, bf16_t* orow, int lane) {
    const f32x4* xr = (const f32x4*)xrow + lane; const f32x4* gr = (const f32x4*)g + lane;
    f32x4 v[4]; float s = 0.f;
#pragma unroll
    for (int j = 0; j < 4; ++j) { v[j] = xr[64 * j]; s += (v[j][0] * v[j][0] + v[j][1] * v[j][1]) + (v[j][2] * v[j][2] + v[j][3] * v[j][3]); }
    const float rstd = 1.0f / sqrtf(wave_sum(s) * (1.f / 1024.f) + EPS);
    u32x2* o8 = (u32x2*)orow + lane;
#pragma unroll
    for (int j = 0; j < 4; ++j) { const f32x4 gg = gr[64 * j]; o8[64 * j] = pk4(v[j] * rstd * gg); }
}

template <int PH>
__device__ __forceinline__ void conv31_chunk(LAS unsigned char* lds, LAS float* red, LAS float* stats, const bf16_t* GLU, bf16_t* SZB, const float* cw, const float* cb, const float* lng, const float* lnb,
                                            const int t0, const bool has_next, const int tid_in) {
    int tid_o = tid_in; asm volatile("" : "+v"(tid_o));
    const int tid = tid_o, lane = tid & 63, wid = tid >> 6, c2 = tid * 2;
    u32x4 nx[4];
    if (has_next) {
        int tf = tid; asm volatile("" : "+v"(tf));
#pragma unroll
        for (int q = 0; q < 4; ++q) { const int i = tf + q * 512; nx[q] = *(const u32x4*)(GLU + (size_t)(t0 + 16 + (i >> 7)) * 1024 + (i & 127) * 8); }
    }
    const f32x2 bias = *(const f32x2*)(cb + c2);
    f32x2 outv[16];
#pragma unroll
    for (int t = 0; t < 16; ++t) outv[t] = bias;
#pragma unroll
    for (int ps = 0; ps < 2; ++ps) {
        const int kb = ps * 16, ntap = ps == 0 ? 16 : 15;
        f32x2 w[16];
#pragma unroll
        for (int k = 0; k < 16; ++k) if (k < ntap) w[k] = *(const f32x2*)(cw + (kb + k) * 1024 + c2);
#pragma unroll
        for (int r = 0; r < 31; ++r) if (r < ntap + 15) {
            const unsigned v = *(const LAS unsigned*)(lds + ((34 + 16 * PH + kb + r) & 63) * 2048 + tid * 4);
            const f32x2 x = (f32x2){bf_lo(v), bf_hi(v)};
#pragma unroll
            for (int t = 0; t < 16; ++t) { const int k = r - t; if (k >= 0 && k < ntap) outv[t] = __builtin_elementwise_fma(w[k], x, outv[t]); }
            if ((r & 7) == 7) asm volatile("" ::: "memory");
        }
    }
    {
        float s[16], q[16];
#pragma unroll
        for (int t = 0; t < 16; ++t) { s[t] = outv[t][0] + outv[t][1]; q[t] = outv[t][0] * outv[t][0] + outv[t][1] * outv[t][1]; }
#pragma unroll
        for (int lvl = 0; lvl < 4; ++lvl) {
            const int half = 8 >> lvl, off = 32 >> lvl; const bool hi = (lane & off) != 0;
#pragma unroll
            for (int i = 0; i < half; ++i) {
                const float ks = hi ? s[i + half] : s[i], ss = hi ? s[i] : s[i + half]; s[i] = ks + __shfl_xor(ss, off);
                const float kq = hi ? q[i + half] : q[i], sq = hi ? q[i] : q[i + half]; q[i] = kq + __shfl_xor(sq, off);
            }
        }
        s[0] += __shfl_xor(s[0], 2); q[0] += __shfl_xor(q[0], 2);
        s[0] += __shfl_xor(s[0], 1); q[0] += __shfl_xor(q[0], 1);
        if ((lane & 3) == 0) *(LAS f32x2*)(red + ((lane >> 2) * 8 + wid) * 2) = (f32x2){s[0], q[0]};
    }
    __syncthreads();
    if (has_next) {
#pragma unroll
        for (int q = 0; q < 4; ++q) { const int i = tid + q * 512; *(LAS u32x4*)(lds + ((34 + 16 * PH + 46 + (i >> 7)) & 63) * 2048 + (i & 127) * 16) = nx[q]; }
    }
    if (tid < 16) {
        float S = 0.f, Q2 = 0.f;
#pragma unroll
        for (int wv = 0; wv < 8; ++wv) { const f32x2 t = *(const LAS f32x2*)(red + (tid * 8 + wv) * 2); S += t[0]; Q2 += t[1]; }
        const float mean = S * (1.f / 1024.f), var = fmaxf(Q2 * (1.f / 1024.f) - mean * mean, 0.f);
        *(LAS f32x2*)(stats + tid * 2) = (f32x2){mean, 1.0f / sqrtf(var + EPS)};
    }
    __syncthreads();
    const f32x2 lg = *(const f32x2*)(lng + c2), lb = *(const f32x2*)(lnb + c2);
    unsigned zz[16];
#pragma unroll
    for (int t = 0; t < 16; ++t) zz[t] = *(const unsigned*)(SZB + (size_t)(t0 + t) * 1024 + c2);
#pragma unroll
    for (int t = 0; t < 16; ++t) {
        const f32x2 st = *(const LAS f32x2*)(stats + t * 2);
        const float y0 = (outv[t][0] - st[0]) * st[1] * lg[0] + lb[0], y1 = (outv[t][1] - st[0]) * st[1] * lg[1] + lb[1];
        *(unsigned*)(SZB + (size_t)(t0 + t) * 1024 + c2) = pk_bf16(bf_lo(zz[t]) * siluf_(y0), bf_hi(zz[t]) * siluf_(y1));
    }
}
__device__ __forceinline__ void conv31_phase(LAS unsigned char* lds, const bf16_t* GLU, bf16_t* SZB, const float* cw, const float* cb, const float* lng, const float* lnb, int G, int c) {
    int tid_ = threadIdx.x; asm volatile("" : "+v"(tid_));
    const int tid = tid_;
    LAS float* red = (LAS float*)(lds + 131072 + 1024);
    LAS float* stats = (LAS float*)(lds + 131072 + 3072);
    for (int run = c; run < NTOK / 128; run += G) {
        const int T0 = run * 128, tpos = T0 & (SEQ - 1);
        __syncthreads();
#pragma unroll
        for (int h = 0; h < 2; ++h) {
            int tf = tid; asm volatile("" : "+v"(tf));
            u32x4 tv[6];
#pragma unroll
            for (int q = 0; q < 6; ++q) { const int i = tf + (h * 6 + q) * 512, r = (i >> 7) < 46 ? (i >> 7) : 45; const int gr = (tpos - 30 + r >= 0) ? (T0 - 30 + r) : T0;
                tv[q] = *(const u32x4*)(GLU + (size_t)gr * 1024 + (i & 127) * 8); }
#pragma unroll
            for (int q = 0; q < 6; ++q) { const int i = tf + (h * 6 + q) * 512, r = i >> 7;
                if (r < 46) *(LAS u32x4*)(lds + ((34 + r) & 63) * 2048 + (i & 127) * 16) = (tpos - 30 + r >= 0) ? tv[q] : (u32x4){0u, 0u, 0u, 0u}; }
        }
        __syncthreads();
        conv31_chunk<0>(lds, red, stats, GLU, SZB, cw, cb, lng, lnb, T0, true, tid);
        conv31_chunk<1>(lds, red, stats, GLU, SZB, cw, cb, lng, lnb, T0 + 16, true, tid);
        conv31_chunk<2>(lds, red, stats, GLU, SZB, cw, cb, lng, lnb, T0 + 32, true, tid);
        conv31_chunk<3>(lds, red, stats, GLU, SZB, cw, cb, lng, lnb, T0 + 48, true, tid);
        conv31_chunk<0>(lds, red, stats, GLU, SZB, cw, cb, lng, lnb, T0 + 64, true, tid);
        conv31_chunk<1>(lds, red, stats, GLU, SZB, cw, cb, lng, lnb, T0 + 80, true, tid);
        conv31_chunk<2>(lds, red, stats, GLU, SZB, cw, cb, lng, lnb, T0 + 96, true, tid);
        conv31_chunk<3>(lds, red, stats, GLU, SZB, cw, cb, lng, lnb, T0 + 112, false, tid);
    }
    __syncthreads();
}

__global__ void __launch_bounds__(512, 2) fwd_megakernel(Params p) {
    extern __shared__ __attribute__((aligned(16))) unsigned char lds_raw[];
    LAS unsigned char* lds = (LAS unsigned char*)lds_raw;
    const int G = gridDim.x, bx = blockIdx.x;
    unsigned char* ws = p.ws; unsigned char* ob = (unsigned char*)p.out;
    const float *x = p.in[0], *mem = p.in[1], *norm_g = p.in[2], *w_in = p.in[3], *conv_a_w = p.in[4], *w_out_a = p.in[5], *conv_b_w = p.in[6], *conv_b_b = p.in[7],
                *ln_b_g = p.in[8], *ln_b_b = p.in[9], *w_out_b = p.in[10], *mem_norm_g = p.in[11], *w_kv = p.in[12], *w_out_x = p.in[13], *w_o = p.in[14], *final_g = p.in[15];
    bf16_t *WIN = (bf16_t*)(ws + WS_WIN), *WOUT = (bf16_t*)(ws + WS_WOUT), *WO = (bf16_t*)(ws + WS_WO), *WKV = (bf16_t*)(ws + WS_WKV), *MEMN = (bf16_t*)(ws + WS_MEMN),
           *KB = (bf16_t*)(ws + WS_KB), *VT = (bf16_t*)(ws + WS_VT), *PAT = (bf16_t*)(ws + WS_PAT), *GAH = (bf16_t*)(ws + WS_GAH), *HA = (bf16_t*)(ws + WS_HA), *SZB = (bf16_t*)(ws + WS_SZB),
           *SZX = (bf16_t*)(ws + WS_SZX), *GLU = (bf16_t*)(ws + WS_GLU), *Q = (bf16_t*)(ws + WS_Q), *SGA = (bf16_t*)(ws + WS_SGA), *SGB = (bf16_t*)(ws + WS_SGB),
           *U = (bf16_t*)(ob + OUT_U), *SGX = (bf16_t*)(ob + OUT_SGX);
    float *ROWSS = (float*)(ws + WS_ROWSS), *RSUM = (float*)(ws + WS_RSUM);
    bf16_t* MERGED = GLU;
    volatile LAS unsigned* xst = (volatile LAS unsigned*)(lds + 131072 + 512);
    if (threadIdx.x < 4) xst[threadIdx.x] = 0u;
    __syncthreads();
    XcdBarrier xb = xcd_barrier_post((unsigned*)(ws + WS_BAR), xst);

    {
        int tid_ = threadIdx.x; asm volatile("" : "+v"(tid_)); const int tid = tid_, lane = tid & 63, wave = tid >> 6;
        LAS float* scr = (LAS float*)(lds + wave * 16384);
        const int gw = bx * 8 + wave, NGW = G * 8;
        for (int it = gw; it < 9216; it += NGW) {
            int r = it;
            if (r < 6144) { const int g = r % 384; p0_transpose_item(w_in, 12288, WIN, (g >> 1) * 64 + (g & 1) * 16, (r / 384) * 64, true, scr, lane); continue; } r -= 6144;
            if (r < 512) { p0_transpose_item(w_out_a, 1024, WOUT, (r & 31) * 32, (r >> 5) * 64, false, scr, lane); continue; } r -= 512;
            if (r < 512) { p0_transpose_item(w_out_b, 1024, WOUT + (size_t)1024 * 1024, (r & 31) * 32, (r >> 5) * 64, false, scr, lane); continue; } r -= 512;
            if (r < 512) { p0_transpose_item(w_out_x, 1024, WOUT + (size_t)2048 * 1024, (r & 31) * 32, (r >> 5) * 64, false, scr, lane); continue; } r -= 512;
            if (r < 512) { p0_transpose_item(w_o, 1024, WO, (r & 31) * 32, (r >> 5) * 64, false, scr, lane); continue; } r -= 512;
            p0_transpose_item(w_kv, 2048, WKV, (r & 63) * 32, (r >> 6) * 64, false, scr, lane);
        }
        {
            const f32x4* gr = (const f32x4*)norm_g + lane; f32x4 gg[4];
#pragma unroll
            for (int j = 0; j < 4; ++j) gg[j] = gr[64 * j];
            for (int m = gw; m < NTOK; m += 4 * NGW) {
                f32x4 v[4][4];
#pragma unroll
                for (int r = 0; r < 4; ++r) { const f32x4* xr = (const f32x4*)(x + (size_t)(m + r * NGW) * 1024) + lane;
#pragma unroll
                    for (int j = 0; j < 4; ++j) v[r][j] = xr[64 * j]; }
#pragma unroll
                for (int r = 0; r < 4; ++r) {
                    float sq = 0.f;
#pragma unroll
                    for (int j = 0; j < 4; ++j) sq += (v[r][j][0] * v[r][j][0] + v[r][j][1] * v[r][j][1]) + (v[r][j][2] * v[r][j][2] + v[r][j][3] * v[r][j][3]);
                    const float rstd = 1.0f / sqrtf(wave_sum(sq) * (1.f / 1024.f) + EPS);
                    u32x2* o8 = (u32x2*)(U + (size_t)(m + r * NGW) * 1024) + lane;
#pragma unroll
                    for (int j = 0; j < 4; ++j) o8[64 * j] = pk4(v[r][j] * rstd * gg[j]);
                }
            }
        }
        for (int m = gw; m < 1024; m += NGW) rms_row_to_bf16(mem + (size_t)m * 1024, mem_norm_g, MEMN + (size_t)m * 1024, lane);
        for (int i = bx * 512 + tid; i < NTOK * 5; i += G * 512) ROWSS[i] = 0.f;
    }
    GRID_SYNC();

    {
        SchedP1 S{(const char*)U, (const char*)WIN, (const char*)MEMN, (const char*)WKV, G, bx};
        EpiP1 E{HA, GLU, SZB, SZX, Q, SGA, SGB, SGX, KB, VT, PAT, GAH, conv_a_w};
        gemm_phase(lds, 1024, 1024, 1024, S, E);
    }
    GRID_SYNC();

    {
        int tid_ = threadIdx.x; asm volatile("" : "+v"(tid_)); const int tid = tid_;
        for (int i = bx * 512 + tid; i < 512 * 256; i += G * 512) {
            const int blk = i >> 8, ch = (i & 255) * 4;
            if ((blk & 127) != 0) {
                const f32x4 w0 = *(const f32x4*)(conv_a_w + ch), w1 = *(const f32x4*)(conv_a_w + 1024 + ch);
                const f32x4 pt0 = unpk4(*(const u32x2*)(PAT + (size_t)((blk - 1) * 2 + 0) * 1024 + ch)), pt1 = unpk4(*(const u32x2*)(PAT + (size_t)((blk - 1) * 2 + 1) * 1024 + ch));
                const f32x4 g0 = unpk4(*(const u32x2*)(GAH + (size_t)(blk * 2 + 0) * 1024 + ch)), g1 = unpk4(*(const u32x2*)(GAH + (size_t)(blk * 2 + 1) * 1024 + ch));
                u32x2* h0 = (u32x2*)(HA + (size_t)(blk * 64) * 1024 + ch); u32x2* h1 = (u32x2*)(HA + (size_t)(blk * 64 + 1) * 1024 + ch);
                *h0 = pk4(unpk4(*h0) + g0 * (w1 * pt1 + w0 * pt0));
                *h1 = pk4(unpk4(*h1) + g1 * (w0 * pt1));
            }
        }
        { SchedAttn S{(const char*)Q, (const char*)KB, TILE, (size_t)512, G, bx}; EpiS E{Q, RSUM}; gemm_phase(lds, 1024, 1024, 256, S, E); }
        conv31_phase(lds, GLU, SZB, conv_b_w, conv_b_b, ln_b_g, ln_b_b, G, bx);
    }
    asm volatile("s_waitcnt vmcnt(0) lgkmcnt(0)" ::: "memory"); __syncthreads();
    __builtin_amdgcn_fence(__ATOMIC_ACQUIRE, "agent"); asm volatile("s_waitcnt vmcnt(0)" ::: "memory"); __syncthreads();

    { SchedAttn S{(const char*)Q, (const char*)VT, (size_t)1024 * 256 * 2, (size_t)256 * 256 * 2, G, bx}; EpiPV E{SZX, U  , RSUM}; gemm_phase(lds, 1024, 256, 256, S, E); }
    GRID_SYNC();

    { SchedOut S{(const char*)HA, (const char*)U, (const char*)WOUT, G, bx}; EpiOut E{SGA, SGB, SGX, Q  , MERGED}; gemm_phase(lds, 1024, 1024, 1024, S, E); }
    GRID_SYNC();

    { SchedWo S{(const char*)MERGED, (const char*)WO, G, bx}; EpiWo E{x, HA  , ROWSS}; gemm_phase(lds, 1024, 1024, 1024, S, E); }
    GRID_SYNC();

    {
        int tid_ = threadIdx.x; asm volatile("" : "+v"(tid_)); const int lane = tid_ & 63, w4 = tid_ >> 6, wr = w4 >> 2, wc = w4 & 3, fr = lane & 15, fq = lane >> 4;
        for (int L = bx; L < 512; L += G) {
            const int pm = L >> 2, pn = L & 3;
#pragma unroll
            for (int ai = 0; ai < 2; ++ai) {
                u32x2 hv[4][2][2]; float rs[4]; f32x4 gg[2][2];
#pragma unroll
                for (int m = 0; m < 4; ++m) {
                    rs[m] = ROWSS[pm * 256 + ai * 128 + wr * 64 + m * 16 + fr];
#pragma unroll
                    for (int bj = 0; bj < 2; ++bj)
#pragma unroll
                        for (int n = 0; n < 2; ++n) hv[m][bj][n] = ((const u32x2*)HA)[native_slot(pm, pn, w4, ai, m, bj, n, fq * 16 + fr)];
                }
#pragma unroll
                for (int bj = 0; bj < 2; ++bj)
#pragma unroll
                    for (int n = 0; n < 2; ++n) gg[bj][n] = *(const f32x4*)(final_g + pn * 256 + bj * 128 + wc * 32 + n * 16 + fq * 4);
#pragma unroll
                for (int m = 0; m < 4; ++m) {
                    const float rstd = 1.0f / sqrtf(rs[m] * (1.f / 1024.f) + EPS);
#pragma unroll
                    for (int bj = 0; bj < 2; ++bj)
#pragma unroll
                        for (int n = 0; n < 2; ++n)
                            *(f32x4*)(p.out + (size_t)(pm * 256 + ai * 128 + wr * 64 + m * 16 + fr) * 1024 + pn * 256 + bj * 128 + wc * 32 + n * 16 + fq * 4) = unpk4(hv[m][bj][n]) * rstd * gg[bj][n];
                }
            }
        }
    }
}

extern "C" void kernel_launch(void* const* d_in, const int* in_sizes, int n_in, void* d_out, int out_size, void* d_ws, size_t ws_size, hipStream_t stream) {
    static int grid_blocks = 0;
    if (!grid_blocks) {
        int dev = 0, cus = 0, per_cu = 0;
        hipGetDevice(&dev);
        hipDeviceGetAttribute(&cus, hipDeviceAttributeMultiprocessorCount, dev);
        hipFuncSetAttribute((const void*)fwd_megakernel, hipFuncAttributeMaxDynamicSharedMemorySize, LDS_BYTES);
        hipOccupancyMaxActiveBlocksPerMultiprocessor(&per_cu, (const void*)fwd_megakernel, 512, LDS_BYTES);
        if (per_cu < 1) { fprintf(stderr, "kernel_launch: occupancy query reports %d blocks per CU\n", per_cu); per_cu = 1; }
        if (per_cu > 1) per_cu = 1;
        grid_blocks = cus * per_cu;
        if (ws_size < WS_END) fprintf(stderr, "kernel_launch: workspace too small: %zu < %zu\n", ws_size, (size_t)WS_END);
    }
    (void)hipMemsetAsync((char*)d_ws + WS_BAR, 0, XCD_BAR_WORDS * 4, stream);
    if (ws_size < WS_END) return;
    Params p{};
    for (int i = 0; i < 16; ++i) p.in[i] = (const float*)d_in[i];
    p.out = (float*)d_out; p.ws = (unsigned char*)d_ws;
    void* args[] = {&p};
    hipError_t e = hipLaunchCooperativeKernel((const void*)fwd_megakernel, dim3(grid_blocks), dim3(512), args, LDS_BYTES, stream);
    if (e != hipSuccess) fprintf(stderr, "cooperative launch failed: %s (grid %d)\n", hipGetErrorString(e), grid_blocks);
}
```

```cpp
#include <hip/hip_runtime.h>
#include <cstdio>

#define LAS __attribute__((address_space(3)))
typedef unsigned short bf16_t;
typedef short bf16x8 __attribute__((ext_vector_type(8)));
typedef float f32x4 __attribute__((ext_vector_type(4)));
typedef float f32x2 __attribute__((ext_vector_type(2)));
typedef unsigned u32x4 __attribute__((ext_vector_type(4)));
typedef unsigned u32x2 __attribute__((ext_vector_type(2)));

constexpr int BM = 256, BK = 64, HALF = 128, HTB = HALF * BK * 2, STAGE_BYTES = 8 * HTB;
constexpr int LDS_BYTES = 147456;
constexpr int NTOK = 32768, DM = 1024, SEQ = 8192;
constexpr float EPS = 1e-6f;
constexpr size_t MiB = 1u << 20;
constexpr size_t TILE = (size_t)256 * 1024 * 2;
constexpr size_t WS_WIN = 0, WS_WOUT = 24 * MiB, WS_WO = 30 * MiB, WS_WKV = 32 * MiB, WS_MEMN = 36 * MiB, WS_KB = 38 * MiB, WS_VT = 40 * MiB;
constexpr size_t WS_ROWSS = 42 * MiB, WS_RSUM = 42 * MiB + 131072, WS_PAT = 43 * MiB, WS_GAH = 45 * MiB;
constexpr size_t WS_BAR = 47 * MiB;
constexpr size_t WS_HA = 48 * MiB, WS_SZB = 112 * MiB, WS_SZX = 176 * MiB, WS_GLU = 240 * MiB, WS_Q = 304 * MiB, WS_SGA = 368 * MiB, WS_SGB = 432 * MiB, WS_END = 496 * MiB;
constexpr size_t OUT_U = 0, OUT_SGX = 64 * MiB;

#define XB_TMO      128
#define XB_XCNT(j)  (256  + 64 * (j))
#define XB_XSUB(j)  (1280 + 64 * (j))
#define XB_XGEN(j)  (2304 + 64 * (j))
#define XB_TOP      3328
#define XB_TOPGEN   3392
#define XCD_BAR_WORDS 3456
#define XB_SPIN_CAP (1u << 18)

__device__ __forceinline__ unsigned xb_ld(unsigned* p)              { return __hip_atomic_load(p, __ATOMIC_RELAXED, __HIP_MEMORY_SCOPE_AGENT); }
__device__ __forceinline__ unsigned xb_add(unsigned* p, unsigned v) { return __hip_atomic_fetch_add(p, v, __ATOMIC_RELAXED, __HIP_MEMORY_SCOPE_AGENT); }
__device__ __forceinline__ unsigned xb_xcc_id() { return (unsigned)__builtin_amdgcn_s_getreg((3 << 11) | 20) & 0xFu; }
#define XB_SPIN(cond, bar) do { unsigned _sp = 0; while (cond) { __builtin_amdgcn_s_sleep(1); \
    if ((++_sp & 255u) == 0u) { if (xb_ld(&(bar)[XB_TMO])) break; if (_sp > XB_SPIN_CAP) { atomicAdd(&(bar)[XB_TMO], 1u); break; } } } } while (0)

struct XcdBarrier {
    unsigned* bar; unsigned x;
    volatile LAS unsigned* st;
};

__device__ __forceinline__ XcdBarrier xcd_barrier_post(unsigned* bar, volatile LAS unsigned* st) {
    XcdBarrier b; b.bar = bar; b.x = xb_xcc_id(); b.st = st;
    if (threadIdx.x == 0) (void)xb_add(&bar[XB_XCNT(b.x)], 1u);
    return b;
}
__device__ __forceinline__ void xcd_barrier_complete(unsigned* bar, unsigned x, unsigned& nloc, unsigned& nx) {
    const unsigned G = gridDim.x * gridDim.y * gridDim.z;
    unsigned sum, cnt, mine, sp = 0u;
    for (;;) {
        sum = 0u; cnt = 0u; mine = 0u;
#pragma unroll
        for (unsigned j = 0; j < 16; ++j) { const unsigned c = xb_ld(&bar[XB_XCNT(j)]); sum += c; cnt += (c > 0u) ? 1u : 0u; mine = (j == x) ? c : mine; }
        if (sum == G) break;
        __builtin_amdgcn_s_sleep(1);
        if ((++sp & 255u) == 0u) { if (xb_ld(&bar[XB_TMO])) break; if (sp > XB_SPIN_CAP) { atomicAdd(&bar[XB_TMO], 1u); break; } }
    }
    nloc = mine > 0u ? mine : 1u; nx = cnt > 0u ? cnt : 1u;
}

__device__ __forceinline__ void xcd_barrier(const XcdBarrier& b) {
    asm volatile("s_waitcnt vmcnt(0)" ::: "memory");
    __syncthreads();
    if (threadIdx.x == 0) {
        unsigned* bar = b.bar;
        __builtin_amdgcn_s_waitcnt(0);
        unsigned nloc = b.st[0], nx = b.st[1];
        if (nloc == 0u) { xcd_barrier_complete(bar, b.x, nloc, nx); b.st[0] = nloc; b.st[1] = nx; }
        const unsigned old = xb_add(&bar[XB_XSUB(b.x)], 1u);
        const unsigned gen = old / nloc;
        if (old + 1u == (gen + 1u) * nloc) {
            __builtin_amdgcn_fence(__ATOMIC_RELEASE, "agent");
            asm volatile("s_waitcnt vmcnt(0)" ::: "memory");
            const unsigned og = xb_add(&bar[XB_TOP], 1u);
            const unsigned tg = og / nx;
            if (og + 1u == (tg + 1u) * nx) xb_add(&bar[XB_TOPGEN], 1u);
            else XB_SPIN(xb_ld(&bar[XB_TOPGEN]) == tg, bar);
            __builtin_amdgcn_fence(__ATOMIC_ACQUIRE, "agent");
            xb_add(&bar[XB_XGEN(b.x)], 1u);
            asm volatile("s_waitcnt vmcnt(0)" ::: "memory");
        } else {
            XB_SPIN(xb_ld(&bar[XB_XGEN(b.x)]) == gen, bar);
            __builtin_amdgcn_fence(__ATOMIC_ACQUIRE, "agent");
            asm volatile("s_waitcnt vmcnt(0)" ::: "memory");
        }
    }
    __syncthreads();
}

#define GRID_SYNC() xcd_barrier(xb)

struct Params { const float* in[16]; float* out; unsigned char* ws; };

typedef __bf16 bf16x2_t __attribute__((ext_vector_type(2)));
__device__ __forceinline__ unsigned pk_bf16(float lo, float hi) { const f32x2 v = {lo, hi}; return __builtin_bit_cast(unsigned, __builtin_convertvector(v, bf16x2_t)); }
__device__ __forceinline__ float bf_lo(unsigned u) { return __uint_as_float(u << 16); }
__device__ __forceinline__ float bf_hi(unsigned u) { return __uint_as_float(u & 0xffff0000u); }
__device__ __forceinline__ float sigmoidf_(float x) { return __builtin_amdgcn_rcpf(1.0f + __builtin_amdgcn_exp2f(-1.44269504089f * x)); }
__device__ __forceinline__ float siluf_(float x) { return x * sigmoidf_(x); }
__device__ __forceinline__ u32x2 pk4(f32x4 v) { u32x2 r; r.x = pk_bf16(v[0], v[1]); r.y = pk_bf16(v[2], v[3]); return r; }
__device__ __forceinline__ f32x4 unpk4(u32x2 v) { return (f32x4){bf_lo(v.x), bf_hi(v.x), bf_lo(v.y), bf_hi(v.y)}; }
template <int CTRL> __device__ __forceinline__ float dppf(float old, float v) { return __int_as_float(__builtin_amdgcn_update_dpp(__float_as_int(old), __float_as_int(v), CTRL, 0xf, 0xf, false)); }
__device__ __forceinline__ float wave_sum(float v) {
#pragma unroll
    for (int o = 1; o < 64; o <<= 1) v += __shfl_xor(v, o);
    return v;
}

__device__ __forceinline__ int lds_byte(int r, int c) { const int st = (r >> 4) * 2 + (c >> 5), rr = r & 15, cc = c & 31, ob = rr * 64 + cc * 2; return st * 1024 + (ob ^ (((ob >> 9) & 1) << 5)); }
__device__ __forceinline__ void stage_rc(int b, int& R, int& C) { const int st = b / 1024, sb = b % 1024, swz = sb ^ (((sb >> 9) & 1) << 5); R = (st >> 1) * 16 + swz / 64; C = (st & 1) * 32 + (swz % 64) / 2; }

struct Unit { const char* A; const char* B; int pm, pn, kind; };
__device__ __forceinline__ size_t native_slot(int pm, int pn4, int w4, int ai, int m, int bj, int n, int lane) {
    return ((((size_t)(pm * 4 + pn4) * 8 + w4) * 32 + (((ai * 4 + m) * 2 + bj) * 2 + n)) * 64 + lane);
}

template <int WG = 8> __device__ __forceinline__ void remap_tile(int L, int nM, int nN, int& pm, int& pn) {
    const int nwg = nM * nN; int wgid = L;
    { const int q = nwg / 8, r = nwg % 8, xcd = wgid % 8, off = wgid / 8; wgid = (xcd < r ? xcd * (q + 1) : r * (q + 1) + (xcd - r) * q) + off; }
    const int nig = WG * nN, gid = wgid / nig, fm = gid * WG, gsz = (nM - fm) < WG ? (nM - fm) : WG;
    pm = fm + ((wgid % nig) % gsz); pn = (wgid % nig) / gsz;
}

template <class Epi, class Sched>
__device__ __forceinline__ void gemm_phase(LAS unsigned char* lds, const int lda, const int ldb, const int K, const Sched& S, const Epi& E) {
    int tid_ = threadIdx.x; asm volatile("" : "+v"(tid_));
    const int tid = tid_, wid = __builtin_amdgcn_readfirstlane(tid >> 6), lane = tid & 63, wr = wid >> 2, wc = wid & 3, fr = lane & 15, fq = lane >> 4;
    const int nt = K / BK;
    unsigned voffA[2], voffB[2];
#pragma unroll
    for (int i = 0; i < 2; ++i) { int R, C; stage_rc(tid * 16 + i * 8192, R, C); voffA[i] = (unsigned)(R * lda + C) * 2u; voffB[i] = (unsigned)(R * ldb + C) * 2u; }
    const size_t kstep = (size_t)(BK * 2);
    const size_t hstepA = (size_t)HALF * lda * 2, hstepB = (size_t)HALF * ldb * 2;
    const unsigned ldsw = (unsigned)wid * 1024u;
    const int aoff = lds_byte(wr * 64 + fr, fq * 8), boff = lds_byte(wc * 32 + fr, fq * 8);
#define GP_SA(b, h) (((b) * 2 + (h)) * HTB)
#define GP_SB(b, h) ((4 + (b) * 2 + (h)) * HTB)
#define GP_STAGE(bufoff, gbase, voff) do { _Pragma("unroll") for (int _i = 0; _i < 2; ++_i) \
        __builtin_amdgcn_global_load_lds((const unsigned*)((const char*)(gbase) + (voff)[_i]), (LAS unsigned*)(lds + (bufoff) + ldsw + _i * 8192), 16, 0, 0); } while (0)
#define GP_LDA(dst, b, h) do { _Pragma("unroll") for (int m = 0; m < 4; ++m) _Pragma("unroll") for (int k = 0; k < 2; ++k) dst[m][k] = *(const LAS bf16x8*)(lds + GP_SA(b, h) + aoff + m * 2048 + k * 1024); } while (0)
#define GP_LDB(dst, b, h) do { _Pragma("unroll") for (int n = 0; n < 2; ++n) _Pragma("unroll") for (int k = 0; k < 2; ++k) dst[n][k] = *(const LAS bf16x8*)(lds + GP_SB(b, h) + boff + n * 2048 + k * 1024); } while (0)
#define GP_MMA(ai, bj, At, Bt) do { __builtin_amdgcn_s_setprio(1); _Pragma("unroll") for (int m = 0; m < 4; ++m) _Pragma("unroll") for (int n = 0; n < 2; ++n) _Pragma("unroll") for (int k = 0; k < 2; ++k) \
        acc[ai][bj][m][n] = __builtin_amdgcn_mfma_f32_16x16x32_bf16(Bt[n][k], At[m][k], acc[ai][bj][m][n], 0, 0, 0); __builtin_amdgcn_s_setprio(0); } while (0)
#define GP_WAIT_V(n) asm volatile("s_waitcnt vmcnt(" #n ")" ::: "memory")
#define GP_WAIT_L(n) asm volatile("s_waitcnt lgkmcnt(" #n ")" ::: "memory")
#define GP_BAR __builtin_amdgcn_s_barrier()
#define GP_SCHED __builtin_amdgcn_sched_barrier(0)
    Unit cur, nxt; int ui = 0;
    if (!S.next(0, cur)) return;
    f32x4 acc[2][2][4][2];
#pragma unroll
    for (int a = 0; a < 2; ++a)
#pragma unroll
        for (int b = 0; b < 2; ++b)
#pragma unroll
            for (int m = 0; m < 4; ++m)
#pragma unroll
                for (int n = 0; n < 2; ++n) acc[a][b][m][n] = (f32x4){0.f, 0.f, 0.f, 0.f};
    bf16x8 At[4][2], B0[2][2], B1[2][2];
    const char* cA = cur.A; const char* cB = cur.B;
    GP_STAGE(GP_SB(0, 0), cB, voffB); GP_STAGE(GP_SB(0, 1), cB + hstepB, voffB); GP_STAGE(GP_SA(0, 0), cA, voffA); GP_STAGE(GP_SA(0, 1), cA + hstepA, voffA);
    if (wr == 1) GP_BAR;
    GP_WAIT_V(2); GP_BAR;
    GP_STAGE(GP_SB(1, 0), cB + kstep, voffB); GP_STAGE(GP_SA(1, 0), cA + kstep, voffA); GP_STAGE(GP_SB(1, 1), cB + hstepB + kstep, voffB);
    GP_WAIT_V(6); GP_BAR;
    for (;;) {
        const bool has_next = S.next(ui + 1, nxt);
        const char* nA = has_next ? nxt.A : cA; const char* nB = has_next ? nxt.B : cB;
        for (int t = 0; t < nt; t += 2) {
            const bool last = (t == nt - 2);
            const char* a1 = cA + (size_t)(t + 1) * kstep;
            const char* a2 = last ? nA : cA + (size_t)(t + 2) * kstep; const char* b2 = last ? nB : cB + (size_t)(t + 2) * kstep;
            const char* a3 = a2 + kstep; const char* b3 = b2 + kstep;
            GP_LDB(B0, 0, 0); GP_LDB(B1, 0, 1); GP_SCHED; GP_LDA(At, 0, 0); GP_STAGE(GP_SA(1, 1), a1 + hstepA, voffA);
            GP_WAIT_V(8); GP_WAIT_L(0); GP_BAR; GP_MMA(0, 0, At, B0); GP_MMA(0, 1, At, B1); GP_BAR; GP_SCHED;
            GP_LDA(At, 0, 1); GP_STAGE(GP_SB(0, 0), b2, voffB); GP_STAGE(GP_SB(0, 1), b2 + hstepB, voffB); GP_STAGE(GP_SA(0, 0), a2, voffA);
            GP_WAIT_V(8); GP_WAIT_L(0); GP_BAR; GP_MMA(1, 0, At, B0); GP_MMA(1, 1, At, B1); GP_BAR; GP_SCHED;
            GP_LDB(B0, 1, 0); GP_LDB(B1, 1, 1); GP_SCHED; GP_LDA(At, 1, 0); GP_STAGE(GP_SA(0, 1), a2 + hstepA, voffA);
            GP_WAIT_V(8); GP_WAIT_L(0); GP_BAR; GP_MMA(0, 0, At, B0); GP_MMA(0, 1, At, B1); GP_BAR; GP_SCHED;
            GP_LDA(At, 1, 1); GP_STAGE(GP_SB(1, 0), b3, voffB); GP_STAGE(GP_SB(1, 1), b3 + hstepB, voffB); GP_STAGE(GP_SA(1, 0), a3, voffA);
            GP_WAIT_V(8); GP_WAIT_L(0); GP_BAR; GP_MMA(1, 0, At, B0); GP_MMA(1, 1, At, B1); GP_BAR; GP_SCHED;
        }
        if (wr == 0) GP_BAR;
        E(acc, cur, wr, wc, fr, fq);
        if (!has_next) break;
#pragma unroll
        for (int a = 0; a < 2; ++a)
#pragma unroll
            for (int b = 0; b < 2; ++b)
#pragma unroll
                for (int m = 0; m < 4; ++m)
#pragma unroll
                    for (int n = 0; n < 2; ++n) acc[a][b][m][n] = (f32x4){0.f, 0.f, 0.f, 0.f};
        cur = nxt; cA = nA; cB = nB; ++ui;
        if (wr == 1) GP_BAR;
    }
    GP_WAIT_V(0);
    GP_BAR;
#undef GP_SA
#undef GP_SB
#undef GP_STAGE
#undef GP_LDA
#undef GP_LDB
#undef GP_MMA
#undef GP_WAIT_V
#undef GP_WAIT_L
#undef GP_BAR
#undef GP_SCHED
}

struct SchedP1 {
    const char *U, *Win, *Memn, *Wkv; int G, c;
    __device__ __forceinline__ bool next(int i, Unit& u) const {
        if (G == 256) {
            if (i < 24) { const int l = i * 32 + (c >> 3); int pm = l / 6, pn = 6 * (c & 7) + l % 6; pn = (pn % 3) * 16 + pn / 3;
                u.pm = pm; u.pn = pn; u.kind = pn >> 4; u.A = U + (size_t)pm * TILE; u.B = Win + (size_t)pn * TILE; return true; }
            if (i > 24 || c >= 32) return false;
            int L = c;
            if (L < 16) { u.pm = L >> 2; u.pn = L & 3; u.kind = 3; u.A = Memn + (size_t)u.pm * TILE; u.B = Wkv + (size_t)u.pn * TILE; }
            else { L -= 16; u.pm = L >> 2; u.pn = L & 3; u.kind = 4; u.A = Wkv + (size_t)(4 + u.pm) * TILE; u.B = Memn + (size_t)u.pn * TILE; }
            return true;
        }
        int L = i * G + c;
        if (L < 6144) { int pm, pn; remap_tile<4>(L, 128, 48, pm, pn); pn = (pn % 3) * 16 + pn / 3; u.pm = pm; u.pn = pn; u.kind = pn >> 4; u.A = U + (size_t)pm * TILE; u.B = Win + (size_t)pn * TILE; return true; }
        L -= 6144; if (L >= 32) return false;
        if (L < 16) { u.pm = L >> 2; u.pn = L & 3; u.kind = 3; u.A = Memn + (size_t)u.pm * TILE; u.B = Wkv + (size_t)u.pn * TILE; }
        else { L -= 16; u.pm = L >> 2; u.pn = L & 3; u.kind = 4; u.A = Wkv + (size_t)(4 + u.pm) * TILE; u.B = Memn + (size_t)u.pn * TILE; }
        return true;
    }
};
struct SchedAttn {
    const char *Aq, *Bm; size_t bstride_b, bstride_h; int G, c;
    __device__ __forceinline__ bool next(int i, Unit& u) const {
        const int L = i * G + c; if (L >= 512) return false;
        u.pm = L >> 2; u.pn = L & 3; u.kind = 0;
        u.A = Aq + (size_t)u.pm * TILE + (size_t)u.pn * 512; u.B = Bm + (size_t)(u.pm >> 5) * bstride_b + (size_t)u.pn * bstride_h; return true;
    }
};
struct SchedOut {
    const char *H, *HXp, *W; int G, c;
    __device__ __forceinline__ bool next(int i, Unit& u) const {
        const int ti = i / 3, g = i - 3 * ti; const int L = ti * G + c; if (L >= 512) return false;
        int pm, pn; remap_tile(L, 128, 4, pm, pn); u.pm = pm; u.pn = pn; u.kind = g;
        if (g == 2) u.A = HXp + (size_t)pm * TILE; else u.A = H + ((size_t)g * 128 + pm) * TILE;
        u.B = W + ((size_t)g * 4 + pn) * TILE; return true;
    }
};
struct SchedWo {
    const char *A, *W; int G, c;
    __device__ __forceinline__ bool next(int i, Unit& u) const {
        const int L = i * G + c; if (L >= 512) return false;
        int pm, pn; remap_tile(L, 128, 4, pm, pn); u.pm = pm; u.pn = pn; u.kind = 0; u.A = A + (size_t)pm * TILE; u.B = W + (size_t)pn * TILE; return true;
    }
};

__device__ __forceinline__ int pf(int fq) { return (fq >> 1) | ((fq & 1) << 1); }
__device__ __forceinline__ void store_pair16(bf16_t* rowbase  , u32x2 a  , u32x2 b  , int fq) {
    const auto rx = __builtin_amdgcn_permlane32_swap(a.x, b.x, false, false), ry = __builtin_amdgcn_permlane32_swap(a.y, b.y, false, false);
    *(u32x4*)(rowbase + (size_t)((fq >> 1) * 16) * 1024 + (fq & 1) * 8) = (u32x4){rx[0], ry[0], rx[1], ry[1]};
}
struct EpiP1 {
    bf16_t *HA, *GLU, *SZB, *SZX, *Q, *SGA, *SGB, *SGX, *KB, *VT, *PAT, *GAH; const float* convw;
    __device__ __forceinline__ void operator()(const f32x4 (&acc)[2][2][4][2], const Unit& u, int wr, int wc, int fr, int fq) const {
        if (u.kind <= 2) {
            const int chw = (u.pn & 15) * 64 + wc * 16, ch = chw + pf(fq) * 4;
            const int rowb = u.pm * 256 + wr * 64 + fr;
            if (u.kind == 0) {
                const f32x4 w0 = *(const f32x4*)(convw + ch), w1 = *(const f32x4*)(convw + 1024 + ch), w2 = *(const f32x4*)(convw + 2048 + ch);
#pragma unroll
                for (int ai = 0; ai < 2; ++ai) {
                    const int blk = u.pm * 4 + ai * 2 + wr;
                    f32x4 pprev = (f32x4){0.f, 0.f, 0.f, 0.f}; u32x2 hv[4];
#pragma unroll
                    for (int m = 0; m < 4; ++m) {
                        const f32x4 Bv = acc[ai][0][m][0], Cv = acc[ai][0][m][1], Xv = acc[ai][1][m][0], Zv = acc[ai][1][m][1];
                        const f32x4 p = Cv * Xv; f32x4 ga, p1, p2;
#pragma unroll
                        for (int j = 0; j < 4; ++j) {
                            ga[j] = siluf_(Zv[j]) * Bv[j];
                            const float r1 = (m > 0) ? dppf<0x121>(0.f, pprev[j]) : 0.f, r2 = (m > 0) ? dppf<0x122>(0.f, pprev[j]) : 0.f;
                            p1[j] = dppf<0x111>(r1, p[j]); p2[j] = dppf<0x112>(r2, p[j]);
                        }
                        const f32x4 cv = w2 * p + w1 * p1 + w0 * p2;
                        hv[m] = pk4(ga * cv);
                        if (m == 3 && fr >= 14) *(u32x2*)(PAT + (size_t)(blk * 2 + (fr - 14)) * 1024 + ch) = pk4(p);
                        if (m == 0 && fr < 2) *(u32x2*)(GAH + (size_t)(blk * 2 + fr) * 1024 + ch) = pk4(ga);
                        pprev = p;
                    }
#pragma unroll
                    for (int pr = 0; pr < 2; ++pr) store_pair16(HA + (size_t)(rowb + ai * 128 + pr * 32) * 1024 + chw, hv[2 * pr], hv[2 * pr + 1], fq);
                }
            } else if (u.kind == 1) {
#pragma unroll
                for (int ai = 0; ai < 2; ++ai) {
                    u32x2 gv[4], zv[4];
#pragma unroll
                    for (int m = 0; m < 4; ++m) {
                        const f32x4 Vv = acc[ai][0][m][0], Gv = acc[ai][0][m][1], Zb = acc[ai][1][m][0], Zx = acc[ai][1][m][1]; f32x4 o0, o1, o2;
#pragma unroll
                        for (int j = 0; j < 4; ++j) { o0[j] = Vv[j] * sigmoidf_(Gv[j]); o1[j] = siluf_(Zb[j]); o2[j] = siluf_(Zx[j]); }
                        gv[m] = pk4(o0); zv[m] = pk4(o1);
                        { const int c = (u.pn & 3) * 64 + wc * 16;
                          ((u32x2*)SZX)[native_slot(u.pm, (u.pn & 15) >> 2, wr * 4 + ((c >> 5) & 3), ai, m, c >> 7, (c >> 4) & 1, pf(fq) * 16 + fr)] = pk4(o2); }
                    }
#pragma unroll
                    for (int pr = 0; pr < 2; ++pr) {
                        store_pair16(GLU + (size_t)(rowb + ai * 128 + pr * 32) * 1024 + chw, gv[2 * pr], gv[2 * pr + 1], fq);
                        store_pair16(SZB + (size_t)(rowb + ai * 128 + pr * 32) * 1024 + chw, zv[2 * pr], zv[2 * pr + 1], fq);
                    }
                }
            } else {
#pragma unroll
                for (int ai = 0; ai < 2; ++ai) {
                    u32x2 qv[4];
#pragma unroll
                    for (int m = 0; m < 4; ++m) {
                        const f32x4 Qv = acc[ai][0][m][0], Ga = acc[ai][0][m][1], Gb = acc[ai][1][m][0], Gx = acc[ai][1][m][1]; f32x4 o1, o2, o3;
#pragma unroll
                        for (int j = 0; j < 4; ++j) { o1[j] = sigmoidf_(Ga[j]); o2[j] = sigmoidf_(Gb[j]); o3[j] = sigmoidf_(Gx[j]); }
                        qv[m] = pk4(Qv * 0.0625f);
                        const int c = (u.pn & 3) * 64 + wc * 16;
                        const size_t ns = native_slot(u.pm, (u.pn & 15) >> 2, wr * 4 + ((c >> 5) & 3), ai, m, c >> 7, (c >> 4) & 1, pf(fq) * 16 + fr);
                        ((u32x2*)SGA)[ns] = pk4(o1); ((u32x2*)SGB)[ns] = pk4(o2); ((u32x2*)SGX)[ns] = pk4(o3);
                    }
#pragma unroll
                    for (int pr = 0; pr < 2; ++pr) store_pair16(Q + (size_t)(rowb + ai * 128 + pr * 32) * 1024 + chw, qv[2 * pr], qv[2 * pr + 1], fq);
                }
            }
        } else {
            const int r0 = wr * 64 + fr, c0 = wc * 32 + fq * 4;
#pragma unroll
            for (int ai = 0; ai < 2; ++ai)
#pragma unroll
                for (int m = 0; m < 4; ++m)
#pragma unroll
                    for (int bj = 0; bj < 2; ++bj)
#pragma unroll
                        for (int n = 0; n < 2; ++n) {
                            const int r = r0 + ai * 128 + m * 16, c = c0 + bj * 128 + n * 16;
                            if (u.kind == 3) *(u32x2*)(KB + (size_t)(u.pm * 256 + r) * 1024 + u.pn * 256 + c) = pk4(acc[ai][bj][m][n]);
                            else             *(u32x2*)(VT + ((size_t)u.pn * 1024 + u.pm * 256 + r) * 256 + c) = pk4(acc[ai][bj][m][n]);
                        }
        }
    }
};
struct EpiS {
    bf16_t* Q; float* RSUM;
    __device__ __forceinline__ void operator()(const f32x4 (&acc)[2][2][4][2], const Unit& u, int wr, int wc, int fr, int fq) const {
#pragma unroll
        for (int ai = 0; ai < 2; ++ai)
#pragma unroll
            for (int m = 0; m < 4; ++m) {
                const int row = u.pm * 256 + ai * 128 + wr * 64 + m * 16 + fr; float rs = 0.f;
#pragma unroll
                for (int bj = 0; bj < 2; ++bj)
#pragma unroll
                    for (int n = 0; n < 2; ++n) {
                        const f32x4 s = acc[ai][bj][m][n]; f32x4 e;
#pragma unroll
                        for (int j = 0; j < 4; ++j) e[j] = __builtin_amdgcn_exp2f(1.44269504089f * s[j]);
                        const u32x2 w = pk4(e); const f32x4 er = unpk4(w); rs += (er[0] + er[1]) + (er[2] + er[3]);
                        *(u32x2*)(Q + (size_t)row * 1024 + u.pn * 256 + bj * 128 + wc * 32 + n * 16 + fq * 4) = w;
                    }
                rs += __shfl_xor(rs, 16); rs += __shfl_xor(rs, 32);
                if (fq == 0) unsafeAtomicAdd(RSUM + row * 4 + u.pn, rs);
            }
    }
};
struct EpiPV {
    const bf16_t* SZXN; bf16_t* HX; const float* RSUM;
    __device__ __forceinline__ void operator()(const f32x4 (&acc)[2][2][4][2], const Unit& u, int wr, int wc, int fr, int fq) const {
        const int w4 = wr * 4 + wc, lane = fq * 16 + fr;
#pragma unroll
        for (int ai = 0; ai < 2; ++ai) {
            u32x2 z[4][2][2]; float rs[4];
#pragma unroll
            for (int m = 0; m < 4; ++m) {
                rs[m] = RSUM[(u.pm * 256 + ai * 128 + wr * 64 + m * 16 + fr) * 4 + u.pn];
#pragma unroll
                for (int bj = 0; bj < 2; ++bj)
#pragma unroll
                    for (int n = 0; n < 2; ++n) z[m][bj][n] = ((const u32x2*)SZXN)[native_slot(u.pm, u.pn, w4, ai, m, bj, n, lane)];
            }
#pragma unroll
            for (int m = 0; m < 4; ++m) {
                const int row = u.pm * 256 + ai * 128 + wr * 64 + m * 16 + fr; const float inv = __builtin_amdgcn_rcpf(rs[m]);
#pragma unroll
                for (int bj = 0; bj < 2; ++bj)
#pragma unroll
                    for (int n = 0; n < 2; ++n)
                        *(u32x2*)(HX + (size_t)row * 1024 + u.pn * 256 + bj * 128 + wc * 32 + n * 16 + fq * 4) = pk4(unpk4(z[m][bj][n]) * (acc[ai][bj][m][n] * inv));
            }
        }
    }
};
__device__ __forceinline__ void ld8(u32x2 (&d)[8], const u32x2* p) {
    asm volatile("global_load_dwordx2 %0, %1, off"             : "=v"(d[0]) : "v"(p) : "memory");
    asm volatile("global_load_dwordx2 %0, %1, off offset:512"  : "=v"(d[1]) : "v"(p) : "memory");
    asm volatile("global_load_dwordx2 %0, %1, off offset:1024" : "=v"(d[2]) : "v"(p) : "memory");
    asm volatile("global_load_dwordx2 %0, %1, off offset:1536" : "=v"(d[3]) : "v"(p) : "memory");
    asm volatile("global_load_dwordx2 %0, %1, off offset:2048" : "=v"(d[4]) : "v"(p) : "memory");
    asm volatile("global_load_dwordx2 %0, %1, off offset:2560" : "=v"(d[5]) : "v"(p) : "memory");
    asm volatile("global_load_dwordx2 %0, %1, off offset:3072" : "=v"(d[6]) : "v"(p) : "memory");
    asm volatile("global_load_dwordx2 %0, %1, off offset:3584" : "=v"(d[7]) : "v"(p) : "memory");
}
__device__ __forceinline__ void tie8(u32x2 (&d)[8]) { asm volatile("" : "+v"(d[0]), "+v"(d[1]), "+v"(d[2]), "+v"(d[3]), "+v"(d[4]), "+v"(d[5]), "+v"(d[6]), "+v"(d[7])); }

struct EpiOut {
    const bf16_t *SGA, *SGB, *SGX; bf16_t* PART; bf16_t* MERGED;
    template <int G> __device__ __forceinline__ void run(const f32x4 (&acc)[2][2][4][2], const Unit& u, const bf16_t* SG, int wr, int wc, int fr, int fq) const {
        const int w4 = wr * 4 + wc, lane = fq * 16 + fr;
        const size_t base0 = native_slot(u.pm, u.pn, w4, 0, 0, 0, 0, lane);
        const u32x2* sg = (const u32x2*)SG + base0; u32x2* part = (u32x2*)PART + base0;
        u32x2 gA[2][8], pA[2][8], gB[2][8], pB[2][8], rs[16];
        ld8(gA[0], sg); ld8(gA[1], sg + 512); if (G > 0) { ld8(pA[0], part); ld8(pA[1], part + 512); }
        asm volatile("s_waitcnt vmcnt(0)" ::: "memory");
        tie8(gA[0]); tie8(gA[1]); if (G > 0) { tie8(pA[0]); tie8(pA[1]); }
#pragma unroll
        for (int k = 0; k < 16; ++k) { const int m = k >> 2, bj = (k >> 1) & 1, n = k & 1;
            f32x4 t = unpk4(gA[k >> 3][k & 7]) * acc[0][bj][m][n]; if (G > 0) t += unpk4(pA[k >> 3][k & 7]); rs[k] = pk4(t); }
        ld8(gB[0], sg + 1024); ld8(gB[1], sg + 1536); if (G > 0) { ld8(pB[0], part + 1024); ld8(pB[1], part + 1536); }
#pragma unroll
        for (int k = 0; k < 16; ++k) { const int m = k >> 2, bj = (k >> 1) & 1, n = k & 1;
            if (G < 2) part[k * 64] = rs[k];
            else *(u32x2*)(MERGED + (size_t)(u.pm * 256 + wr * 64 + m * 16 + fr) * 1024 + u.pn * 256 + bj * 128 + wc * 32 + n * 16 + fq * 4) = rs[k]; }
        asm volatile("s_waitcnt vmcnt(8)" ::: "memory");
        tie8(gB[0]); tie8(gB[1]); if (G > 0) { tie8(pB[0]); tie8(pB[1]); }
#pragma unroll
        for (int k = 0; k < 16; ++k) { const int m = k >> 2, bj = (k >> 1) & 1, n = k & 1;
            f32x4 t = unpk4(gB[k >> 3][k & 7]) * acc[1][bj][m][n]; if (G > 0) t += unpk4(pB[k >> 3][k & 7]);
            if (G < 2) part[(16 + k) * 64] = pk4(t);
            else *(u32x2*)(MERGED + (size_t)(u.pm * 256 + 128 + wr * 64 + m * 16 + fr) * 1024 + u.pn * 256 + bj * 128 + wc * 32 + n * 16 + fq * 4) = pk4(t); }
    }
    __device__ __forceinline__ void operator()(const f32x4 (&acc)[2][2][4][2], const Unit& u, int wr, int wc, int fr, int fq) const {
        if (u.kind == 0) run<0>(acc, u, SGA, wr, wc, fr, fq);
        else if (u.kind == 1) run<1>(acc, u, SGB, wr, wc, fr, fq);
        else run<2>(acc, u, SGX, wr, wc, fr, fq);
    }
};
struct EpiWo {
    const float* X; bf16_t* HN; float* ROWSS;
    __device__ __forceinline__ void operator()(const f32x4 (&acc)[2][2][4][2], const Unit& u, int wr, int wc, int fr, int fq) const {
        const int w4 = wr * 4 + wc, lane = fq * 16 + fr;
#pragma unroll
        for (int ai = 0; ai < 2; ++ai) {
            f32x4 xv[4][2][2];
#pragma unroll
            for (int m = 0; m < 4; ++m)
#pragma unroll
                for (int bj = 0; bj < 2; ++bj)
#pragma unroll
                    for (int n = 0; n < 2; ++n)
                        xv[m][bj][n] = *(const f32x4*)(X + (size_t)(u.pm * 256 + ai * 128 + wr * 64 + m * 16 + fr) * 1024 + u.pn * 256 + bj * 128 + wc * 32 + n * 16 + fq * 4);
#pragma unroll
            for (int m = 0; m < 4; ++m) {
                const int row = u.pm * 256 + ai * 128 + wr * 64 + m * 16 + fr; float ss = 0.f;
#pragma unroll
                for (int bj = 0; bj < 2; ++bj)
#pragma unroll
                    for (int n = 0; n < 2; ++n) {
                        const u32x2 hw = pk4(xv[m][bj][n] + acc[ai][bj][m][n]); const f32x4 h = unpk4(hw);
                        ((u32x2*)HN)[native_slot(u.pm, u.pn, w4, ai, m, bj, n, lane)] = hw; ss += (h[0] * h[0] + h[1] * h[1]) + (h[2] * h[2] + h[3] * h[3]);
                    }
                ss += __shfl_xor(ss, 16); ss += __shfl_xor(ss, 32);
                if (fq == 0) unsafeAtomicAdd(ROWSS + row, ss);
            }
        }
    }
};

__device__ __forceinline__ int win_src_col(int R) {
    const int unit = R >> 8, rho = R & 255, kind = unit >> 4, cu = unit & 15;
    const int fqb = (rho >> 2) & 3;
    const int gi = ((rho >> 7) & 1) * 2 + ((rho >> 4) & 1), chl = ((rho >> 5) & 3) * 16 + (((fqb >> 1) | ((fqb & 1) << 1)) << 2) + (rho & 3);
    int base;
    if (kind == 0) base = gi * 1024;
    else if (kind == 1) base = (gi < 3) ? 4096 + gi * 1024 : 8192;
    else base = (gi == 0) ? 7168 : 9216 + (gi - 1) * 1024;
    return base + cu * 64 + chl;
}
__device__ __forceinline__ void p0_transpose_item(const float* W, int ldw, bf16_t* WT, int dst_row0, int k0, bool perm, LAS float* scr, int lane) {
    const int li = lane & 31; const int drow = dst_row0 + (perm ? ((li & 15) + ((li >> 4) << 5)) : li); const int scol = perm ? win_src_col(drow) : drow;
#pragma unroll
    for (int i = 0; i < 32; ++i) { const int kk = 2 * i + (lane >> 5); scr[kk * 33 + (lane & 31)] = W[(size_t)(k0 + kk) * ldw + scol]; }
    asm volatile("s_waitcnt lgkmcnt(0)" ::: "memory");
    const int c = lane & 7;
#pragma unroll
    for (int j = 0; j < 4; ++j) { const int n = (lane >> 3) + 8 * j; const LAS float* s = scr + (8 * c) * 33 + n;
        u32x4 o; o.x = pk_bf16(s[0 * 33], s[1 * 33]); o.y = pk_bf16(s[2 * 33], s[3 * 33]); o.z = pk_bf16(s[4 * 33], s[5 * 33]); o.w = pk_bf16(s[6 * 33], s[7 * 33]);
        const int orow = dst_row0 + (perm ? ((n & 15) + ((n >> 4) << 5)) : n);
        *(u32x4*)(WT + (size_t)orow * 1024 + k0 + 8 * c) = o; }
    asm volatile("s_waitcnt lgkmcnt(0)" ::: "memory");
}
__device__ __forceinline__ void rms_row_to_bf16(const float* xrow, const float* g, bf16_t* orow, int lane) {
    const f32x4* xr = (const f32x4*)xrow + lane; const f32x4* gr = (const f32x4*)g + lane;
    f32x4 v[4]; float s = 0.f;
#pragma unroll
    for (int j = 0; j < 4; ++j) { v[j] = xr[64 * j]; s += (v[j][0] * v[j][0] + v[j][1] * v[j][1]) + (v[j][2] * v[j][2] + v[j][3] * v[j][3]); }
    const float rstd = 1.0f / sqrtf(wave_sum(s) * (1.f / 1024.f) + EPS);
    u32x2* o8 = (u32x2*)orow + lane;
#pragma unroll
    for (int j = 0; j < 4; ++j) { const f32x4 gg = gr[64 * j]; o8[64 * j] = pk4(v[j] * rstd * gg); }
}

template <int PH>
__device__ __forceinline__ void conv31_chunk(LAS unsigned char* lds, LAS float* red, LAS float* stats, const bf16_t* GLU, bf16_t* SZB, const float* cw, const float* cb, const float* lng, const float* lnb,
                                            const int t0, const bool has_next, const int tid_in) {
    int tid_o = tid_in; asm volatile("" : "+v"(tid_o));
    const int tid = tid_o, lane = tid & 63, wid = tid >> 6, c2 = tid * 2;
    u32x4 nx[4];
    if (has_next) {
        int tf = tid; asm volatile("" : "+v"(tf));
#pragma unroll
        for (int q = 0; q < 4; ++q) { const int i = tf + q * 512; nx[q] = *(const u32x4*)(GLU + (size_t)(t0 + 16 + (i >> 7)) * 1024 + (i & 127) * 8); }
    }
    const f32x2 bias = *(const f32x2*)(cb + c2);
    f32x2 outv[16];
#pragma unroll
    for (int t = 0; t < 16; ++t) outv[t] = bias;
#pragma unroll
    for (int ps = 0; ps < 2; ++ps) {
        const int kb = ps * 16, ntap = ps == 0 ? 16 : 15;
        f32x2 w[16];
#pragma unroll
        for (int k = 0; k < 16; ++k) if (k < ntap) w[k] = *(const f32x2*)(cw + (kb + k) * 1024 + c2);
#pragma unroll
        for (int r = 0; r < 31; ++r) if (r < ntap + 15) {
            const unsigned v = *(const LAS unsigned*)(lds + ((34 + 16 * PH + kb + r) & 63) * 2048 + tid * 4);
            const f32x2 x = (f32x2){bf_lo(v), bf_hi(v)};
#pragma unroll
            for (int t = 0; t < 16; ++t) { const int k = r - t; if (k >= 0 && k < ntap) outv[t] = __builtin_elementwise_fma(w[k], x, outv[t]); }
            if ((r & 7) == 7) asm volatile("" ::: "memory");
        }
    }
    {
        float s[16], q[16];
#pragma unroll
        for (int t = 0; t < 16; ++t) { s[t] = outv[t][0] + outv[t][1]; q[t] = outv[t][0] * outv[t][0] + outv[t][1] * outv[t][1]; }
#pragma unroll
        for (int lvl = 0; lvl < 4; ++lvl) {
            const int half = 8 >> lvl, off = 32 >> lvl; const bool hi = (lane & off) != 0;
#pragma unroll
            for (int i = 0; i < half; ++i) {
                const float ks = hi ? s[i + half] : s[i], ss = hi ? s[i] : s[i + half]; s[i] = ks + __shfl_xor(ss, off);
                const float kq = hi ? q[i + half] : q[i], sq = hi ? q[i] : q[i + half]; q[i] = kq + __shfl_xor(sq, off);
            }
        }
        s[0] += __shfl_xor(s[0], 2); q[0] += __shfl_xor(q[0], 2);
        s[0] += __shfl_xor(s[0], 1); q[0] += __shfl_xor(q[0], 1);
        if ((lane & 3) == 0) *(LAS f32x2*)(red + ((lane >> 2) * 8 + wid) * 2) = (f32x2){s[0], q[0]};
    }
    __syncthreads();
    if (has_next) {
#pragma unroll
        for (int q = 0; q < 4; ++q) { const int i = tid + q * 512; *(LAS u32x4*)(lds + ((34 + 16 * PH + 46 + (i >> 7)) & 63) * 2048 + (i & 127) * 16) = nx[q]; }
    }
    if (tid < 16) {
        float S = 0.f, Q2 = 0.f;
#pragma unroll
        for (int wv = 0; wv < 8; ++wv) { const f32x2 t = *(const LAS f32x2*)(red + (tid * 8 + wv) * 2); S += t[0]; Q2 += t[1]; }
        const float mean = S * (1.f / 1024.f), var = fmaxf(Q2 * (1.f / 1024.f) - mean * mean, 0.f);
        *(LAS f32x2*)(stats + tid * 2) = (f32x2){mean, 1.0f / sqrtf(var + EPS)};
    }
    __syncthreads();
    const f32x2 lg = *(const f32x2*)(lng + c2), lb = *(const f32x2*)(lnb + c2);
    unsigned zz[16];
#pragma unroll
    for (int t = 0; t < 16; ++t) zz[t] = *(const unsigned*)(SZB + (size_t)(t0 + t) * 1024 + c2);
#pragma unroll
    for (int t = 0; t < 16; ++t) {
        const f32x2 st = *(const LAS f32x2*)(stats + t * 2);
        const float y0 = (outv[t][0] - st[0]) * st[1] * lg[0] + lb[0], y1 = (outv[t][1] - st[0]) * st[1] * lg[1] + lb[1];
        *(unsigned*)(SZB + (size_t)(t0 + t) * 1024 + c2) = pk_bf16(bf_lo(zz[t]) * siluf_(y0), bf_hi(zz[t]) * siluf_(y1));
    }
}
__device__ __forceinline__ void conv31_phase(LAS unsigned char* lds, const bf16_t* GLU, bf16_t* SZB, const float* cw, const float* cb, const float* lng, const float* lnb, int G, int c) {
    int tid_ = threadIdx.x; asm volatile("" : "+v"(tid_));
    const int tid = tid_;
    LAS float* red = (LAS float*)(lds + 131072 + 1024);
    LAS float* stats = (LAS float*)(lds + 131072 + 3072);
    for (int run = c; run < NTOK / 128; run += G) {
        const int T0 = run * 128, tpos = T0 & (SEQ - 1);
        __syncthreads();
#pragma unroll
        for (int h = 0; h < 2; ++h) {
            int tf = tid; asm volatile("" : "+v"(tf));
            u32x4 tv[6];
#pragma unroll
            for (int q = 0; q < 6; ++q) { const int i = tf + (h * 6 + q) * 512, r = (i >> 7) < 46 ? (i >> 7) : 45; const int gr = (tpos - 30 + r >= 0) ? (T0 - 30 + r) : T0;
                tv[q] = *(const u32x4*)(GLU + (size_t)gr * 1024 + (i & 127) * 8); }
#pragma unroll
            for (int q = 0; q < 6; ++q) { const int i = tf + (h * 6 + q) * 512, r = i >> 7;
                if (r < 46) *(LAS u32x4*)(lds + ((34 + r) & 63) * 2048 + (i & 127) * 16) = (tpos - 30 + r >= 0) ? tv[q] : (u32x4){0u, 0u, 0u, 0u}; }
        }
        __syncthreads();
        conv31_chunk<0>(lds, red, stats, GLU, SZB, cw, cb, lng, lnb, T0, true, tid);
        conv31_chunk<1>(lds, red, stats, GLU, SZB, cw, cb, lng, lnb, T0 + 16, true, tid);
        conv31_chunk<2>(lds, red, stats, GLU, SZB, cw, cb, lng, lnb, T0 + 32, true, tid);
        conv31_chunk<3>(lds, red, stats, GLU, SZB, cw, cb, lng, lnb, T0 + 48, true, tid);
        conv31_chunk<0>(lds, red, stats, GLU, SZB, cw, cb, lng, lnb, T0 + 64, true, tid);
        conv31_chunk<1>(lds, red, stats, GLU, SZB, cw, cb, lng, lnb, T0 + 80, true, tid);
        conv31_chunk<2>(lds, red, stats, GLU, SZB, cw, cb, lng, lnb, T0 + 96, true, tid);
        conv31_chunk<3>(lds, red, stats, GLU, SZB, cw, cb, lng, lnb, T0 + 112, false, tid);
    }
    __syncthreads();
}

__global__ void __launch_bounds__(512, 2) fwd_megakernel(Params p) {
    extern __shared__ __attribute__((aligned(16))) unsigned char lds_raw[];
    LAS unsigned char* lds = (LAS unsigned char*)lds_raw;
    const int G = gridDim.x, bx = blockIdx.x;
    unsigned char* ws = p.ws; unsigned char* ob = (unsigned char*)p.out;
    const float *x = p.in[0], *mem = p.in[1], *norm_g = p.in[2], *w_in = p.in[3], *conv_a_w = p.in[4], *w_out_a = p.in[5], *conv_b_w = p.in[6], *conv_b_b = p.in[7],
                *ln_b_g = p.in[8], *ln_b_b = p.in[9], *w_out_b = p.in[10], *mem_norm_g = p.in[11], *w_kv = p.in[12], *w_out_x = p.in[13], *w_o = p.in[14], *final_g = p.in[15];
    bf16_t *WIN = (bf16_t*)(ws + WS_WIN), *WOUT = (bf16_t*)(ws + WS_WOUT), *WO = (bf16_t*)(ws + WS_WO), *WKV = (bf16_t*)(ws + WS_WKV), *MEMN = (bf16_t*)(ws + WS_MEMN),
           *KB = (bf16_t*)(ws + WS_KB), *VT = (bf16_t*)(ws + WS_VT), *PAT = (bf16_t*)(ws + WS_PAT), *GAH = (bf16_t*)(ws + WS_GAH), *HA = (bf16_t*)(ws + WS_HA), *SZB = (bf16_t*)(ws + WS_SZB),
           *SZX = (bf16_t*)(ws + WS_SZX), *GLU = (bf16_t*)(ws + WS_GLU), *Q = (bf16_t*)(ws + WS_Q), *SGA = (bf16_t*)(ws + WS_SGA), *SGB = (bf16_t*)(ws + WS_SGB),
           *U = (bf16_t*)(ob + OUT_U), *SGX = (bf16_t*)(ob + OUT_SGX);
    float *ROWSS = (float*)(ws + WS_ROWSS), *RSUM = (float*)(ws + WS_RSUM);
    bf16_t* MERGED = GLU;
    volatile LAS unsigned* xst = (volatile LAS unsigned*)(lds + 131072 + 512);
    if (threadIdx.x < 4) xst[threadIdx.x] = 0u;
    __syncthreads();
    XcdBarrier xb = xcd_barrier_post((unsigned*)(ws + WS_BAR), xst);

    {
        int tid_ = threadIdx.x; asm volatile("" : "+v"(tid_)); const int tid = tid_, lane = tid & 63, wave = tid >> 6;
        LAS float* scr = (LAS float*)(lds + wave * 16384);
        const int gw = bx * 8 + wave, NGW = G * 8;
        for (int it = gw; it < 9216; it += NGW) {
            int r = it;
            if (r < 6144) { const int g = r % 384; p0_transpose_item(w_in, 12288, WIN, (g >> 1) * 64 + (g & 1) * 16, (r / 384) * 64, true, scr, lane); continue; } r -= 6144;
            if (r < 512) { p0_transpose_item(w_out_a, 1024, WOUT, (r & 31) * 32, (r >> 5) * 64, false, scr, lane); continue; } r -= 512;
            if (r < 512) { p0_transpose_item(w_out_b, 1024, WOUT + (size_t)1024 * 1024, (r & 31) * 32, (r >> 5) * 64, false, scr, lane); continue; } r -= 512;
            if (r < 512) { p0_transpose_item(w_out_x, 1024, WOUT + (size_t)2048 * 1024, (r & 31) * 32, (r >> 5) * 64, false, scr, lane); continue; } r -= 512;
            if (r < 512) { p0_transpose_item(w_o, 1024, WO, (r & 31) * 32, (r >> 5) * 64, false, scr, lane); continue; } r -= 512;
            p0_transpose_item(w_kv, 2048, WKV, (r & 63) * 32, (r >> 6) * 64, false, scr, lane);
        }
        {
            const f32x4* gr = (const f32x4*)norm_g + lane; f32x4 gg[4];
#pragma unroll
            for (int j = 0; j < 4; ++j) gg[j] = gr[64 * j];
            for (int m = gw; m < NTOK; m += 4 * NGW) {
                f32x4 v[4][4];
#pragma unroll
                for (int r = 0; r < 4; ++r) { const f32x4* xr = (const f32x4*)(x + (size_t)(m + r * NGW) * 1024) + lane;
#pragma unroll
                    for (int j = 0; j < 4; ++j) v[r][j] = xr[64 * j]; }
#pragma unroll
                for (int r = 0; r < 4; ++r) {
                    float sq = 0.f;
#pragma unroll
                    for (int j = 0; j < 4; ++j) sq += (v[r][j][0] * v[r][j][0] + v[r][j][1] * v[r][j][1]) + (v[r][j][2] * v[r][j][2] + v[r][j][3] * v[r][j][3]);
                    const float rstd = 1.0f / sqrtf(wave_sum(sq) * (1.f / 1024.f) + EPS);
                    u32x2* o8 = (u32x2*)(U + (size_t)(m + r * NGW) * 1024) + lane;
#pragma unroll
                    for (int j = 0; j < 4; ++j) o8[64 * j] = pk4(v[r][j] * rstd * gg[j]);
                }
            }
        }
        for (int m = gw; m < 1024; m += NGW) rms_row_to_bf16(mem + (size_t)m * 1024, mem_norm_g, MEMN + (size_t)m * 1024, lane);
        for (int i = bx * 512 + tid; i < NTOK * 5; i += G * 512) ROWSS[i] = 0.f;
    }
    GRID_SYNC();

    {
        SchedP1 S{(const char*)U, (const char*)WIN, (const char*)MEMN, (const char*)WKV, G, bx};
        EpiP1 E{HA, GLU, SZB, SZX, Q, SGA, SGB, SGX, KB, VT, PAT, GAH, conv_a_w};
        gemm_phase(lds, 1024, 1024, 1024, S, E);
    }
    GRID_SYNC();

    {
        int tid_ = threadIdx.x; asm volatile("" : "+v"(tid_)); const int tid = tid_;
        for (int i = bx * 512 + tid; i < 512 * 256; i += G * 512) {
            const int blk = i >> 8, ch = (i & 255) * 4;
            if ((blk & 127) != 0) {
                const f32x4 w0 = *(const f32x4*)(conv_a_w + ch), w1 = *(const f32x4*)(conv_a_w + 1024 + ch);
                const f32x4 pt0 = unpk4(*(const u32x2*)(PAT + (size_t)((blk - 1) * 2 + 0) * 1024 + ch)), pt1 = unpk4(*(const u32x2*)(PAT + (size_t)((blk - 1) * 2 + 1) * 1024 + ch));
                const f32x4 g0 = unpk4(*(const u32x2*)(GAH + (size_t)(blk * 2 + 0) * 1024 + ch)), g1 = unpk4(*(const u32x2*)(GAH + (size_t)(blk * 2 + 1) * 1024 + ch));
                u32x2* h0 = (u32x2*)(HA + (size_t)(blk * 64) * 1024 + ch); u32x2* h1 = (u32x2*)(HA + (size_t)(blk * 64 + 1) * 1024 + ch);
                *h0 = pk4(unpk4(*h0) + g0 * (w1 * pt1 + w0 * pt0));
                *h1 = pk4(unpk4(*h1) + g1 * (w0 * pt1));
            }
        }
        { SchedAttn S{(const char*)Q, (const char*)KB, TILE, (size_t)512, G, bx}; EpiS E{Q, RSUM}; gemm_phase(lds, 1024, 1024, 256, S, E); }
        conv31_phase(lds, GLU, SZB, conv_b_w, conv_b_b, ln_b_g, ln_b_b, G, bx);
    }
    asm volatile("s_waitcnt vmcnt(0) lgkmcnt(0)" ::: "memory"); __syncthreads();
    __builtin_amdgcn_fence(__ATOMIC_ACQUIRE, "agent"); asm volatile("s_waitcnt vmcnt(0)" ::: "memory"); __syncthreads();

    { SchedAttn S{(const char*)Q, (const char*)VT, (size_t)1024 * 256 * 2, (size_t)256 * 256 * 2, G, bx}; EpiPV E{SZX, U  , RSUM}; gemm_phase(lds, 1024, 256, 256, S, E); }
    GRID_SYNC();

    { SchedOut S{(const char*)HA, (const char*)U, (const char*)WOUT, G, bx}; EpiOut E{SGA, SGB, SGX, Q  , MERGED}; gemm_phase(lds, 1024, 1024, 1024, S, E); }
    GRID_SYNC();

    { SchedWo S{(const char*)MERGED, (const char*)WO, G, bx}; EpiWo E{x, HA  , ROWSS}; gemm_phase(lds, 1024, 1024, 1024, S, E); }
    GRID_SYNC();

    {
        int tid_ = threadIdx.x; asm volatile("" : "+v"(tid_)); const int lane = tid_ & 63, w4 = tid_ >> 6, wr = w4 >> 2, wc = w4 & 3, fr = lane & 15, fq = lane >> 4;
        for (int L = bx; L < 512; L += G) {
            const int pm = L >> 2, pn = L & 3;
#pragma unroll
            for (int ai = 0; ai < 2; ++ai) {
                u32x2 hv[4][2][2]; float rs[4]; f32x4 gg[2][2];
#pragma unroll
                for (int m = 0; m < 4; ++m) {
                    rs[m] = ROWSS[pm * 256 + ai * 128 + wr * 64 + m * 16 + fr];
#pragma unroll
                    for (int bj = 0; bj < 2; ++bj)
#pragma unroll
                        for (int n = 0; n < 2; ++n) hv[m][bj][n] = ((const u32x2*)HA)[native_slot(pm, pn, w4, ai, m, bj, n, fq * 16 + fr)];
                }
#pragma unroll
                for (int bj = 0; bj < 2; ++bj)
#pragma unroll
                    for (int n = 0; n < 2; ++n) gg[bj][n] = *(const f32x4*)(final_g + pn * 256 + bj * 128 + wc * 32 + n * 16 + fq * 4);
#pragma unroll
                for (int m = 0; m < 4; ++m) {
                    const float rstd = 1.0f / sqrtf(rs[m] * (1.f / 1024.f) + EPS);
#pragma unroll
                    for (int bj = 0; bj < 2; ++bj)
#pragma unroll
                        for (int n = 0; n < 2; ++n)
                            *(f32x4*)(p.out + (size_t)(pm * 256 + ai * 128 + wr * 64 + m * 16 + fr) * 1024 + pn * 256 + bj * 128 + wc * 32 + n * 16 + fq * 4) = unpk4(hv[m][bj][n]) * rstd * gg[bj][n];
                }
            }
        }
    }
}

extern "C" void kernel_launch(void* const* d_in, const int* in_sizes, int n_in, void* d_out, int out_size, void* d_ws, size_t ws_size, hipStream_t stream) {
    static int grid_blocks = 0;
    if (!grid_blocks) {
        int dev = 0, cus = 0, per_cu = 0;
        hipGetDevice(&dev);
        hipDeviceGetAttribute(&cus, hipDeviceAttributeMultiprocessorCount, dev);
        hipFuncSetAttribute((const void*)fwd_megakernel, hipFuncAttributeMaxDynamicSharedMemorySize, LDS_BYTES);
        hipOccupancyMaxActiveBlocksPerMultiprocessor(&per_cu, (const void*)fwd_megakernel, 512, LDS_BYTES);
        if (per_cu < 1) { fprintf(stderr, "kernel_launch: occupancy query reports %d blocks per CU\n", per_cu); per_cu = 1; }
        if (per_cu > 1) per_cu = 1;
        grid_blocks = cus * per_cu;
        if (ws_size < WS_END) fprintf(stderr, "kernel_launch: workspace too small: %zu < %zu\n", ws_size, (size_t)WS_END);
    }
    (void)hipMemsetAsync((char*)d_ws + WS_BAR, 0, XCD_BAR_WORDS * 4, stream);
    if (ws_size < WS_END) return;
    Params p{};
    for (int i = 0; i < 16; ++i) p.in[i] = (const float*)d_in[i];
    p.out = (float*)d_out; p.ws = (unsigned char*)d_ws;
    void* args[] = {&p};
    hipError_t e = hipLaunchCooperativeKernel((const void*)fwd_megakernel, dim3(grid_blocks), dim3(512), args, LDS_BYTES, stream);
    if (e != hipSuccess) fprintf(stderr, "cooperative launch failed: %s (grid %d)\n", hipGetErrorString(e), grid_blocks);
}
```

```cpp
#include <hip/hip_runtime.h>
#include <cstdio>

#define LAS __attribute__((address_space(3)))
typedef unsigned short bf16_t;
typedef short bf16x8 __attribute__((ext_vector_type(8)));
typedef float f32x4 __attribute__((ext_vector_type(4)));
typedef float f32x2 __attribute__((ext_vector_type(2)));
typedef unsigned u32x4 __attribute__((ext_vector_type(4)));
typedef unsigned u32x2 __attribute__((ext_vector_type(2)));

constexpr int BM = 256, BK = 64, HALF = 128, HTB = HALF * BK * 2, STAGE_BYTES = 8 * HTB;
constexpr int LDS_BYTES = 147456;
constexpr int NTOK = 32768, DM = 1024, SEQ = 8192;
constexpr float EPS = 1e-6f;
constexpr size_t MiB = 1u << 20;
constexpr size_t TILE = (size_t)256 * 1024 * 2;
constexpr size_t WS_WIN = 0, WS_WOUT = 24 * MiB, WS_WO = 30 * MiB, WS_WKV = 32 * MiB, WS_MEMN = 36 * MiB, WS_KB = 38 * MiB, WS_VT = 40 * MiB;
constexpr size_t WS_ROWSS = 42 * MiB, WS_RSUM = 42 * MiB + 131072, WS_PAT = 43 * MiB, WS_GAH = 45 * MiB;
constexpr size_t WS_BAR = 47 * MiB;
constexpr size_t WS_HA = 48 * MiB, WS_SZB = 112 * MiB, WS_SZX = 176 * MiB, WS_GLU = 240 * MiB, WS_Q = 304 * MiB, WS_SGA = 368 * MiB, WS_SGB = 432 * MiB, WS_END = 496 * MiB;
constexpr size_t OUT_U = 0, OUT_SGX = 64 * MiB;

#define XB_TMO      128
#define XB_XCNT(j)  (256  + 64 * (j))
#define XB_XSUB(j)  (1280 + 64 * (j))
#define XB_XGEN(j)  (2304 + 64 * (j))
#define XB_TOP      3328
#define XB_TOPGEN   3392
#define XCD_BAR_WORDS 3456
#define XB_SPIN_CAP (1u << 18)

__device__ __forceinline__ unsigned xb_ld(unsigned* p)              { return __hip_atomic_load(p, __ATOMIC_RELAXED, __HIP_MEMORY_SCOPE_AGENT); }
__device__ __forceinline__ unsigned xb_add(unsigned* p, unsigned v) { return __hip_atomic_fetch_add(p, v, __ATOMIC_RELAXED, __HIP_MEMORY_SCOPE_AGENT); }
__device__ __forceinline__ unsigned xb_xcc_id() { return (unsigned)__builtin_amdgcn_s_getreg((3 << 11) | 20) & 0xFu; }
#define XB_SPIN(cond, bar) do { unsigned _sp = 0; while (cond) { __builtin_amdgcn_s_sleep(1); \
    if ((++_sp & 255u) == 0u) { if (xb_ld(&(bar)[XB_TMO])) break; if (_sp > XB_SPIN_CAP) { atomicAdd(&(bar)[XB_TMO], 1u); break; } } } } while (0)

struct XcdBarrier {
    unsigned* bar; unsigned x;
    volatile LAS unsigned* st;
};

__device__ __forceinline__ XcdBarrier xcd_barrier_post(unsigned* bar, volatile LAS unsigned* st) {
    XcdBarrier b; b.bar = bar; b.x = xb_xcc_id(); b.st = st;
    if (threadIdx.x == 0) (void)xb_add(&bar[XB_XCNT(b.x)], 1u);
    return b;
}
__device__ __forceinline__ void xcd_barrier_complete(unsigned* bar, unsigned x, unsigned& nloc, unsigned& nx) {
    const unsigned G = gridDim.x * gridDim.y * gridDim.z;
    unsigned sum, cnt, mine, sp = 0u;
    for (;;) {
        sum = 0u; cnt = 0u; mine = 0u;
#pragma unroll
        for (unsigned j = 0; j < 16; ++j) { const unsigned c = xb_ld(&bar[XB_XCNT(j)]); sum += c; cnt += (c > 0u) ? 1u : 0u; mine = (j == x) ? c : mine; }
        if (sum == G) break;
        __builtin_amdgcn_s_sleep(1);
        if ((++sp & 255u) == 0u) { if (xb_ld(&bar[XB_TMO])) break; if (sp > XB_SPIN_CAP) { atomicAdd(&bar[XB_TMO], 1u); break; } }
    }
    nloc = mine > 0u ? mine : 1u; nx = cnt > 0u ? cnt : 1u;
}

__device__ __forceinline__ void xcd_barrier(const XcdBarrier& b) {
    asm volatile("s_waitcnt vmcnt(0)" ::: "memory");
    __syncthreads();
    if (threadIdx.x == 0) {
        unsigned* bar = b.bar;
        __builtin_amdgcn_s_waitcnt(0);
        unsigned nloc = b.st[0], nx = b.st[1];
        if (nloc == 0u) { xcd_barrier_complete(bar, b.x, nloc, nx); b.st[0] = nloc; b.st[1] = nx; }
        const unsigned old = xb_add(&bar[XB_XSUB(b.x)], 1u);
        const unsigned gen = old / nloc;
        if (old + 1u == (gen + 1u) * nloc) {
            __builtin_amdgcn_fence(__ATOMIC_RELEASE, "agent");
            asm volatile("s_waitcnt vmcnt(0)" ::: "memory");
            const unsigned og = xb_add(&bar[XB_TOP], 1u);
            const unsigned tg = og / nx;
            if (og + 1u == (tg + 1u) * nx) xb_add(&bar[XB_TOPGEN], 1u);
            else XB_SPIN(xb_ld(&bar[XB_TOPGEN]) == tg, bar);
            __builtin_amdgcn_fence(__ATOMIC_ACQUIRE, "agent");
            xb_add(&bar[XB_XGEN(b.x)], 1u);
            asm volatile("s_waitcnt vmcnt(0)" ::: "memory");
        } else {
            XB_SPIN(xb_ld(&bar[XB_XGEN(b.x)]) == gen, bar);
            __builtin_amdgcn_fence(__ATOMIC_ACQUIRE, "agent");
            asm volatile("s_waitcnt vmcnt(0)" ::: "memory");
        }
    }
    __syncthreads();
}

#define GRID_SYNC() xcd_barrier(xb)

struct Params { const float* in[16]; float* out; unsigned char* ws; };

typedef __bf16 bf16x2_t __attribute__((ext_vector_type(2)));
__device__ __forceinline__ unsigned pk_bf16(float lo, float hi) { const f32x2 v = {lo, hi}; return __builtin_bit_cast(unsigned, __builtin_convertvector(v, bf16x2_t)); }
__device__ __forceinline__ float bf_lo(unsigned u) { return __uint_as_float(u << 16); }
__device__ __forceinline__ float bf_hi(unsigned u) { return __uint_as_float(u & 0xffff0000u); }
__device__ __forceinline__ float sigmoidf_(float x) { return __builtin_amdgcn_rcpf(1.0f + __builtin_amdgcn_exp2f(-1.44269504089f * x)); }
__device__ __forceinline__ float siluf_(float x) { return x * sigmoidf_(x); }
__device__ __forceinline__ u32x2 pk4(f32x4 v) { u32x2 r; r.x = pk_bf16(v[0], v[1]); r.y = pk_bf16(v[2], v[3]); return r; }
__device__ __forceinline__ f32x4 unpk4(u32x2 v) { return (f32x4){bf_lo(v.x), bf_hi(v.x), bf_lo(v.y), bf_hi(v.y)}; }
template <int CTRL> __device__ __forceinline__ float dppf(float old, float v) { return __int_as_float(__builtin_amdgcn_update_dpp(__float_as_int(old), __float_as_int(v), CTRL, 0xf, 0xf, false)); }
__device__ __forceinline__ float wave_sum(float v) {
#pragma unroll
    for (int o = 1; o < 64; o <<= 1) v += __shfl_xor(v, o);
    return v;
}

__device__ __forceinline__ int lds_byte(int r, int c) { const int st = (r >> 4) * 2 + (c >> 5), rr = r & 15, cc = c & 31, ob = rr * 64 + cc * 2; return st * 1024 + (ob ^ (((ob >> 9) & 1) << 5)); }
__device__ __forceinline__ void stage_rc(int b, int& R, int& C) { const int st = b / 1024, sb = b % 1024, swz = sb ^ (((sb >> 9) & 1) << 5); R = (st >> 1) * 16 + swz / 64; C = (st & 1) * 32 + (swz % 64) / 2; }

struct Unit { const char* A; const char* B; int pm, pn, kind; };
__device__ __forceinline__ size_t native_slot(int pm, int pn4, int w4, int ai, int m, int bj, int n, int lane) {
    return ((((size_t)(pm * 4 + pn4) * 8 + w4) * 32 + (((ai * 4 + m) * 2 + bj) * 2 + n)) * 64 + lane);
}

template <int WG = 8> __device__ __forceinline__ void remap_tile(int L, int nM, int nN, int& pm, int& pn) {
    const int nwg = nM * nN; int wgid = L;
    { const int q = nwg / 8, r = nwg % 8, xcd = wgid % 8, off = wgid / 8; wgid = (xcd < r ? xcd * (q + 1) : r * (q + 1) + (xcd - r) * q) + off; }
    const int nig = WG * nN, gid = wgid / nig, fm = gid * WG, gsz = (nM - fm) < WG ? (nM - fm) : WG;
    pm = fm + ((wgid % nig) % gsz); pn = (wgid % nig) / gsz;
}

template <class Epi, class Sched>
__device__ __forceinline__ void gemm_phase(LAS unsigned char* lds, const int lda, const int ldb, const int K, const Sched& S, const Epi& E) {
    int tid_ = threadIdx.x; asm volatile("" : "+v"(tid_));
    const int tid = tid_, wid = __builtin_amdgcn_readfirstlane(tid >> 6), lane = tid & 63, wr = wid >> 2, wc = wid & 3, fr = lane & 15, fq = lane >> 4;
    const int nt = K / BK;
    unsigned voffA[2], voffB[2];
#pragma unroll
    for (int i = 0; i < 2; ++i) { int R, C; stage_rc(tid * 16 + i * 8192, R, C); voffA[i] = (unsigned)(R * lda + C) * 2u; voffB[i] = (unsigned)(R * ldb + C) * 2u; }
    const size_t kstep = (size_t)(BK * 2);
    const size_t hstepA = (size_t)HALF * lda * 2, hstepB = (size_t)HALF * ldb * 2;
    const unsigned ldsw = (unsigned)wid * 1024u;
    const int aoff = lds_byte(wr * 64 + fr, fq * 8), boff = lds_byte(wc * 32 + fr, fq * 8);
#define GP_SA(b, h) (((b) * 2 + (h)) * HTB)
#define GP_SB(b, h) ((4 + (b) * 2 + (h)) * HTB)
#define GP_STAGE(bufoff, gbase, voff) do { _Pragma("unroll") for (int _i = 0; _i < 2; ++_i) \
        __builtin_amdgcn_global_load_lds((const unsigned*)((const char*)(gbase) + (voff)[_i]), (LAS unsigned*)(lds + (bufoff) + ldsw + _i * 8192), 16, 0, 0); } while (0)
#define GP_LDA(dst, b, h) do { _Pragma("unroll") for (int m = 0; m < 4; ++m) _Pragma("unroll") for (int k = 0; k < 2; ++k) dst[m][k] = *(const LAS bf16x8*)(lds + GP_SA(b, h) + aoff + m * 2048 + k * 1024); } while (0)
#define GP_LDB(dst, b, h) do { _Pragma("unroll") for (int n = 0; n < 2; ++n) _Pragma("unroll") for (int k = 0; k < 2; ++k) dst[n][k] = *(const LAS bf16x8*)(lds + GP_SB(b, h) + boff + n * 2048 + k * 1024); } while (0)
#define GP_MMA(ai, bj, At, Bt) do { __builtin_amdgcn_s_setprio(1); _Pragma("unroll") for (int m = 0; m < 4; ++m) _Pragma("unroll") for (int n = 0; n < 2; ++n) _Pragma("unroll") for (int k = 0; k < 2; ++k) \
        acc[ai][bj][m][n] = __builtin_amdgcn_mfma_f32_16x16x32_bf16(Bt[n][k], At[m][k], acc[ai][bj][m][n], 0, 0, 0); __builtin_amdgcn_s_setprio(0); } while (0)
#define GP_WAIT_V(n) asm volatile("s_waitcnt vmcnt(" #n ")" ::: "memory")
#define GP_WAIT_L(n) asm volatile("s_waitcnt lgkmcnt(" #n ")" ::: "memory")
#define GP_BAR __builtin_amdgcn_s_barrier()
#define GP_SCHED __builtin_amdgcn_sched_barrier(0)
    Unit cur, nxt; int ui = 0;
    if (!S.next(0, cur)) return;
    f32x4 acc[2][2][4][2];
#pragma unroll
    for (int a = 0; a < 2; ++a)
#pragma unroll
        for (int b = 0; b < 2; ++b)
#pragma unroll
            for (int m = 0; m < 4; ++m)
#pragma unroll
                for (int n = 0; n < 2; ++n) acc[a][b][m][n] = (f32x4){0.f, 0.f, 0.f, 0.f};
    bf16x8 At[4][2], B0[2][2], B1[2][2];
    const char* cA = cur.A; const char* cB = cur.B;
    GP_STAGE(GP_SB(0, 0), cB, voffB); GP_STAGE(GP_SB(0, 1), cB + hstepB, voffB); GP_STAGE(GP_SA(0, 0), cA, voffA); GP_STAGE(GP_SA(0, 1), cA + hstepA, voffA);
    if (wr == 1) GP_BAR;
    GP_WAIT_V(2); GP_BAR;
    GP_STAGE(GP_SB(1, 0), cB + kstep, voffB); GP_STAGE(GP_SA(1, 0), cA + kstep, voffA); GP_STAGE(GP_SB(1, 1), cB + hstepB + kstep, voffB);
    GP_WAIT_V(6); GP_BAR;
    for (;;) {
        const bool has_next = S.next(ui + 1, nxt);
        const char* nA = has_next ? nxt.A : cA; const char* nB = has_next ? nxt.B : cB;
        for (int t = 0; t < nt; t += 2) {
            const bool last = (t == nt - 2);
            const char* a1 = cA + (size_t)(t + 1) * kstep;
            const char* a2 = last ? nA : cA + (size_t)(t + 2) * kstep; const char* b2 = last ? nB : cB + (size_t)(t + 2) * kstep;
            const char* a3 = a2 + kstep; const char* b3 = b2 + kstep;
            GP_LDB(B0, 0, 0); GP_LDB(B1, 0, 1); GP_SCHED; GP_LDA(At, 0, 0); GP_STAGE(GP_SA(1, 1), a1 + hstepA, voffA);
            GP_WAIT_V(8); GP_WAIT_L(0); GP_BAR; GP_MMA(0, 0, At, B0); GP_MMA(0, 1, At, B1); GP_BAR; GP_SCHED;
            GP_LDA(At, 0, 1); GP_STAGE(GP_SB(0, 0), b2, voffB); GP_STAGE(GP_SB(0, 1), b2 + hstepB, voffB); GP_STAGE(GP_SA(0, 0), a2, voffA);
            GP_WAIT_V(8); GP_WAIT_L(0); GP_BAR; GP_MMA(1, 0, At, B0); GP_MMA(1, 1, At, B1); GP_BAR; GP_SCHED;
            GP_LDB(B0, 1, 0); GP_LDB(B1, 1, 1); GP_SCHED; GP_LDA(At, 1, 0); GP_STAGE(GP_SA(0, 1), a2 + hstepA, voffA);
            GP_WAIT_V(8); GP_WAIT_L(0); GP_BAR; GP_MMA(0, 0, At, B0); GP_MMA(0, 1, At, B1); GP_BAR; GP_SCHED;
            GP_LDA(At, 1, 1); GP_STAGE(GP_SB(1, 0), b3, voffB); GP_STAGE(GP_SB(1, 1), b3 + hstepB, voffB); GP_STAGE(GP_SA(1, 0), a3, voffA);
            GP_WAIT_V(8); GP_WAIT_L(0); GP_BAR; GP_MMA(1, 0, At, B0); GP_MMA(1, 1, At, B1); GP_BAR; GP_SCHED;
        }
        if (wr == 0) GP_BAR;
        E(acc, cur, wr, wc, fr, fq);
        if (!has_next) break;
#pragma unroll
        for (int a = 0; a < 2; ++a)
#pragma unroll
            for (int b = 0; b < 2; ++b)
#pragma unroll
                for (int m = 0; m < 4; ++m)
#pragma unroll
                    for (int n = 0; n < 2; ++n) acc[a][b][m][n] = (f32x4){0.f, 0.f, 0.f, 0.f};
        cur = nxt; cA = nA; cB = nB; ++ui;
        if (wr == 1) GP_BAR;
    }
    GP_WAIT_V(0);
    GP_BAR;
#undef GP_SA
#undef GP_SB
#undef GP_STAGE
#undef GP_LDA
#undef GP_LDB
#undef GP_MMA
#undef GP_WAIT_V
#undef GP_WAIT_L
#undef GP_BAR
#undef GP_SCHED
}

struct SchedP1 {
    const char *U, *Win, *Memn, *Wkv; int G, c;
    __device__ __forceinline__ bool next(int i, Unit& u) const {
        if (G == 256) {
            if (i < 24) { const int l = i * 32 + (c >> 3); int pm = l / 6, pn = 6 * (c & 7) + l % 6; pn = (pn % 3) * 16 + pn / 3;
                u.pm = pm; u.pn = pn; u.kind = pn >> 4; u.A = U + (size_t)pm * TILE; u.B = Win + (size_t)pn * TILE; return true; }
            if (i > 24 || c >= 32) return false;
            int L = c;
            if (L < 16) { u.pm = L >> 2; u.pn = L & 3; u.kind = 3; u.A = Memn + (size_t)u.pm * TILE; u.B = Wkv + (size_t)u.pn * TILE; }
            else { L -= 16; u.pm = L >> 2; u.pn = L & 3; u.kind = 4; u.A = Wkv + (size_t)(4 + u.pm) * TILE; u.B = Memn + (size_t)u.pn * TILE; }
            return true;
        }
        int L = i * G + c;
        if (L < 6144) { int pm, pn; remap_tile<4>(L, 128, 48, pm, pn); pn = (pn % 3) * 16 + pn / 3; u.pm = pm; u.pn = pn; u.kind = pn >> 4; u.A = U + (size_t)pm * TILE; u.B = Win + (size_t)pn * TILE; return true; }
        L -= 6144; if (L >= 32) return false;
        if (L < 16) { u.pm = L >> 2; u.pn = L & 3; u.kind = 3; u.A = Memn + (size_t)u.pm * TILE; u.B = Wkv + (size_t)u.pn * TILE; }
        else { L -= 16; u.pm = L >> 2; u.pn = L & 3; u.kind = 4; u.A = Wkv + (size_t)(4 + u.pm) * TILE; u.B = Memn + (size_t)u.pn * TILE; }
        return true;
    }
};
struct SchedAttn {
    const char *Aq, *Bm; size_t bstride_b, bstride_h; int G, c;
    __device__ __forceinline__ bool next(int i, Unit& u) const {
        const int L = i * G + c; if (L >= 512) return false;
        u.pm = L >> 2; u.pn = L & 3; u.kind = 0;
        u.A = Aq + (size_t)u.pm * TILE + (size_t)u.pn * 512; u.B = Bm + (size_t)(u.pm >> 5) * bstride_b + (size_t)u.pn * bstride_h; return true;
    }
};
struct SchedOut {
    const char *H, *HXp, *W; int G, c;
    __device__ __forceinline__ bool next(int i, Unit& u) const {
        const int ti = i / 3, g = i - 3 * ti; const int L = ti * G + c; if (L >= 512) return false;
        int pm, pn; remap_tile(L, 128, 4, pm, pn); u.pm = pm; u.pn = pn; u.kind = g;
        if (g == 2) u.A = HXp + (size_t)pm * TILE; else u.A = H + ((size_t)g * 128 + pm) * TILE;
        u.B = W + ((size_t)g * 4 + pn) * TILE; return true;
    }
};
struct SchedWo {
    const char *A, *W; int G, c;
    __device__ __forceinline__ bool next(int i, Unit& u) const {
        const int L = i * G + c; if (L >= 512) return false;
        int pm, pn; remap_tile(L, 128, 4, pm, pn); u.pm = pm; u.pn = pn; u.kind = 0; u.A = A + (size_t)pm * TILE; u.B = W + (size_t)pn * TILE; return true;
    }
};

__device__ __forceinline__ int pf(int fq) { return (fq >> 1) | ((fq & 1) << 1); }
__device__ __forceinline__ void store_pair16(bf16_t* rowbase  , u32x2 a  , u32x2 b  , int fq) {
    const auto rx = __builtin_amdgcn_permlane32_swap(a.x, b.x, false, false), ry = __builtin_amdgcn_permlane32_swap(a.y, b.y, false, false);
    *(u32x4*)(rowbase + (size_t)((fq >> 1) * 16) * 1024 + (fq & 1) * 8) = (u32x4){rx[0], ry[0], rx[1], ry[1]};
}
struct EpiP1 {
    bf16_t *HA, *GLU, *SZB, *SZX, *Q, *SGA, *SGB, *SGX, *KB, *VT, *PAT, *GAH; const float* convw;
    __device__ __forceinline__ void operator()(const f32x4 (&acc)[2][2][4][2], const Unit& u, int wr, int wc, int fr, int fq) const {
        if (u.kind <= 2) {
            const int chw = (u.pn & 15) * 64 + wc * 16, ch = chw + pf(fq) * 4;
            const int rowb = u.pm * 256 + wr * 64 + fr;
            if (u.kind == 0) {
                const f32x4 w0 = *(const f32x4*)(convw + ch), w1 = *(const f32x4*)(convw + 1024 + ch), w2 = *(const f32x4*)(convw + 2048 + ch);
#pragma unroll
                for (int ai = 0; ai < 2; ++ai) {
                    const int blk = u.pm * 4 + ai * 2 + wr;
                    f32x4 pprev = (f32x4){0.f, 0.f, 0.f, 0.f}; u32x2 hv[4];
#pragma unroll
                    for (int m = 0; m < 4; ++m) {
                        const f32x4 Bv = acc[ai][0][m][0], Cv = acc[ai][0][m][1], Xv = acc[ai][1][m][0], Zv = acc[ai][1][m][1];
                        const f32x4 p = Cv * Xv; f32x4 ga, p1, p2;
#pragma unroll
                        for (int j = 0; j < 4; ++j) {
                            ga[j] = siluf_(Zv[j]) * Bv[j];
                            const float r1 = (m > 0) ? dppf<0x121>(0.f, pprev[j]) : 0.f, r2 = (m > 0) ? dppf<0x122>(0.f, pprev[j]) : 0.f;
                            p1[j] = dppf<0x111>(r1, p[j]); p2[j] = dppf<0x112>(r2, p[j]);
                        }
                        const f32x4 cv = w2 * p + w1 * p1 + w0 * p2;
                        hv[m] = pk4(ga * cv);
                        if (m == 3 && fr >= 14) *(u32x2*)(PAT + (size_t)(blk * 2 + (fr - 14)) * 1024 + ch) = pk4(p);
                        if (m == 0 && fr < 2) *(u32x2*)(GAH + (size_t)(blk * 2 + fr) * 1024 + ch) = pk4(ga);
                        pprev = p;
                    }
#pragma unroll
                    for (int pr = 0; pr < 2; ++pr) store_pair16(HA + (size_t)(rowb + ai * 128 + pr * 32) * 1024 + chw, hv[2 * pr], hv[2 * pr + 1], fq);
                }
            } else if (u.kind == 1) {
#pragma unroll
                for (int ai = 0; ai < 2; ++ai) {
                    u32x2 gv[4], zv[4];
#pragma unroll
                    for (int m = 0; m < 4; ++m) {
                        const f32x4 Vv = acc[ai][0][m][0], Gv = acc[ai][0][m][1], Zb = acc[ai][1][m][0], Zx = acc[ai][1][m][1]; f32x4 o0, o1, o2;
#pragma unroll
                        for (int j = 0; j < 4; ++j) { o0[j] = Vv[j] * sigmoidf_(Gv[j]); o1[j] = siluf_(Zb[j]); o2[j] = siluf_(Zx[j]); }
                        gv[m] = pk4(o0); zv[m] = pk4(o1);
                        { const int c = (u.pn & 3) * 64 + wc * 16;
                          ((u32x2*)SZX)[native_slot(u.pm, (u.pn & 15) >> 2, wr * 4 + ((c >> 5) & 3), ai, m, c >> 7, (c >> 4) & 1, pf(fq) * 16 + fr)] = pk4(o2); }
                    }
#pragma unroll
                    for (int pr = 0; pr < 2; ++pr) {
                        store_pair16(GLU + (size_t)(rowb + ai * 128 + pr * 32) * 1024 + chw, gv[2 * pr], gv[2 * pr + 1], fq);
                        store_pair16(SZB + (size_t)(rowb + ai * 128 + pr * 32) * 1024 + chw, zv[2 * pr], zv[2 * pr + 1], fq);
                    }
                }
            } else {
#pragma unroll
                for (int ai = 0; ai < 2; ++ai) {
                    u32x2 qv[4];
#pragma unroll
                    for (int m = 0; m < 4; ++m) {
                        const f32x4 Qv = acc[ai][0][m][0], Ga = acc[ai][0][m][1], Gb = acc[ai][1][m][0], Gx = acc[ai][1][m][1]; f32x4 o1, o2, o3;
#pragma unroll
                        for (int j = 0; j < 4; ++j) { o1[j] = sigmoidf_(Ga[j]); o2[j] = sigmoidf_(Gb[j]); o3[j] = sigmoidf_(Gx[j]); }
                        qv[m] = pk4(Qv * 0.0625f);
                        const int c = (u.pn & 3) * 64 + wc * 16;
                        const size_t ns = native_slot(u.pm, (u.pn & 15) >> 2, wr * 4 + ((c >> 5) & 3), ai, m, c >> 7, (c >> 4) & 1, pf(fq) * 16 + fr);
                        ((u32x2*)SGA)[ns] = pk4(o1); ((u32x2*)SGB)[ns] = pk4(o2); ((u32x2*)SGX)[ns] = pk4(o3);
                    }
#pragma unroll
                    for (int pr = 0; pr < 2; ++pr) store_pair16(Q + (size_t)(rowb + ai * 128 + pr * 32) * 1024 + chw, qv[2 * pr], qv[2 * pr + 1], fq);
                }
            }
        } else {
            const int r0 = wr * 64 + fr, c0 = wc * 32 + fq * 4;
#pragma unroll
            for (int ai = 0; ai < 2; ++ai)
#pragma unroll
                for (int m = 0; m < 4; ++m)
#pragma unroll
                    for (int bj = 0; bj < 2; ++bj)
#pragma unroll
                        for (int n = 0; n < 2; ++n) {
                            const int r = r0 + ai * 128 + m * 16, c = c0 + bj * 128 + n * 16;
                            if (u.kind == 3) *(u32x2*)(KB + (size_t)(u.pm * 256 + r) * 1024 + u.pn * 256 + c) = pk4(acc[ai][bj][m][n]);
                            else             *(u32x2*)(VT + ((size_t)u.pn * 1024 + u.pm * 256 + r) * 256 + c) = pk4(acc[ai][bj][m][n]);
                        }
        }
    }
};
struct EpiS {
    bf16_t* Q; float* RSUM;
    __device__ __forceinline__ void operator()(const f32x4 (&acc)[2][2][4][2], const Unit& u, int wr, int wc, int fr, int fq) const {
#pragma unroll
        for (int ai = 0; ai < 2; ++ai)
#pragma unroll
            for (int m = 0; m < 4; ++m) {
                const int row = u.pm * 256 + ai * 128 + wr * 64 + m * 16 + fr; float rs = 0.f;
#pragma unroll
                for (int bj = 0; bj < 2; ++bj)
#pragma unroll
                    for (int n = 0; n < 2; ++n) {
                        const f32x4 s = acc[ai][bj][m][n]; f32x4 e;
#pragma unroll
                        for (int j = 0; j < 4; ++j) e[j] = __builtin_amdgcn_exp2f(1.44269504089f * s[j]);
                        const u32x2 w = pk4(e); const f32x4 er = unpk4(w); rs += (er[0] + er[1]) + (er[2] + er[3]);
                        *(u32x2*)(Q + (size_t)row * 1024 + u.pn * 256 + bj * 128 + wc * 32 + n * 16 + fq * 4) = w;
                    }
                rs += __shfl_xor(rs, 16); rs += __shfl_xor(rs, 32);
                if (fq == 0) unsafeAtomicAdd(RSUM + row * 4 + u.pn, rs);
            }
    }
};
struct EpiPV {
    const bf16_t* SZXN; bf16_t* HX; const float* RSUM;
    __device__ __forceinline__ void operator()(const f32x4 (&acc)[2][2][4][2], const Unit& u, int wr, int wc, int fr, int fq) const {
        const int w4 = wr * 4 + wc, lane = fq * 16 + fr;
#pragma unroll
        for (int ai = 0; ai < 2; ++ai) {
            u32x2 z[4][2][2]; float rs[4];
#pragma unroll
            for (int m = 0; m < 4; ++m) {
                rs[m] = RSUM[(u.pm * 256 + ai * 128 + wr * 64 + m * 16 + fr) * 4 + u.pn];
#pragma unroll
                for (int bj = 0; bj < 2; ++bj)
#pragma unroll
                    for (int n = 0; n < 2; ++n) z[m][bj][n] = ((const u32x2*)SZXN)[native_slot(u.pm, u.pn, w4, ai, m, bj, n, lane)];
            }
#pragma unroll
            for (int m = 0; m < 4; ++m) {
                const int row = u.pm * 256 + ai * 128 + wr * 64 + m * 16 + fr; const float inv = __builtin_amdgcn_rcpf(rs[m]);
#pragma unroll
                for (int bj = 0; bj < 2; ++bj)
#pragma unroll
                    for (int n = 0; n < 2; ++n)
                        *(u32x2*)(HX + (size_t)row * 1024 + u.pn * 256 + bj * 128 + wc * 32 + n * 16 + fq * 4) = pk4(unpk4(z[m][bj][n]) * (acc[ai][bj][m][n] * inv));
            }
        }
    }
};
__device__ __forceinline__ void ld8(u32x2 (&d)[8], const u32x2* p) {
    asm volatile("global_load_dwordx2 %0, %1, off"             : "=v"(d[0]) : "v"(p) : "memory");
    asm volatile("global_load_dwordx2 %0, %1, off offset:512"  : "=v"(d[1]) : "v"(p) : "memory");
    asm volatile("global_load_dwordx2 %0, %1, off offset:1024" : "=v"(d[2]) : "v"(p) : "memory");
    asm volatile("global_load_dwordx2 %0, %1, off offset:1536" : "=v"(d[3]) : "v"(p) : "memory");
    asm volatile("global_load_dwordx2 %0, %1, off offset:2048" : "=v"(d[4]) : "v"(p) : "memory");
    asm volatile("global_load_dwordx2 %0, %1, off offset:2560" : "=v"(d[5]) : "v"(p) : "memory");
    asm volatile("global_load_dwordx2 %0, %1, off offset:3072" : "=v"(d[6]) : "v"(p) : "memory");
    asm volatile("global_load_dwordx2 %0, %1, off offset:3584" : "=v"(d[7]) : "v"(p) : "memory");
}
__device__ __forceinline__ void tie8(u32x2 (&d)[8]) { asm volatile("" : "+v"(d[0]), "+v"(d[1]), "+v"(d[2]), "+v"(d[3]), "+v"(d[4]), "+v"(d[5]), "+v"(d[6]), "+v"(d[7])); }

struct EpiOut {
    const bf16_t *SGA, *SGB, *SGX; bf16_t* PART; bf16_t* MERGED;
    template <int G> __device__ __forceinline__ void run(const f32x4 (&acc)[2][2][4][2], const Unit& u, const bf16_t* SG, int wr, int wc, int fr, int fq) const {
        const int w4 = wr * 4 + wc, lane = fq * 16 + fr;
        const size_t base0 = native_slot(u.pm, u.pn, w4, 0, 0, 0, 0, lane);
        const u32x2* sg = (const u32x2*)SG + base0; u32x2* part = (u32x2*)PART + base0;
        u32x2 gA[2][8], pA[2][8], gB[2][8], pB[2][8], rs[16];
        ld8(gA[0], sg); ld8(gA[1], sg + 512); if (G > 0) { ld8(pA[0], part); ld8(pA[1], part + 512); }
        asm volatile("s_waitcnt vmcnt(0)" ::: "memory");
        tie8(gA[0]); tie8(gA[1]); if (G > 0) { tie8(pA[0]); tie8(pA[1]); }
#pragma unroll
        for (int k = 0; k < 16; ++k) { const int m = k >> 2, bj = (k >> 1) & 1, n = k & 1;
            f32x4 t = unpk4(gA[k >> 3][k & 7]) * acc[0][bj][m][n]; if (G > 0) t += unpk4(pA[k >> 3][k & 7]); rs[k] = pk4(t); }
        ld8(gB[0], sg + 1024); ld8(gB[1], sg + 1536); if (G > 0) { ld8(pB[0], part + 1024); ld8(pB[1], part + 1536); }
#pragma unroll
        for (int k = 0; k < 16; ++k) { const int m = k >> 2, bj = (k >> 1) & 1, n = k & 1;
            if (G < 2) part[k * 64] = rs[k];
            else *(u32x2*)(MERGED + (size_t)(u.pm * 256 + wr * 64 + m * 16 + fr) * 1024 + u.pn * 256 + bj * 128 + wc * 32 + n * 16 + fq * 4) = rs[k]; }
        asm volatile("s_waitcnt vmcnt(8)" ::: "memory");
        tie8(gB[0]); tie8(gB[1]); if (G > 0) { tie8(pB[0]); tie8(pB[1]); }
#pragma unroll
        for (int k = 0; k < 16; ++k) { const int m = k >> 2, bj = (k >> 1) & 1, n = k & 1;
            f32x4 t = unpk4(gB[k >> 3][k & 7]) * acc[1][bj][m][n]; if (G > 0) t += unpk4(pB[k >> 3][k & 7]);
            if (G < 2) part[(16 + k) * 64] = pk4(t);
            else *(u32x2*)(MERGED + (size_t)(u.pm * 256 + 128 + wr * 64 + m * 16 + fr) * 1024 + u.pn * 256 + bj * 128 + wc * 32 + n * 16 + fq * 4) = pk4(t); }
    }
    __device__ __forceinline__ void operator()(const f32x4 (&acc)[2][2][4][2], const Unit& u, int wr, int wc, int fr, int fq) const {
        if (u.kind == 0) run<0>(acc, u, SGA, wr, wc, fr, fq);
        else if (u.kind == 1) run<1>(acc, u, SGB, wr, wc, fr, fq);
        else run<2>(acc, u, SGX, wr, wc, fr, fq);
    }
};
struct EpiWo {
    const float* X; bf16_t* HN; float* ROWSS;
    __device__ __forceinline__ void operator()(const f32x4 (&acc)[2][2][4][2], const Unit& u, int wr, int wc, int fr, int fq) const {
        const int w4 = wr * 4 + wc, lane = fq * 16 + fr;
#pragma unroll
        for (int ai = 0; ai < 2; ++ai) {
            f32x4 xv[4][2][2];
#pragma unroll
            for (int m = 0; m < 4; ++m)
#pragma unroll
                for (int bj = 0; bj < 2; ++bj)
#pragma unroll
                    for (int n = 0; n < 2; ++n)
                        xv[m][bj][n] = *(const f32x4*)(X + (size_t)(u.pm * 256 + ai * 128 + wr * 64 + m * 16 + fr) * 1024 + u.pn * 256 + bj * 128 + wc * 32 + n * 16 + fq * 4);
#pragma unroll
            for (int m = 0; m < 4; ++m) {
                const int row = u.pm * 256 + ai * 128 + wr * 64 + m * 16 + fr; float ss = 0.f;
#pragma unroll
                for (int bj = 0; bj < 2; ++bj)
#pragma unroll
                    for (int n = 0; n < 2; ++n) {
                        const u32x2 hw = pk4(xv[m][bj][n] + acc[ai][bj][m][n]); const f32x4 h = unpk4(hw);
                        ((u32x2*)HN)[native_slot(u.pm, u.pn, w4, ai, m, bj, n, lane)] = hw; ss += (h[0] * h[0] + h[1] * h[1]) + (h[2] * h[2] + h[3] * h[3]);
                    }
                ss += __shfl_xor(ss, 16); ss += __shfl_xor(ss, 32);
                if (fq == 0) unsafeAtomicAdd(ROWSS + row, ss);
            }
        }
    }
};

__device__ __forceinline__ int win_src_col(int R) {
    const int unit = R >> 8, rho = R & 255, kind = unit >> 4, cu = unit & 15;
    const int fqb = (rho >> 2) & 3;
    const int gi = ((rho >> 7) & 1) * 2 + ((rho >> 4) & 1), chl = ((rho >> 5) & 3) * 16 + (((fqb >> 1) | ((fqb & 1) << 1)) << 2) + (rho & 3);
    int base;
    if (kind == 0) base = gi * 1024;
    else if (kind == 1) base = (gi < 3) ? 4096 + gi * 1024 : 8192;
    else base = (gi == 0) ? 7168 : 9216 + (gi - 1) * 1024;
    return base + cu * 64 + chl;
}
__device__ __forceinline__ void p0_transpose_item(const float* W, int ldw, bf16_t* WT, int dst_row0, int k0, bool perm, LAS float* scr, int lane) {
    const int li = lane & 31; const int drow = dst_row0 + (perm ? ((li & 15) + ((li >> 4) << 5)) : li); const int scol = perm ? win_src_col(drow) : drow;
#pragma unroll
    for (int i = 0; i < 32; ++i) { const int kk = 2 * i + (lane >> 5); scr[kk * 33 + (lane & 31)] = W[(size_t)(k0 + kk) * ldw + scol]; }
    asm volatile("s_waitcnt lgkmcnt(0)" ::: "memory");
    const int c = lane & 7;
#pragma unroll
    for (int j = 0; j < 4; ++j) { const int n = (lane >> 3) + 8 * j; const LAS float* s = scr + (8 * c) * 33 + n;
        u32x4 o; o.x = pk_bf16(s[0 * 33], s[1 * 33]); o.y = pk_bf16(s[2 * 33], s[3 * 33]); o.z = pk_bf16(s[4 * 33], s[5 * 33]); o.w = pk_bf16(s[6 * 33], s[7 * 33]);
        const int orow = dst_row0 + (perm ? ((n & 15) + ((n >> 4) << 5)) : n);
        *(u32x4*)(WT + (size_t)orow * 1024 + k0 + 8 * c) = o; }
    asm volatile("s_waitcnt lgkmcnt(0)" ::: "memory");
}
__device__ __forceinline__ void rms_row_to_bf16(const float* xrow, const float* g, bf16_t* orow, int lane) {
    const f32x4* xr = (const f32x4*)xrow + lane; const f32x4* gr = (const f32x4*)g + lane;
    f32x4 v[4]; float s = 0.f;
#pragma unroll
    for (int j = 0; j < 4; ++j) { v[j] = xr[64 * j]; s += (v[j][0] * v[j][0] + v[j][1] * v[j][1]) + (v[j][2] * v[j][2] + v[j][3] * v[j][3]); }
    const float rstd = 1.0f / sqrtf(wave_sum(s) * (1.f / 1024.f) + EPS);
    u32x2* o8 = (u32x2*)orow + lane;
#pragma unroll
    for (int j = 0; j < 4; ++j) { const f32x4 gg = gr[64 * j]; o8[64 * j] = pk4(v[j] * rstd * gg); }
}

template <int PH>
__device__ __forceinline__ void conv31_chunk(LAS unsigned char* lds, LAS float* red, LAS float* stats, const bf16_t* GLU, bf16_t* SZB, const float* cw, const float* cb, const float* lng, const float* lnb,
                                            const int t0, const bool has_next, const int tid_in) {
    int tid_o = tid_in; asm volatile("" : "+v"(tid_o));
    const int tid = tid_o, lane = tid & 63, wid = tid >> 6, c2 = tid * 2;
    u32x4 nx[4];
    if (has_next) {
        int tf = tid; asm volatile("" : "+v"(tf));
#pragma unroll
        for (int q = 0; q < 4; ++q) { const int i = tf + q * 512; nx[q] = *(const u32x4*)(GLU + (size_t)(t0 + 16 + (i >> 7)) * 1024 + (i & 127) * 8); }
    }
    const f32x2 bias = *(const f32x2*)(cb + c2);
    f32x2 outv[16];
#pragma unroll
    for (int t = 0; t < 16; ++t) outv[t] = bias;
#pragma unroll
    for (int ps = 0; ps < 2; ++ps) {
        const int kb = ps * 16, ntap = ps == 0 ? 16 : 15;
        f32x2 w[16];
#pragma unroll
        for (int k = 0; k < 16; ++k) if (k < ntap) w[k] = *(const f32x2*)(cw + (kb + k) * 1024 + c2);
#pragma unroll
        for (int r = 0; r < 31; ++r) if (r < ntap + 15) {
            const unsigned v = *(const LAS unsigned*)(lds + ((34 + 16 * PH + kb + r) & 63) * 2048 + tid * 4);
            const f32x2 x = (f32x2){bf_lo(v), bf_hi(v)};
#pragma unroll
            for (int t = 0; t < 16; ++t) { const int k = r - t; if (k >= 0 && k < ntap) outv[t] = __builtin_elementwise_fma(w[k], x, outv[t]); }
            if ((r & 7) == 7) asm volatile("" ::: "memory");
        }
    }
    {
        float s[16], q[16];
#pragma unroll
        for (int t = 0; t < 16; ++t) { s[t] = outv[t][0] + outv[t][1]; q[t] = outv[t][0] * outv[t][0] + outv[t][1] * outv[t][1]; }
#pragma unroll
        for (int lvl = 0; lvl < 4; ++lvl) {
            const int half = 8 >> lvl, off = 32 >> lvl; const bool hi = (lane & off) != 0;
#pragma unroll
            for (int i = 0; i < half; ++i) {
                const float ks = hi ? s[i + half] : s[i], ss = hi ? s[i] : s[i + half]; s[i] = ks + __shfl_xor(ss, off);
                const float kq = hi ? q[i + half] : q[i], sq = hi ? q[i] : q[i + half]; q[i] = kq + __shfl_xor(sq, off);
            }
        }
        s[0] += __shfl_xor(s[0], 2); q[0] += __shfl_xor(q[0], 2);
        s[0] += __shfl_xor(s[0], 1); q[0] += __shfl_xor(q[0], 1);
        if ((lane & 3) == 0) *(LAS f32x2*)(red + ((lane >> 2) * 8 + wid) * 2) = (f32x2){s[0], q[0]};
    }
    __syncthreads();
    if (has_next) {
#pragma unroll
        for (int q = 0; q < 4; ++q) { const int i = tid + q * 512; *(LAS u32x4*)(lds + ((34 + 16 * PH + 46 + (i >> 7)) & 63) * 2048 + (i & 127) * 16) = nx[q]; }
    }
    if (tid < 16) {
        float S = 0.f, Q2 = 0.f;
#pragma unroll
        for (int wv = 0; wv < 8; ++wv) { const f32x2 t = *(const LAS f32x2*)(red + (tid * 8 + wv) * 2); S += t[0]; Q2 += t[1]; }
        const float mean = S * (1.f / 1024.f), var = fmaxf(Q2 * (1.f / 1024.f) - mean * mean, 0.f);
        *(LAS f32x2*)(stats + tid * 2) = (f32x2){mean, 1.0f / sqrtf(var + EPS)};
    }
    __syncthreads();
    const f32x2 lg = *(const f32x2*)(lng + c2), lb = *(const f32x2*)(lnb + c2);
    unsigned zz[16];
#pragma unroll
    for (int t = 0; t < 16; ++t) zz[t] = *(const unsigned*)(SZB + (size_t)(t0 + t) * 1024 + c2);
#pragma unroll
    for (int t = 0; t < 16; ++t) {
        const f32x2 st = *(const LAS f32x2*)(stats + t * 2);
        const float y0 = (outv[t][0] - st[0]) * st[1] * lg[0] + lb[0], y1 = (outv[t][1] - st[0]) * st[1] * lg[1] + lb[1];
        *(unsigned*)(SZB + (size_t)(t0 + t) * 1024 + c2) = pk_bf16(bf_lo(zz[t]) * siluf_(y0), bf_hi(zz[t]) * siluf_(y1));
    }
}
__device__ __forceinline__ void conv31_phase(LAS unsigned char* lds, const bf16_t* GLU, bf16_t* SZB, const float* cw, const float* cb, const float* lng, const float* lnb, int G, int c) {
    int tid_ = threadIdx.x; asm volatile("" : "+v"(tid_));
    const int tid = tid_;
    LAS float* red = (LAS float*)(lds + 131072 + 1024);
    LAS float* stats = (LAS float*)(lds + 131072 + 3072);
    for (int run = c; run < NTOK / 128; run += G) {
        const int T0 = run * 128, tpos = T0 & (SEQ - 1);
        __syncthreads();
#pragma unroll
        for (int h = 0; h < 2; ++h) {
            int tf = tid; asm volatile("" : "+v"(tf));
            u32x4 tv[6];
#pragma unroll
            for (int q = 0; q < 6; ++q) { const int i = tf + (h * 6 + q) * 512, r = (i >> 7) < 46 ? (i >> 7) : 45; const int gr = (tpos - 30 + r >= 0) ? (T0 - 30 + r) : T0;
                tv[q] = *(const u32x4*)(GLU + (size_t)gr * 1024 + (i & 127) * 8); }
#pragma unroll
            for (int q = 0; q < 6; ++q) { const int i = tf + (h * 6 + q) * 512, r = i >> 7;
                if (r < 46) *(LAS u32x4*)(lds + ((34 + r) & 63) * 2048 + (i & 127) * 16) = (tpos - 30 + r >= 0) ? tv[q] : (u32x4){0u, 0u, 0u, 0u}; }
        }
        __syncthreads();
        conv31_chunk<0>(lds, red, stats, GLU, SZB, cw, cb, lng, lnb, T0, true, tid);
        conv31_chunk<1>(lds, red, stats, GLU, SZB, cw, cb, lng, lnb, T0 + 16, true, tid);
        conv31_chunk<2>(lds, red, stats, GLU, SZB, cw, cb, lng, lnb, T0 + 32, true, tid);
        conv31_chunk<3>(lds, red, stats, GLU, SZB, cw, cb, lng, lnb, T0 + 48, true, tid);
        conv31_chunk<0>(lds, red, stats, GLU, SZB, cw, cb, lng, lnb, T0 + 64, true, tid);
        conv31_chunk<1>(lds, red, stats, GLU, SZB, cw, cb, lng, lnb, T0 + 80, true, tid);
        conv31_chunk<2>(lds, red, stats, GLU, SZB, cw, cb, lng, lnb, T0 + 96, true, tid);
        conv31_chunk<3>(lds, red, stats, GLU, SZB, cw, cb, lng, lnb, T0 + 112, false, tid);
    }
    __syncthreads();
}

__global__ void __launch_bounds__(512, 2) fwd_megakernel(Params p) {
    extern __shared__ __attribute__((aligned(16))) unsigned char lds_raw[];
    LAS unsigned char* lds = (LAS unsigned char*)lds_raw;
    const int G = gridDim.x, bx = blockIdx.x;
    unsigned char* ws = p.ws; unsigned char* ob = (unsigned char*)p.out;
    const float *x = p.in[0], *mem = p.in[1], *norm_g = p.in[2], *w_in = p.in[3], *conv_a_w = p.in[4], *w_out_a = p.in[5], *conv_b_w = p.in[6], *conv_b_b = p.in[7],
                *ln_b_g = p.in[8], *ln_b_b = p.in[9], *w_out_b = p.in[10], *mem_norm_g = p.in[11], *w_kv = p.in[12], *w_out_x = p.in[13], *w_o = p.in[14], *final_g = p.in[15];
    bf16_t *WIN = (bf16_t*)(ws + WS_WIN), *WOUT = (bf16_t*)(ws + WS_WOUT), *WO = (bf16_t*)(ws + WS_WO), *WKV = (bf16_t*)(ws + WS_WKV), *MEMN = (bf16_t*)(ws + WS_MEMN),
           *KB = (bf16_t*)(ws + WS_KB), *VT = (bf16_t*)(ws + WS_VT), *PAT = (bf16_t*)(ws + WS_PAT), *GAH = (bf16_t*)(ws + WS_GAH), *HA = (bf16_t*)(ws + WS_HA), *SZB = (bf16_t*)(ws + WS_SZB),
           *SZX = (bf16_t*)(ws + WS_SZX), *GLU = (bf16_t*)(ws + WS_GLU), *Q = (bf16_t*)(ws + WS_Q), *SGA = (bf16_t*)(ws + WS_SGA), *SGB = (bf16_t*)(ws + WS_SGB),
           *U = (bf16_t*)(ob + OUT_U), *SGX = (bf16_t*)(ob + OUT_SGX);
    float *ROWSS = (float*)(ws + WS_ROWSS), *RSUM = (float*)(ws + WS_RSUM);
    bf16_t* MERGED = GLU;
    volatile LAS unsigned* xst = (volatile LAS unsigned*)(lds + 131072 + 512);
    if (threadIdx.x < 4) xst[threadIdx.x] = 0u;
    __syncthreads();
    XcdBarrier xb = xcd_barrier_post((unsigned*)(ws + WS_BAR), xst);

    {
        int tid_ = threadIdx.x; asm volatile("" : "+v"(tid_)); const int tid = tid_, lane = tid & 63, wave = tid >> 6;
        LAS float* scr = (LAS float*)(lds + wave * 16384);
        const int gw = bx * 8 + wave, NGW = G * 8;
        for (int it = gw; it < 9216; it += NGW) {
            int r = it;
            if (r < 6144) { const int g = r % 384; p0_transpose_item(w_in, 12288, WIN, (g >> 1) * 64 + (g & 1) * 16, (r / 384) * 64, true, scr, lane); continue; } r -= 6144;
            if (r < 512) { p0_transpose_item(w_out_a, 1024, WOUT, (r & 31) * 32, (r >> 5) * 64, false, scr, lane); continue; } r -= 512;
            if (r < 512) { p0_transpose_item(w_out_b, 1024, WOUT + (size_t)1024 * 1024, (r & 31) * 32, (r >> 5) * 64, false, scr, lane); continue; } r -= 512;
            if (r < 512) { p0_transpose_item(w_out_x, 1024, WOUT + (size_t)2048 * 1024, (r & 31) * 32, (r >> 5) * 64, false, scr, lane); continue; } r -= 512;
            if (r < 512) { p0_transpose_item(w_o, 1024, WO, (r & 31) * 32, (r >> 5) * 64, false, scr, lane); continue; } r -= 512;
            p0_transpose_item(w_kv, 2048, WKV, (r & 63) * 32, (r >> 6) * 64, false, scr, lane);
        }
        {
            const f32x4* gr = (const f32x4*)norm_g + lane; f32x4 gg[4];
#pragma unroll
            for (int j = 0; j < 4; ++j) gg[j] = gr[64 * j];
            for (int m = gw; m < NTOK; m += 4 * NGW) {
                f32x4 v[4][4];
#pragma unroll
                for (int r = 0; r < 4; ++r) { const f32x4* xr = (const f32x4*)(x + (size_t)(m + r * NGW) * 1024) + lane;
#pragma unroll
                    for (int j = 0; j < 4; ++j) v[r][j] = xr[64 * j]; }
#pragma unroll
                for (int r = 0; r < 4; ++r) {
                    float sq = 0.f;
#pragma unroll
                    for (int j = 0; j < 4; ++j) sq += (v[r][j][0] * v[r][j][0] + v[r][j][1] * v[r][j][1]) + (v[r][j][2] * v[r][j][2] + v[r][j][3] * v[r][j][3]);
                    const float rstd = 1.0f / sqrtf(wave_sum(sq) * (1.f / 1024.f) + EPS);
                    u32x2* o8 = (u32x2*)(U + (size_t)(m + r * NGW) * 1024) + lane;
#pragma unroll
                    for (int j = 0; j < 4; ++j) o8[64 * j] = pk4(v[r][j] * rstd * gg[j]);
                }
            }
        }
        for (int m = gw; m < 1024; m += NGW) rms_row_to_bf16(mem + (size_t)m * 1024, mem_norm_g, MEMN + (size_t)m * 1024, lane);
        for (int i = bx * 512 + tid; i < NTOK * 5; i += G * 512) ROWSS[i] = 0.f;
    }
    GRID_SYNC();

    {
        SchedP1 S{(const char*)U, (const char*)WIN, (const char*)MEMN, (const char*)WKV, G, bx};
        EpiP1 E{HA, GLU, SZB, SZX, Q, SGA, SGB, SGX, KB, VT, PAT, GAH, conv_a_w};
        gemm_phase(lds, 1024, 1024, 1024, S, E);
    }
    GRID_SYNC();

    {
        int tid_ = threadIdx.x; asm volatile("" : "+v"(tid_)); const int tid = tid_;
        for (int i = bx * 512 + tid; i < 512 * 256; i += G * 512) {
            const int blk = i >> 8, ch = (i & 255) * 4;
            if ((blk & 127) != 0) {
                const f32x4 w0 = *(const f32x4*)(conv_a_w + ch), w1 = *(const f32x4*)(conv_a_w + 1024 + ch);
                const f32x4 pt0 = unpk4(*(const u32x2*)(PAT + (size_t)((blk - 1) * 2 + 0) * 1024 + ch)), pt1 = unpk4(*(const u32x2*)(PAT + (size_t)((blk - 1) * 2 + 1) * 1024 + ch));
                const f32x4 g0 = unpk4(*(const u32x2*)(GAH + (size_t)(blk * 2 + 0) * 1024 + ch)), g1 = unpk4(*(const u32x2*)(GAH + (size_t)(blk * 2 + 1) * 1024 + ch));
                u32x2* h0 = (u32x2*)(HA + (size_t)(blk * 64) * 1024 + ch); u32x2* h1 = (u32x2*)(HA + (size_t)(blk * 64 + 1) * 1024 + ch);
                *h0 = pk4(unpk4(*h0) + g0 * (w1 * pt1 + w0 * pt0));
                *h1 = pk4(unpk4(*h1) + g1 * (w0 * pt1));
            }
        }
        { SchedAttn S{(const char*)Q, (const char*)KB, TILE, (size_t)512, G, bx}; EpiS E{Q, RSUM}; gemm_phase(lds, 1024, 1024, 256, S, E); }
        conv31_phase(lds, GLU, SZB, conv_b_w, conv_b_b, ln_b_g, ln_b_b, G, bx);
    }
    asm volatile("s_waitcnt vmcnt(0) lgkmcnt(0)" ::: "memory"); __syncthreads();
    __builtin_amdgcn_fence(__ATOMIC_ACQUIRE, "agent"); asm volatile("s_waitcnt vmcnt(0)" ::: "memory"); __syncthreads();

    { SchedAttn S{(const char*)Q, (const char*)VT, (size_t)1024 * 256 * 2, (size_t)256 * 256 * 2, G, bx}; EpiPV E{SZX, U  , RSUM}; gemm_phase(lds, 1024, 256, 256, S, E); }
    GRID_SYNC();

    { SchedOut S{(const char*)HA, (const char*)U, (const char*)WOUT, G, bx}; EpiOut E{SGA, SGB, SGX, Q  , MERGED}; gemm_phase(lds, 1024, 1024, 1024, S, E); }
    GRID_SYNC();

    { SchedWo S{(const char*)MERGED, (const char*)WO, G, bx}; EpiWo E{x, HA  , ROWSS}; gemm_phase(lds, 1024, 1024, 1024, S, E); }
    GRID_SYNC();

    {
        int tid_ = threadIdx.x; asm volatile("" : "+v"(tid_)); const int lane = tid_ & 63, w4 = tid_ >> 6, wr = w4 >> 2, wc = w4 & 3, fr = lane & 15, fq = lane >> 4;
        for (int L = bx; L < 512; L += G) {
            int pm, pn; remap_tile(L, 128, 4, pm, pn);
#pragma unroll
            for (int ai = 0; ai < 2; ++ai) {
                u32x2 hv[4][2][2]; float rs[4]; f32x4 gg[2][2];
#pragma unroll
                for (int m = 0; m < 4; ++m) {
                    rs[m] = ROWSS[pm * 256 + ai * 128 + wr * 64 + m * 16 + fr];
#pragma unroll
                    for (int bj = 0; bj < 2; ++bj)
#pragma unroll
                        for (int n = 0; n < 2; ++n) hv[m][bj][n] = ((const u32x2*)HA)[native_slot(pm, pn, w4, ai, m, bj, n, fq * 16 + fr)];
                }
#pragma unroll
                for (int bj = 0; bj < 2; ++bj)
#pragma unroll
                    for (int n = 0; n < 2; ++n) gg[bj][n] = *(const f32x4*)(final_g + pn * 256 + bj * 128 + wc * 32 + n * 16 + fq * 4);
#pragma unroll
                for (int m = 0; m < 4; ++m) {
                    const float rstd = 1.0f / sqrtf(rs[m] * (1.f / 1024.f) + EPS);
#pragma unroll
                    for (int bj = 0; bj < 2; ++bj)
#pragma unroll
                        for (int n = 0; n < 2; ++n)
                            *(f32x4*)(p.out + (size_t)(pm * 256 + ai * 128 + wr * 64 + m * 16 + fr) * 1024 + pn * 256 + bj * 128 + wc * 32 + n * 16 + fq * 4) = unpk4(hv[m][bj][n]) * rstd * gg[bj][n];
                }
            }
        }
    }
}

extern "C" void kernel_launch(void* const* d_in, const int* in_sizes, int n_in, void* d_out, int out_size, void* d_ws, size_t ws_size, hipStream_t stream) {
    static int grid_blocks = 0;
    if (!grid_blocks) {
        int dev = 0, cus = 0, per_cu = 0;
        hipGetDevice(&dev);
        hipDeviceGetAttribute(&cus, hipDeviceAttributeMultiprocessorCount, dev);
        hipFuncSetAttribute((const void*)fwd_megakernel, hipFuncAttributeMaxDynamicSharedMemorySize, LDS_BYTES);
        hipOccupancyMaxActiveBlocksPerMultiprocessor(&per_cu, (const void*)fwd_megakernel, 512, LDS_BYTES);
        if (per_cu < 1) { fprintf(stderr, "kernel_launch: occupancy query reports %d blocks per CU\n", per_cu); per_cu = 1; }
        if (per_cu > 1) per_cu = 1;
        grid_blocks = cus * per_cu;
        if (ws_size < WS_END) fprintf(stderr, "kernel_launch: workspace too small: %zu < %zu\n", ws_size, (size_t)WS_END);
    }
    (void)hipMemsetAsync((char*)d_ws + WS_BAR, 0, XCD_BAR_WORDS * 4, stream);
    if (ws_size < WS_END) return;
    Params p{};
    for (int i = 0; i < 16; ++i) p.in[i] = (const float*)d_in[i];
    p.out = (float*)d_out; p.ws = (unsigned char*)d_ws;
    void* args[] = {&p};
    hipError_t e = hipLaunchCooperativeKernel((const void*)fwd_megakernel, dim3(grid_blocks), dim3(512), args, LDS_BYTES, stream);
    if (e != hipSuccess) fprintf(stderr, "cooperative launch failed: %s (grid %d)\n", hipGetErrorString(e), grid_blocks);
}
```

```cpp
#include <hip/hip_runtime.h>
#include <cstdio>

#define LAS __attribute__((address_space(3)))
typedef unsigned short bf16_t;
typedef short bf16x8 __attribute__((ext_vector_type(8)));
typedef float f32x4 __attribute__((ext_vector_type(4)));
typedef float f32x2 __attribute__((ext_vector_type(2)));
typedef unsigned u32x4 __attribute__((ext_vector_type(4)));
typedef unsigned u32x2 __attribute__((ext_vector_type(2)));

constexpr int BM = 256, BK = 64, HALF = 128, HTB = HALF * BK * 2, STAGE_BYTES = 8 * HTB;
constexpr int LDS_BYTES = 147456;
constexpr int NTOK = 32768, DM = 1024, SEQ = 8192;
constexpr float EPS = 1e-6f;
constexpr size_t MiB = 1u << 20;
constexpr size_t TILE = (size_t)256 * 1024 * 2;
constexpr size_t WS_WIN = 0, WS_WOUT = 24 * MiB, WS_WO = 30 * MiB, WS_WKV = 32 * MiB, WS_MEMN = 36 * MiB, WS_KB = 38 * MiB, WS_VT = 40 * MiB;
constexpr size_t WS_ROWSS = 42 * MiB, WS_RSUM = 42 * MiB + 131072, WS_PAT = 43 * MiB, WS_GAH = 45 * MiB;
constexpr size_t WS_BAR = 47 * MiB;
constexpr size_t WS_HA = 48 * MiB, WS_SZB = 112 * MiB, WS_SZX = 176 * MiB, WS_GLU = 240 * MiB, WS_Q = 304 * MiB, WS_SGA = 368 * MiB, WS_SGB = 432 * MiB, WS_END = 496 * MiB;
constexpr size_t OUT_U = 0, OUT_SGX = 64 * MiB;

#define XB_TMO      128
#define XB_XCNT(j)  (256  + 64 * (j))
#define XB_XSUB(j)  (1280 + 64 * (j))
#define XB_XGEN(j)  (2304 + 64 * (j))
#define XB_TOP      3328
#define XB_TOPGEN   3392
#define XCD_BAR_WORDS 3456
#define XB_SPIN_CAP (1u << 18)

__device__ __forceinline__ unsigned xb_ld(unsigned* p)              { return __hip_atomic_load(p, __ATOMIC_RELAXED, __HIP_MEMORY_SCOPE_AGENT); }
__device__ __forceinline__ unsigned xb_add(unsigned* p, unsigned v) { return __hip_atomic_fetch_add(p, v, __ATOMIC_RELAXED, __HIP_MEMORY_SCOPE_AGENT); }
__device__ __forceinline__ unsigned xb_xcc_id() { return (unsigned)__builtin_amdgcn_s_getreg((3 << 11) | 20) & 0xFu; }
#define XB_SPIN(cond, bar) do { unsigned _sp = 0; while (cond) { __builtin_amdgcn_s_sleep(1); \
    if ((++_sp & 255u) == 0u) { if (xb_ld(&(bar)[XB_TMO])) break; if (_sp > XB_SPIN_CAP) { atomicAdd(&(bar)[XB_TMO], 1u); break; } } } } while (0)

struct XcdBarrier {
    unsigned* bar; unsigned x;
    volatile LAS unsigned* st;
};

__device__ __forceinline__ XcdBarrier xcd_barrier_post(unsigned* bar, volatile LAS unsigned* st, bool leader) {
    XcdBarrier b; b.bar = bar; b.x = xb_xcc_id(); b.st = st;
    if (leader) (void)xb_add(&bar[XB_XCNT(b.x)], 1u);
    return b;
}
__device__ __forceinline__ void xcd_barrier_complete(unsigned* bar, unsigned x, unsigned& nloc, unsigned& nx) {
    const unsigned G = gridDim.x * gridDim.y * gridDim.z;
    unsigned sum, cnt, mine, sp = 0u;
    for (;;) {
        sum = 0u; cnt = 0u; mine = 0u;
#pragma unroll
        for (unsigned j = 0; j < 16; ++j) { const unsigned c = xb_ld(&bar[XB_XCNT(j)]); sum += c; cnt += (c > 0u) ? 1u : 0u; mine = (j == x) ? c : mine; }
        if (sum == G) break;
        __builtin_amdgcn_s_sleep(1);
        if ((++sp & 255u) == 0u) { if (xb_ld(&bar[XB_TMO])) break; if (sp > XB_SPIN_CAP) { atomicAdd(&bar[XB_TMO], 1u); break; } }
    }
    nloc = mine > 0u ? mine : 1u; nx = cnt > 0u ? cnt : 1u;
}

__device__ __forceinline__ void xcd_barrier(const XcdBarrier& b, bool leader) {
    asm volatile("s_waitcnt vmcnt(0)" ::: "memory");
    __syncthreads();
    if (leader) {
        unsigned* bar = b.bar;
        __builtin_amdgcn_s_waitcnt(0);
        unsigned nloc = b.st[0], nx = b.st[1];
        if (nloc == 0u) { xcd_barrier_complete(bar, b.x, nloc, nx); b.st[0] = nloc; b.st[1] = nx; }
        const unsigned old = xb_add(&bar[XB_XSUB(b.x)], 1u);
        const unsigned gen = old / nloc;
        if (old + 1u == (gen + 1u) * nloc) {
            __builtin_amdgcn_fence(__ATOMIC_RELEASE, "agent");
            asm volatile("s_waitcnt vmcnt(0)" ::: "memory");
            const unsigned og = xb_add(&bar[XB_TOP], 1u);
            const unsigned tg = og / nx;
            if (og + 1u == (tg + 1u) * nx) xb_add(&bar[XB_TOPGEN], 1u);
            else XB_SPIN(xb_ld(&bar[XB_TOPGEN]) == tg, bar);
            __builtin_amdgcn_fence(__ATOMIC_ACQUIRE, "agent");
            xb_add(&bar[XB_XGEN(b.x)], 1u);
            asm volatile("s_waitcnt vmcnt(0)" ::: "memory");
        } else {
            XB_SPIN(xb_ld(&bar[XB_XGEN(b.x)]) == gen, bar);
            __builtin_amdgcn_fence(__ATOMIC_ACQUIRE, "agent");
            asm volatile("s_waitcnt vmcnt(0)" ::: "memory");
        }
    }
    __syncthreads();
}

#define GRID_SYNC() xcd_barrier(xb, tid_of(widx) == 0)

struct Params { const float* in[16]; float* out; unsigned char* ws; };

typedef __bf16 bf16x2_t __attribute__((ext_vector_type(2)));
__device__ __forceinline__ unsigned pk_bf16(float lo, float hi) { const f32x2 v = {lo, hi}; return __builtin_bit_cast(unsigned, __builtin_convertvector(v, bf16x2_t)); }
__device__ __forceinline__ float bf_lo(unsigned u) { return __uint_as_float(u << 16); }
__device__ __forceinline__ float bf_hi(unsigned u) { return __uint_as_float(u & 0xffff0000u); }
__device__ __forceinline__ float sigmoidf_(float x) { return __builtin_amdgcn_rcpf(1.0f + __builtin_amdgcn_exp2f(-1.44269504089f * x)); }
__device__ __forceinline__ float siluf_(float x) { return x * sigmoidf_(x); }
__device__ __forceinline__ u32x2 pk4(f32x4 v) { u32x2 r; r.x = pk_bf16(v[0], v[1]); r.y = pk_bf16(v[2], v[3]); return r; }
__device__ __forceinline__ f32x4 unpk4(u32x2 v) { return (f32x4){bf_lo(v.x), bf_hi(v.x), bf_lo(v.y), bf_hi(v.y)}; }
template <int CTRL> __device__ __forceinline__ float dppf(float old, float v) { return __int_as_float(__builtin_amdgcn_update_dpp(__float_as_int(old), __float_as_int(v), CTRL, 0xf, 0xf, false)); }
__device__ __forceinline__ float wave_sum(float v) {
#pragma unroll
    for (int o = 1; o < 64; o <<= 1) v += __shfl_xor(v, o);
    return v;
}

__device__ __forceinline__ int lds_byte(int r, int c) { const int st = (r >> 4) * 2 + (c >> 5), rr = r & 15, cc = c & 31, ob = rr * 64 + cc * 2; return st * 1024 + (ob ^ (((ob >> 9) & 1) << 5)); }
__device__ __forceinline__ void stage_rc(int b, int& R, int& C) { const int st = b / 1024, sb = b % 1024, swz = sb ^ (((sb >> 9) & 1) << 5); R = (st >> 1) * 16 + swz / 64; C = (st & 1) * 32 + (swz % 64) / 2; }

__device__ __forceinline__ int tid_of(int widx) { int l; asm volatile("v_mbcnt_lo_u32_b32 %0, -1, 0\n\tv_mbcnt_hi_u32_b32 %0, -1, %0" : "=v"(l)); return widx * 64 + l; }
struct Unit { const char* A; const char* B; int pm, pn, kind; };
__device__ __forceinline__ size_t native_slot(int pm, int pn4, int w4, int ai, int m, int bj, int n, int lane) {
    return ((((size_t)(pm * 4 + pn4) * 8 + w4) * 32 + (((ai * 4 + m) * 2 + bj) * 2 + n)) * 64 + lane);
}

template <int WG = 8> __device__ __forceinline__ void remap_tile(int L, int nM, int nN, int& pm, int& pn) {
    const int nwg = nM * nN; int wgid = L;
    { const int q = nwg / 8, r = nwg % 8, xcd = wgid % 8, off = wgid / 8; wgid = (xcd < r ? xcd * (q + 1) : r * (q + 1) + (xcd - r) * q) + off; }
    const int nig = WG * nN, gid = wgid / nig, fm = gid * WG, gsz = (nM - fm) < WG ? (nM - fm) : WG;
    pm = fm + ((wgid % nig) % gsz); pn = (wgid % nig) / gsz;
}

struct EpiOut;
template <class Epi> __device__ __forceinline__ bool epi_keeps(const Epi&, const Unit&) { return false; }
__device__ __forceinline__ bool epi_keeps(const EpiOut&, const Unit& u) { return u.kind < 2; }
template <class Epi, class Sched>
__device__ __forceinline__ void gemm_phase(LAS unsigned char* lds, const int lda, const int ldb, const int K, const Sched& S, const Epi& E, const int widx) {
    int tid_ = tid_of(widx); asm volatile("" : "+v"(tid_));
    const int tid = tid_, wid = __builtin_amdgcn_readfirstlane(tid >> 6), lane = tid & 63, wr = wid >> 2, wc = wid & 3, fr = lane & 15, fq = lane >> 4;
    const int nt = K / BK;
    unsigned voffA[2], voffB[2];
#pragma unroll
    for (int i = 0; i < 2; ++i) { int R, C; stage_rc(tid * 16 + i * 8192, R, C); voffA[i] = (unsigned)(R * lda + C) * 2u; voffB[i] = (unsigned)(R * ldb + C) * 2u; }
    const size_t kstep = (size_t)(BK * 2);
    const size_t hstepA = (size_t)HALF * lda * 2, hstepB = (size_t)HALF * ldb * 2;
    const unsigned ldsw = (unsigned)wid * 1024u;
    const int aoff = lds_byte(wr * 64 + fr, fq * 8), boff = lds_byte(wc * 32 + fr, fq * 8);
#define GP_SA(b, h) (((b) * 2 + (h)) * HTB)
#define GP_SB(b, h) ((4 + (b) * 2 + (h)) * HTB)
#define GP_STAGE(bufoff, gbase, voff) do { _Pragma("unroll") for (int _i = 0; _i < 2; ++_i) \
        __builtin_amdgcn_global_load_lds((const unsigned*)((const char*)(gbase) + (voff)[_i]), (LAS unsigned*)(lds + (bufoff) + ldsw + _i * 8192), 16, 0, 0); } while (0)
#define GP_LDA(dst, b, h) do { _Pragma("unroll") for (int m = 0; m < 4; ++m) _Pragma("unroll") for (int k = 0; k < 2; ++k) dst[m][k] = *(const LAS bf16x8*)(lds + GP_SA(b, h) + aoff + m * 2048 + k * 1024); } while (0)
#define GP_LDB(dst, b, h) do { _Pragma("unroll") for (int n = 0; n < 2; ++n) _Pragma("unroll") for (int k = 0; k < 2; ++k) dst[n][k] = *(const LAS bf16x8*)(lds + GP_SB(b, h) + boff + n * 2048 + k * 1024); } while (0)
#define GP_MMA(ai, bj, At, Bt) do { __builtin_amdgcn_s_setprio(1); _Pragma("unroll") for (int m = 0; m < 4; ++m) _Pragma("unroll") for (int n = 0; n < 2; ++n) _Pragma("unroll") for (int k = 0; k < 2; ++k) \
        acc[ai][bj][m][n] = __builtin_amdgcn_mfma_f32_16x16x32_bf16(Bt[n][k], At[m][k], acc[ai][bj][m][n], 0, 0, 0); __builtin_amdgcn_s_setprio(0); } while (0)
#define GP_WAIT_V(n) asm volatile("s_waitcnt vmcnt(" #n ")" ::: "memory")
#define GP_WAIT_L(n) asm volatile("s_waitcnt lgkmcnt(" #n ")" ::: "memory")
#define GP_BAR __builtin_amdgcn_s_barrier()
#define GP_SCHED __builtin_amdgcn_sched_barrier(0)
    Unit cur, nxt; int ui = 0;
    if (!S.next(0, cur)) return;
    f32x4 acc[2][2][4][2];
#pragma unroll
    for (int a = 0; a < 2; ++a)
#pragma unroll
        for (int b = 0; b < 2; ++b)
#pragma unroll
            for (int m = 0; m < 4; ++m)
#pragma unroll
                for (int n = 0; n < 2; ++n) acc[a][b][m][n] = (f32x4){0.f, 0.f, 0.f, 0.f};
    bf16x8 At[4][2], B0[2][2], B1[2][2];
    const char* cA = cur.A; const char* cB = cur.B;
    GP_STAGE(GP_SB(0, 0), cB, voffB); GP_STAGE(GP_SB(0, 1), cB + hstepB, voffB); GP_STAGE(GP_SA(0, 0), cA, voffA); GP_STAGE(GP_SA(0, 1), cA + hstepA, voffA);
    if (wr == 1) GP_BAR;
    GP_WAIT_V(2); GP_BAR;
    GP_STAGE(GP_SB(1, 0), cB + kstep, voffB); GP_STAGE(GP_SA(1, 0), cA + kstep, voffA); GP_STAGE(GP_SB(1, 1), cB + hstepB + kstep, voffB);
    GP_WAIT_V(6); GP_BAR;
    for (;;) {
        const bool has_next = S.next(ui + 1, nxt);
        const char* nA = has_next ? nxt.A : cA; const char* nB = has_next ? nxt.B : cB;
        for (int t = 0; t < nt; t += 2) {
            const bool last = (t == nt - 2);
            const char* a1 = cA + (size_t)(t + 1) * kstep;
            const char* a2 = last ? nA : cA + (size_t)(t + 2) * kstep; const char* b2 = last ? nB : cB + (size_t)(t + 2) * kstep;
            const char* a3 = a2 + kstep; const char* b3 = b2 + kstep;
            GP_LDB(B0, 0, 0); GP_LDB(B1, 0, 1); GP_SCHED; GP_LDA(At, 0, 0); GP_STAGE(GP_SA(1, 1), a1 + hstepA, voffA);
            GP_WAIT_V(8); GP_WAIT_L(0); GP_BAR; GP_MMA(0, 0, At, B0); GP_MMA(0, 1, At, B1); GP_BAR; GP_SCHED;
            GP_LDA(At, 0, 1); GP_STAGE(GP_SB(0, 0), b2, voffB); GP_STAGE(GP_SB(0, 1), b2 + hstepB, voffB); GP_STAGE(GP_SA(0, 0), a2, voffA);
            GP_WAIT_V(8); GP_WAIT_L(0); GP_BAR; GP_MMA(1, 0, At, B0); GP_MMA(1, 1, At, B1); GP_BAR; GP_SCHED;
            GP_LDB(B0, 1, 0); GP_LDB(B1, 1, 1); GP_SCHED; GP_LDA(At, 1, 0); GP_STAGE(GP_SA(0, 1), a2 + hstepA, voffA);
            GP_WAIT_V(8); GP_WAIT_L(0); GP_BAR; GP_MMA(0, 0, At, B0); GP_MMA(0, 1, At, B1); GP_BAR; GP_SCHED;
            GP_LDA(At, 1, 1); GP_STAGE(GP_SB(1, 0), b3, voffB); GP_STAGE(GP_SB(1, 1), b3 + hstepB, voffB); GP_STAGE(GP_SA(1, 0), a3, voffA);
            GP_WAIT_V(8); GP_WAIT_L(0); GP_BAR; GP_MMA(1, 0, At, B0); GP_MMA(1, 1, At, B1); GP_BAR; GP_SCHED;
        }
        if (wr == 0) GP_BAR;
        E(acc, cur, wr, wc, fr, fq);
        if (!has_next) break;
        if (!epi_keeps(E, cur)) {
#pragma unroll
        for (int a = 0; a < 2; ++a)
#pragma unroll
            for (int b = 0; b < 2; ++b)
#pragma unroll
                for (int m = 0; m < 4; ++m)
#pragma unroll
                    for (int n = 0; n < 2; ++n) acc[a][b][m][n] = (f32x4){0.f, 0.f, 0.f, 0.f};
        }
        cur = nxt; cA = nA; cB = nB; ++ui;
        if (wr == 1) GP_BAR;
    }
    GP_WAIT_V(0);
    GP_BAR;
#undef GP_SA
#undef GP_SB
#undef GP_STAGE
#undef GP_LDA
#undef GP_LDB
#undef GP_MMA
#undef GP_WAIT_V
#undef GP_WAIT_L
#undef GP_BAR
#undef GP_SCHED
}

struct SchedP1 {
    const char *U, *Win, *Memn, *Wkv; int G, c;
    __device__ __forceinline__ bool next(int i, Unit& u) const {
        if (G == 256) {
            if (i < 24) { const int l = i * 32 + (c >> 3); int pm = l / 6, pn = 6 * (c & 7) + l % 6; pn = (pn % 3) * 16 + pn / 3;
                u.pm = pm; u.pn = pn; u.kind = pn >> 4; u.A = U + (size_t)pm * TILE; u.B = Win + (size_t)pn * TILE; return true; }
            if (i > 24 || c >= 32) return false;
            int L = c;
            if (L < 16) { u.pm = L >> 2; u.pn = L & 3; u.kind = 3; u.A = Memn + (size_t)u.pm * TILE; u.B = Wkv + (size_t)u.pn * TILE; }
            else { L -= 16; u.pm = L >> 2; u.pn = L & 3; u.kind = 4; u.A = Wkv + (size_t)(4 + u.pm) * TILE; u.B = Memn + (size_t)u.pn * TILE; }
            return true;
        }
        int L = i * G + c;
        if (L < 6144) { int pm, pn; remap_tile<4>(L, 128, 48, pm, pn); pn = (pn % 3) * 16 + pn / 3; u.pm = pm; u.pn = pn; u.kind = pn >> 4; u.A = U + (size_t)pm * TILE; u.B = Win + (size_t)pn * TILE; return true; }
        L -= 6144; if (L >= 32) return false;
        if (L < 16) { u.pm = L >> 2; u.pn = L & 3; u.kind = 3; u.A = Memn + (size_t)u.pm * TILE; u.B = Wkv + (size_t)u.pn * TILE; }
        else { L -= 16; u.pm = L >> 2; u.pn = L & 3; u.kind = 4; u.A = Wkv + (size_t)(4 + u.pm) * TILE; u.B = Memn + (size_t)u.pn * TILE; }
        return true;
    }
};
struct SchedAttn {
    const char *Aq, *Bm; size_t bstride_b, bstride_h; int G, c;
    __device__ __forceinline__ bool next(int i, Unit& u) const {
        const int L = i * G + c; if (L >= 512) return false;
        u.pm = L >> 2; u.pn = L & 3; u.kind = 0;
        u.A = Aq + (size_t)u.pm * TILE + (size_t)u.pn * 512; u.B = Bm + (size_t)(u.pm >> 5) * bstride_b + (size_t)u.pn * bstride_h; return true;
    }
};
struct SchedOut {
    const char *H, *HXp, *W; int G, c;
    __device__ __forceinline__ bool next(int i, Unit& u) const {
        const int ti = i / 3, g = i - 3 * ti; const int L = ti * G + c; if (L >= 512) return false;
        int pm, pn; remap_tile(L, 128, 4, pm, pn); u.pm = pm; u.pn = pn; u.kind = g;
        if (g == 2) u.A = HXp + (size_t)pm * TILE; else u.A = H + ((size_t)g * 128 + pm) * TILE;
        u.B = W + ((size_t)g * 4 + pn) * TILE; return true;
    }
};
struct SchedWo {
    const char *A, *W; int G, c;
    __device__ __forceinline__ bool next(int i, Unit& u) const {
        const int L = i * G + c; if (L >= 512) return false;
        int pm, pn; remap_tile(L, 128, 4, pm, pn); u.pm = pm; u.pn = pn; u.kind = 0; u.A = A + (size_t)pm * TILE; u.B = W + (size_t)pn * TILE; return true;
    }
};

__device__ __forceinline__ int pf(int fq) { return (fq >> 1) | ((fq & 1) << 1); }
__device__ __forceinline__ void store_pair16(bf16_t* rowbase  , u32x2 a  , u32x2 b  , int fq) {
    const auto rx = __builtin_amdgcn_permlane32_swap(a.x, b.x, false, false), ry = __builtin_amdgcn_permlane32_swap(a.y, b.y, false, false);
    *(u32x4*)(rowbase + (size_t)((fq >> 1) * 16) * 1024 + (fq & 1) * 8) = (u32x4){rx[0], ry[0], rx[1], ry[1]};
}
struct EpiP1 {
    bf16_t *HA, *GLU, *SZB, *SZX, *Q, *SGA, *SGB, *SGX, *KB, *VT, *PAT, *GAH; const float* convw;
    __device__ __forceinline__ void operator()(const f32x4 (&acc)[2][2][4][2], const Unit& u, int wr, int wc, int fr, int fq) const {
        if (u.kind <= 2) {
            const int chw = (u.pn & 15) * 64 + wc * 16, ch = chw + pf(fq) * 4;
            const int rowb = u.pm * 256 + wr * 64 + fr;
            if (u.kind == 0) {
                const f32x4 w0 = *(const f32x4*)(convw + ch), w1 = *(const f32x4*)(convw + 1024 + ch), w2 = *(const f32x4*)(convw + 2048 + ch);
#pragma unroll
                for (int ai = 0; ai < 2; ++ai) {
                    const int blk = u.pm * 4 + ai * 2 + wr;
                    f32x4 pprev = (f32x4){0.f, 0.f, 0.f, 0.f}; u32x2 hv[4];
#pragma unroll
                    for (int m = 0; m < 4; ++m) {
                        const f32x4 Bv = acc[ai][0][m][0], Cv = acc[ai][0][m][1], Xv = acc[ai][1][m][0], Zv = acc[ai][1][m][1];
                        const f32x4 p = Cv * Xv; f32x4 ga, p1, p2;
#pragma unroll
                        for (int j = 0; j < 4; ++j) {
                            ga[j] = siluf_(Zv[j]) * Bv[j];
                            const float r1 = (m > 0) ? dppf<0x121>(0.f, pprev[j]) : 0.f, r2 = (m > 0) ? dppf<0x122>(0.f, pprev[j]) : 0.f;
                            p1[j] = dppf<0x111>(r1, p[j]); p2[j] = dppf<0x112>(r2, p[j]);
                        }
                        const f32x4 cv = w2 * p + w1 * p1 + w0 * p2;
                        hv[m] = pk4(ga * cv);
                        if (m == 3 && fr >= 14) *(u32x2*)(PAT + (size_t)(blk * 2 + (fr - 14)) * 1024 + ch) = pk4(p);
                        if (m == 0 && fr < 2) *(u32x2*)(GAH + (size_t)(blk * 2 + fr) * 1024 + ch) = pk4(ga);
                        pprev = p;
                    }
#pragma unroll
                    for (int pr = 0; pr < 2; ++pr) store_pair16(HA + (size_t)(rowb + ai * 128 + pr * 32) * 1024 + chw, hv[2 * pr], hv[2 * pr + 1], fq);
                }
            } else if (u.kind == 1) {
#pragma unroll
                for (int ai = 0; ai < 2; ++ai) {
                    u32x2 gv[4], zv[4];
#pragma unroll
                    for (int m = 0; m < 4; ++m) {
                        const f32x4 Vv = acc[ai][0][m][0], Gv = acc[ai][0][m][1], Zb = acc[ai][1][m][0], Zx = acc[ai][1][m][1]; f32x4 o0, o1, o2;
#pragma unroll
                        for (int j = 0; j < 4; ++j) { o0[j] = Vv[j] * sigmoidf_(Gv[j]); o1[j] = siluf_(Zb[j]); o2[j] = siluf_(Zx[j]); }
                        gv[m] = pk4(o0); zv[m] = pk4(o1);
                        { const int c = (u.pn & 3) * 64 + wc * 16;
                          ((u32x2*)SZX)[native_slot(u.pm, (u.pn & 15) >> 2, wr * 4 + ((c >> 5) & 3), ai, m, c >> 7, (c >> 4) & 1, pf(fq) * 16 + fr)] = pk4(o2); }
                    }
#pragma unroll
                    for (int pr = 0; pr < 2; ++pr) {
                        store_pair16(GLU + (size_t)(rowb + ai * 128 + pr * 32) * 1024 + chw, gv[2 * pr], gv[2 * pr + 1], fq);
                        store_pair16(SZB + (size_t)(rowb + ai * 128 + pr * 32) * 1024 + chw, zv[2 * pr], zv[2 * pr + 1], fq);
                    }
                }
            } else {
#pragma unroll
                for (int ai = 0; ai < 2; ++ai) {
                    u32x2 qv[4];
#pragma unroll
                    for (int m = 0; m < 4; ++m) {
                        const f32x4 Qv = acc[ai][0][m][0], Ga = acc[ai][0][m][1], Gb = acc[ai][1][m][0], Gx = acc[ai][1][m][1]; f32x4 o1, o2, o3;
#pragma unroll
                        for (int j = 0; j < 4; ++j) { o1[j] = sigmoidf_(Ga[j]); o2[j] = sigmoidf_(Gb[j]); o3[j] = sigmoidf_(Gx[j]); }
                        qv[m] = pk4(Qv * 0.0625f);
                        const int c = (u.pn & 3) * 64 + wc * 16;
                        const size_t ns = native_slot(u.pm, (u.pn & 15) >> 2, wr * 4 + ((c >> 5) & 3), ai, m, c >> 7, (c >> 4) & 1, pf(fq) * 16 + fr);
                        ((u32x2*)SGA)[ns] = pk4(o1); ((u32x2*)SGB)[ns] = pk4(o2); ((u32x2*)SGX)[ns] = pk4(o3);
                    }
#pragma unroll
                    for (int pr = 0; pr < 2; ++pr) store_pair16(Q + (size_t)(rowb + ai * 128 + pr * 32) * 1024 + chw, qv[2 * pr], qv[2 * pr + 1], fq);
                }
            }
        } else {
            const int r0 = wr * 64 + fr, c0 = wc * 32 + fq * 4;
#pragma unroll
            for (int ai = 0; ai < 2; ++ai)
#pragma unroll
                for (int m = 0; m < 4; ++m)
#pragma unroll
                    for (int bj = 0; bj < 2; ++bj)
#pragma unroll
                        for (int n = 0; n < 2; ++n) {
                            const int r = r0 + ai * 128 + m * 16, c = c0 + bj * 128 + n * 16;
                            if (u.kind == 3) *(u32x2*)(KB + (size_t)(u.pm * 256 + r) * 1024 + u.pn * 256 + c) = pk4(acc[ai][bj][m][n]);
                            else             *(u32x2*)(VT + ((size_t)u.pn * 1024 + u.pm * 256 + r) * 256 + c) = pk4(acc[ai][bj][m][n]);
                        }
        }
    }
};
struct EpiS {
    bf16_t* Q; float* RSUM;
    __device__ __forceinline__ void operator()(const f32x4 (&acc)[2][2][4][2], const Unit& u, int wr, int wc, int fr, int fq) const {
#pragma unroll
        for (int ai = 0; ai < 2; ++ai)
#pragma unroll
            for (int m = 0; m < 4; ++m) {
                const int row = u.pm * 256 + ai * 128 + wr * 64 + m * 16 + fr; float rs = 0.f;
#pragma unroll
                for (int bj = 0; bj < 2; ++bj)
#pragma unroll
                    for (int n = 0; n < 2; ++n) {
                        const f32x4 s = acc[ai][bj][m][n]; f32x4 e;
#pragma unroll
                        for (int j = 0; j < 4; ++j) e[j] = __builtin_amdgcn_exp2f(1.44269504089f * s[j]);
                        const u32x2 w = pk4(e); const f32x4 er = unpk4(w); rs += (er[0] + er[1]) + (er[2] + er[3]);
                        *(u32x2*)(Q + (size_t)row * 1024 + u.pn * 256 + bj * 128 + wc * 32 + n * 16 + fq * 4) = w;
                    }
                rs += __shfl_xor(rs, 16); rs += __shfl_xor(rs, 32);
                if (fq == 0) unsafeAtomicAdd(RSUM + row * 4 + u.pn, rs);
            }
    }
};
struct EpiPV {
    const bf16_t* SZXN; bf16_t* HX; const float* RSUM;
    __device__ __forceinline__ void operator()(const f32x4 (&acc)[2][2][4][2], const Unit& u, int wr, int wc, int fr_in, int fq_in) const {
        int fr = fr_in, fq = fq_in; asm volatile("" : "+v"(fr), "+v"(fq));
        const int w4 = wr * 4 + wc, lane = fq * 16 + fr;
#pragma unroll
        for (int ai = 0; ai < 2; ++ai) {
            u32x2 z[4][2][2]; float rs[4];
#pragma unroll
            for (int m = 0; m < 4; ++m) {
                rs[m] = RSUM[(u.pm * 256 + ai * 128 + wr * 64 + m * 16 + fr) * 4 + u.pn];
#pragma unroll
                for (int bj = 0; bj < 2; ++bj)
#pragma unroll
                    for (int n = 0; n < 2; ++n) z[m][bj][n] = ((const u32x2*)SZXN)[native_slot(u.pm, u.pn, w4, ai, m, bj, n, lane)];
            }
#pragma unroll
            for (int m = 0; m < 4; ++m) {
                const int row = u.pm * 256 + ai * 128 + wr * 64 + m * 16 + fr; const float inv = __builtin_amdgcn_rcpf(rs[m]);
#pragma unroll
                for (int bj = 0; bj < 2; ++bj)
#pragma unroll
                    for (int n = 0; n < 2; ++n)
                        *(u32x2*)(HX + (size_t)row * 1024 + u.pn * 256 + bj * 128 + wc * 32 + n * 16 + fq * 4) = pk4(unpk4(z[m][bj][n]) * (acc[ai][bj][m][n] * inv));
            }
        }
    }
};
__device__ __forceinline__ void ld8(u32x2 (&d)[8], const u32x2* p) {
    asm volatile("global_load_dwordx2 %0, %1, off"             : "=v"(d[0]) : "v"(p) : "memory");
    asm volatile("global_load_dwordx2 %0, %1, off offset:512"  : "=v"(d[1]) : "v"(p) : "memory");
    asm volatile("global_load_dwordx2 %0, %1, off offset:1024" : "=v"(d[2]) : "v"(p) : "memory");
    asm volatile("global_load_dwordx2 %0, %1, off offset:1536" : "=v"(d[3]) : "v"(p) : "memory");
    asm volatile("global_load_dwordx2 %0, %1, off offset:2048" : "=v"(d[4]) : "v"(p) : "memory");
    asm volatile("global_load_dwordx2 %0, %1, off offset:2560" : "=v"(d[5]) : "v"(p) : "memory");
    asm volatile("global_load_dwordx2 %0, %1, off offset:3072" : "=v"(d[6]) : "v"(p) : "memory");
    asm volatile("global_load_dwordx2 %0, %1, off offset:3584" : "=v"(d[7]) : "v"(p) : "memory");
}
__device__ __forceinline__ void ld4(u32x2 (&d)[4], const u32x2* p) {
    asm volatile("global_load_dwordx2 %0, %1, off"             : "=v"(d[0]) : "v"(p) : "memory");
    asm volatile("global_load_dwordx2 %0, %1, off offset:512"  : "=v"(d[1]) : "v"(p) : "memory");
    asm volatile("global_load_dwordx2 %0, %1, off offset:1024" : "=v"(d[2]) : "v"(p) : "memory");
    asm volatile("global_load_dwordx2 %0, %1, off offset:1536" : "=v"(d[3]) : "v"(p) : "memory");
}
__device__ __forceinline__ void tie4(u32x2 (&d)[4]) { asm volatile("" : "+v"(d[0]), "+v"(d[1]), "+v"(d[2]), "+v"(d[3])); }
__device__ __forceinline__ void tie8(u32x2 (&d)[8]) { asm volatile("" : "+v"(d[0]), "+v"(d[1]), "+v"(d[2]), "+v"(d[3]), "+v"(d[4]), "+v"(d[5]), "+v"(d[6]), "+v"(d[7])); }

struct EpiOut {
    const bf16_t *SGA, *SGB, *SGX; bf16_t* MERGED;
    template <int POS> __device__ __forceinline__ void run(f32x4 (&acc)[2][2][4][2], const Unit& u, const bf16_t* SG0, const bf16_t* SG1, int wr, int wc, int fr, int fq) const {
        const int w4 = wr * 4 + wc, lane = fq * 16 + fr;
        const size_t base0 = native_slot(u.pm, u.pn, w4, 0, 0, 0, 0, lane);
        const u32x2* s0 = (const u32x2*)SG0 + base0; const u32x2* s1 = (const u32x2*)SG1 + base0;
        u32x2 ga[2][4], gb[2][4];
#define EO_ISSUE(e) do { ld4(ga[(e) & 1], s0 + (e) * 256); if (POS < 2) ld4(gb[(e) & 1], s1 + (e) * 256); } while (0)
#define EO_TIE(e) do { tie4(ga[(e) & 1]); if (POS < 2) tie4(gb[(e) & 1]); } while (0)
        EO_ISSUE(0); EO_ISSUE(1);
#pragma unroll
        for (int e = 0; e < 8; ++e) {
            if (POS < 2) { if (e < 7) asm volatile("s_waitcnt vmcnt(8)" ::: "memory"); else asm volatile("s_waitcnt vmcnt(0)" ::: "memory"); }
            else { if (e == 0) asm volatile("s_waitcnt vmcnt(4)" ::: "memory"); else if (e < 7) asm volatile("s_waitcnt vmcnt(8)" ::: "memory"); else asm volatile("s_waitcnt vmcnt(4)" ::: "memory"); }
            EO_TIE(e);
            const int ai = e >> 2, m = e & 3;
#pragma unroll
            for (int k = 0; k < 4; ++k) { const int bj = k >> 1, n = k & 1;
                const f32x4 num = unpk4(ga[e & 1][k]);
                if (POS < 2) { const f32x4 den = unpk4(gb[e & 1][k]); f32x4 r;
#pragma unroll
                    for (int j = 0; j < 4; ++j) r[j] = num[j] * __builtin_amdgcn_rcpf(fmaxf(den[j], 1e-30f));
                    acc[ai][bj][m][n] *= r;
                } else {
                    *(u32x2*)(MERGED + (size_t)(u.pm * 256 + ai * 128 + wr * 64 + m * 16 + fr) * 1024 + u.pn * 256 + bj * 128 + wc * 32 + n * 16 + fq * 4) = pk4(num * acc[ai][bj][m][n]);
                }
            }
            if (e + 2 < 8) EO_ISSUE(e + 2);
        }
#undef EO_ISSUE
#undef EO_TIE
    }
    __device__ __forceinline__ void operator()(f32x4 (&acc)[2][2][4][2], const Unit& u, int wr, int wc, int fr, int fq) const {
        if (u.kind < 2) run<0>(acc, u, SGA + ((size_t)u.kind << 25)  , u.kind == 0 ? SGB : SGX, wr, wc, fr, fq);
        else run<2>(acc, u, SGX, SGX, wr, wc, fr, fq);
    }
};
struct EpiWo {
    const float* X; bf16_t* HN; float* ROWSS;
    __device__ __forceinline__ void operator()(const f32x4 (&acc)[2][2][4][2], const Unit& u, int wr, int wc, int fr, int fq) const {
        const int w4 = wr * 4 + wc, lane = fq * 16 + fr;
#pragma unroll
        for (int ai = 0; ai < 2; ++ai) {
            f32x4 xv[4][2][2];
#pragma unroll
            for (int m = 0; m < 4; ++m)
#pragma unroll
                for (int bj = 0; bj < 2; ++bj)
#pragma unroll
                    for (int n = 0; n < 2; ++n)
                        xv[m][bj][n] = *(const f32x4*)(X + (size_t)(u.pm * 256 + ai * 128 + wr * 64 + m * 16 + fr) * 1024 + u.pn * 256 + bj * 128 + wc * 32 + n * 16 + fq * 4);
#pragma unroll
            for (int m = 0; m < 4; ++m) {
                const int row = u.pm * 256 + ai * 128 + wr * 64 + m * 16 + fr; float ss = 0.f;
#pragma unroll
                for (int bj = 0; bj < 2; ++bj)
#pragma unroll
                    for (int n = 0; n < 2; ++n) {
                        const u32x2 hw = pk4(xv[m][bj][n] + acc[ai][bj][m][n]); const f32x4 h = unpk4(hw);
                        ((u32x2*)HN)[native_slot(u.pm, u.pn, w4, ai, m, bj, n, lane)] = hw; ss += (h[0] * h[0] + h[1] * h[1]) + (h[2] * h[2] + h[3] * h[3]);
                    }
                ss += __shfl_xor(ss, 16); ss += __shfl_xor(ss, 32);
                if (fq == 0) unsafeAtomicAdd(ROWSS + row, ss);
            }
        }
    }
};

__device__ __forceinline__ int win_src_col(int R) {
    const int unit = R >> 8, rho = R & 255, kind = unit >> 4, cu = unit & 15;
    const int fqb = (rho >> 2) & 3;
    const int gi = ((rho >> 7) & 1) * 2 + ((rho >> 4) & 1), chl = ((rho >> 5) & 3) * 16 + (((fqb >> 1) | ((fqb & 1) << 1)) << 2) + (rho & 3);
    int base;
    if (kind == 0) base = gi * 1024;
    else if (kind == 1) base = (gi < 3) ? 4096 + gi * 1024 : 8192;
    else base = (gi == 0) ? 7168 : 9216 + (gi - 1) * 1024;
    return base + cu * 64 + chl;
}
__device__ __forceinline__ void p0_transpose_item(const float* W, int ldw, bf16_t* WT, int dst_row0, int k0, bool perm, LAS float* scr, int lane) {
    const int li = lane & 31; const int drow = dst_row0 + (perm ? ((li & 15) + ((li >> 4) << 5)) : li); const int scol = perm ? win_src_col(drow) : drow;
#pragma unroll
    for (int i = 0; i < 32; ++i) { const int kk = 2 * i + (lane >> 5); scr[kk * 33 + (lane & 31)] = W[(size_t)(k0 + kk) * ldw + scol]; }
    asm volatile("s_waitcnt lgkmcnt(0)" ::: "memory");
    const int c = lane & 7;
#pragma unroll
    for (int j = 0; j < 4; ++j) { const int n = (lane >> 3) + 8 * j; const LAS float* s = scr + (8 * c) * 33 + n;
        u32x4 o; o.x = pk_bf16(s[0 * 33], s[1 * 33]); o.y = pk_bf16(s[2 * 33], s[3 * 33]); o.z = pk_bf16(s[4 * 33], s[5 * 33]); o.w = pk_bf16(s[6 * 33], s[7 * 33]);
        const int orow = dst_row0 + (perm ? ((n & 15) + ((n >> 4) << 5)) : n);
        *(u32x4*)(WT + (size_t)orow * 1024 + k0 + 8 * c) = o; }
    asm volatile("s_waitcnt lgkmcnt(0)" ::: "memory");
}
__device__ __forceinline__ void rms_row_to_bf16(const float* xrow, const float* g, bf16_t* orow, int lane) {
    const f32x4* xr = (const f32x4*)xrow + lane; const f32x4* gr = (const f32x4*)g + lane;
    f32x4 v[4]; float s = 0.f;
#pragma unroll
    for (int j = 0; j < 4; ++j) { v[j] = xr[64 * j]; s += (v[j][0] * v[j][0] + v[j][1] * v[j][1]) + (v[j][2] * v[j][2] + v[j][3] * v[j][3]); }
    const float rstd = 1.0f / sqrtf(wave_sum(s) * (1.f / 1024.f) + EPS);
    u32x2* o8 = (u32x2*)orow + lane;
#pragma unroll
    for (int j = 0; j < 4; ++j) { const f32x4 gg = gr[64 * j]; o8[64 * j] = pk4(v[j] * rstd * gg); }
}

template <int PH>
__device__ __forceinline__ void conv31_chunk(LAS unsigned char* lds, LAS float* red, LAS float* stats, const bf16_t* GLU, bf16_t* SZB, const float* cw, const float* cb, const float* lng, const float* lnb,
                                            const int t0, const bool has_next, const int tid_in) {
    int tid_o = tid_in; asm volatile("" : "+v"(tid_o));
    const int tid = tid_o, lane = tid & 63, wid = tid >> 6, c2 = tid * 2;
    u32x4 nx[4];
    if (has_next) {
        int tf = tid; asm volatile("" : "+v"(tf));
#pragma unroll
        for (int q = 0; q < 4; ++q) { const int i = tf + q * 512; nx[q] = *(const u32x4*)(GLU + (size_t)(t0 + 16 + (i >> 7)) * 1024 + (i & 127) * 8); }
    }
    const f32x2 bias = *(const f32x2*)(cb + c2);
    f32x2 outv[16];
#pragma unroll
    for (int t = 0; t < 16; ++t) outv[t] = bias;
#pragma unroll
    for (int ps = 0; ps < 2; ++ps) {
        const int kb = ps * 16, ntap = ps == 0 ? 16 : 15;
        f32x2 w[16];
#pragma unroll
        for (int k = 0; k < 16; ++k) if (k < ntap) w[k] = *(const f32x2*)(cw + (kb + k) * 1024 + c2);
#pragma unroll
        for (int r = 0; r < 31; ++r) if (r < ntap + 15) {
            const unsigned v = *(const LAS unsigned*)(lds + ((34 + 16 * PH + kb + r) & 63) * 2048 + tid * 4);
            const f32x2 x = (f32x2){bf_lo(v), bf_hi(v)};
#pragma unroll
            for (int t = 0; t < 16; ++t) { const int k = r - t; if (k >= 0 && k < ntap) outv[t] = __builtin_elementwise_fma(w[k], x, outv[t]); }
            if ((r & 7) == 7) asm volatile("" ::: "memory");
        }
    }
    {
        float s[16], q[16];
#pragma unroll
        for (int t = 0; t < 16; ++t) { s[t] = outv[t][0] + outv[t][1]; q[t] = outv[t][0] * outv[t][0] + outv[t][1] * outv[t][1]; }
#pragma unroll
        for (int lvl = 0; lvl < 4; ++lvl) {
            const int half = 8 >> lvl, off = 32 >> lvl; const bool hi = (lane & off) != 0;
#pragma unroll
            for (int i = 0; i < half; ++i) {
                const float ks = hi ? s[i + half] : s[i], ss = hi ? s[i] : s[i + half]; s[i] = ks + __shfl_xor(ss, off);
                const float kq = hi ? q[i + half] : q[i], sq = hi ? q[i] : q[i + half]; q[i] = kq + __shfl_xor(sq, off);
            }
        }
        s[0] += __shfl_xor(s[0], 2); q[0] += __shfl_xor(q[0], 2);
        s[0] += __shfl_xor(s[0], 1); q[0] += __shfl_xor(q[0], 1);
        if ((lane & 3) == 0) *(LAS f32x2*)(red + ((lane >> 2) * 8 + wid) * 2) = (f32x2){s[0], q[0]};
    }
    __syncthreads();
    if (has_next) {
#pragma unroll
        for (int q = 0; q < 4; ++q) { const int i = tid + q * 512; *(LAS u32x4*)(lds + ((34 + 16 * PH + 46 + (i >> 7)) & 63) * 2048 + (i & 127) * 16) = nx[q]; }
    }
    if (tid < 16) {
        float S = 0.f, Q2 = 0.f;
#pragma unroll
        for (int wv = 0; wv < 8; ++wv) { const f32x2 t = *(const LAS f32x2*)(red + (tid * 8 + wv) * 2); S += t[0]; Q2 += t[1]; }
        const float mean = S * (1.f / 1024.f), var = fmaxf(Q2 * (1.f / 1024.f) - mean * mean, 0.f);
        *(LAS f32x2*)(stats + tid * 2) = (f32x2){mean, 1.0f / sqrtf(var + EPS)};
    }
    __syncthreads();
    const f32x2 lg = *(const f32x2*)(lng + c2), lb = *(const f32x2*)(lnb + c2);
    unsigned zz[16];
#pragma unroll
    for (int t = 0; t < 16; ++t) zz[t] = *(const unsigned*)(SZB + (size_t)(t0 + t) * 1024 + c2);
#pragma unroll
    for (int t = 0; t < 16; ++t) {
        const f32x2 st = *(const LAS f32x2*)(stats + t * 2);
        const float y0 = (outv[t][0] - st[0]) * st[1] * lg[0] + lb[0], y1 = (outv[t][1] - st[0]) * st[1] * lg[1] + lb[1];
        *(unsigned*)(SZB + (size_t)(t0 + t) * 1024 + c2) = pk_bf16(bf_lo(zz[t]) * siluf_(y0), bf_hi(zz[t]) * siluf_(y1));
    }
}
__device__ __forceinline__ void conv31_phase(LAS unsigned char* lds, const bf16_t* GLU, bf16_t* SZB, const float* cw, const float* cb, const float* lng, const float* lnb, int G, int c, const int widx) {
    int tid_ = tid_of(widx); asm volatile("" : "+v"(tid_));
    const int tid = tid_;
    LAS float* red = (LAS float*)(lds + 131072 + 1024);
    LAS float* stats = (LAS float*)(lds + 131072 + 3072);
    for (int run = c; run < NTOK / 128; run += G) {
        const int T0 = run * 128, tpos = T0 & (SEQ - 1);
        __syncthreads();
#pragma unroll
        for (int h = 0; h < 2; ++h) {
            int tf = tid; asm volatile("" : "+v"(tf));
            u32x4 tv[6];
#pragma unroll
            for (int q = 0; q < 6; ++q) { const int i = tf + (h * 6 + q) * 512, r = (i >> 7) < 46 ? (i >> 7) : 45; const int gr = (tpos - 30 + r >= 0) ? (T0 - 30 + r) : T0;
                tv[q] = *(const u32x4*)(GLU + (size_t)gr * 1024 + (i & 127) * 8); }
#pragma unroll
            for (int q = 0; q < 6; ++q) { const int i = tf + (h * 6 + q) * 512, r = i >> 7;
                if (r < 46) *(LAS u32x4*)(lds + ((34 + r) & 63) * 2048 + (i & 127) * 16) = (tpos - 30 + r >= 0) ? tv[q] : (u32x4){0u, 0u, 0u, 0u}; }
        }
        __syncthreads();
        conv31_chunk<0>(lds, red, stats, GLU, SZB, cw, cb, lng, lnb, T0, true, tid);
        conv31_chunk<1>(lds, red, stats, GLU, SZB, cw, cb, lng, lnb, T0 + 16, true, tid);
        conv31_chunk<2>(lds, red, stats, GLU, SZB, cw, cb, lng, lnb, T0 + 32, true, tid);
        conv31_chunk<3>(lds, red, stats, GLU, SZB, cw, cb, lng, lnb, T0 + 48, true, tid);
        conv31_chunk<0>(lds, red, stats, GLU, SZB, cw, cb, lng, lnb, T0 + 64, true, tid);
        conv31_chunk<1>(lds, red, stats, GLU, SZB, cw, cb, lng, lnb, T0 + 80, true, tid);
        conv31_chunk<2>(lds, red, stats, GLU, SZB, cw, cb, lng, lnb, T0 + 96, true, tid);
        conv31_chunk<3>(lds, red, stats, GLU, SZB, cw, cb, lng, lnb, T0 + 112, false, tid);
    }
    __syncthreads();
}

__global__ void __launch_bounds__(512, 2) fwd_megakernel(Params p) {
    extern __shared__ __attribute__((aligned(16))) unsigned char lds_raw[];
    LAS unsigned char* lds = (LAS unsigned char*)lds_raw;
    const int G = gridDim.x, bx = blockIdx.x;
    unsigned char* ws = p.ws; unsigned char* ob = (unsigned char*)p.out;
    const float *x = p.in[0], *mem = p.in[1], *norm_g = p.in[2], *w_in = p.in[3], *conv_a_w = p.in[4], *w_out_a = p.in[5], *conv_b_w = p.in[6], *conv_b_b = p.in[7],
                *ln_b_g = p.in[8], *ln_b_b = p.in[9], *w_out_b = p.in[10], *mem_norm_g = p.in[11], *w_kv = p.in[12], *w_out_x = p.in[13], *w_o = p.in[14], *final_g = p.in[15];
    bf16_t *WIN = (bf16_t*)(ws + WS_WIN), *WOUT = (bf16_t*)(ws + WS_WOUT), *WO = (bf16_t*)(ws + WS_WO), *WKV = (bf16_t*)(ws + WS_WKV), *MEMN = (bf16_t*)(ws + WS_MEMN),
           *KB = (bf16_t*)(ws + WS_KB), *VT = (bf16_t*)(ws + WS_VT), *PAT = (bf16_t*)(ws + WS_PAT), *GAH = (bf16_t*)(ws + WS_GAH), *HA = (bf16_t*)(ws + WS_HA), *SZB = (bf16_t*)(ws + WS_SZB),
           *SZX = (bf16_t*)(ws + WS_SZX), *GLU = (bf16_t*)(ws + WS_GLU), *Q = (bf16_t*)(ws + WS_Q), *SGA = (bf16_t*)(ws + WS_SGA), *SGB = (bf16_t*)(ws + WS_SGB),
           *U = (bf16_t*)(ob + OUT_U), *SGX = (bf16_t*)(ob + OUT_SGX);
    float *ROWSS = (float*)(ws + WS_ROWSS), *RSUM = (float*)(ws + WS_RSUM);
    bf16_t* MERGED = GLU;
    volatile LAS unsigned* xst = (volatile LAS unsigned*)(lds + 131072 + 512);
    const int widx = __builtin_amdgcn_readfirstlane((int)threadIdx.x >> 6);
    if (threadIdx.x < 4) xst[threadIdx.x] = 0u;
    __syncthreads();
    XcdBarrier xb = xcd_barrier_post((unsigned*)(ws + WS_BAR), xst, threadIdx.x == 0);

    {
        int tid_ = tid_of(widx); asm volatile("" : "+v"(tid_)); const int tid = tid_, lane = tid & 63, wave = tid >> 6;
        LAS float* scr = (LAS float*)(lds + wave * 16384);
        const int gw = bx * 8 + wave, NGW = G * 8;
        for (int it = gw; it < 9216; it += NGW) {
            int r = it;
            if (r < 6144) { const int g = r % 384; p0_transpose_item(w_in, 12288, WIN, (g >> 1) * 64 + (g & 1) * 16, (r / 384) * 64, true, scr, lane); continue; } r -= 6144;
            if (r < 512) { p0_transpose_item(w_out_a, 1024, WOUT, (r & 31) * 32, (r >> 5) * 64, false, scr, lane); continue; } r -= 512;
            if (r < 512) { p0_transpose_item(w_out_b, 1024, WOUT + (size_t)1024 * 1024, (r & 31) * 32, (r >> 5) * 64, false, scr, lane); continue; } r -= 512;
            if (r < 512) { p0_transpose_item(w_out_x, 1024, WOUT + (size_t)2048 * 1024, (r & 31) * 32, (r >> 5) * 64, false, scr, lane); continue; } r -= 512;
            if (r < 512) { p0_transpose_item(w_o, 1024, WO, (r & 31) * 32, (r >> 5) * 64, false, scr, lane); continue; } r -= 512;
            p0_transpose_item(w_kv, 2048, WKV, (r & 63) * 32, (r >> 6) * 64, false, scr, lane);
        }
        {
            const f32x4* gr = (const f32x4*)norm_g + lane; f32x4 gg[4];
#pragma unroll
            for (int j = 0; j < 4; ++j) gg[j] = gr[64 * j];
            for (int m = gw; m < NTOK; m += 4 * NGW) {
                f32x4 v[4][4];
#pragma unroll
                for (int r = 0; r < 4; ++r) { const f32x4* xr = (const f32x4*)(x + (size_t)(m + r * NGW) * 1024) + lane;
#pragma unroll
                    for (int j = 0; j < 4; ++j) v[r][j] = xr[64 * j]; }
#pragma unroll
                for (int r = 0; r < 4; ++r) {
                    float sq = 0.f;
#pragma unroll
                    for (int j = 0; j < 4; ++j) sq += (v[r][j][0] * v[r][j][0] + v[r][j][1] * v[r][j][1]) + (v[r][j][2] * v[r][j][2] + v[r][j][3] * v[r][j][3]);
                    const float rstd = 1.0f / sqrtf(wave_sum(sq) * (1.f / 1024.f) + EPS);
                    u32x2* o8 = (u32x2*)(U + (size_t)(m + r * NGW) * 1024) + lane;
#pragma unroll
                    for (int j = 0; j < 4; ++j) o8[64 * j] = pk4(v[r][j] * rstd * gg[j]);
                }
            }
        }
        for (int m = gw; m < 1024; m += NGW) rms_row_to_bf16(mem + (size_t)m * 1024, mem_norm_g, MEMN + (size_t)m * 1024, lane);
        for (int i = bx * 512 + tid; i < NTOK * 5; i += G * 512) ROWSS[i] = 0.f;
    }
    GRID_SYNC();

    {
        SchedP1 S{(const char*)U, (const char*)WIN, (const char*)MEMN, (const char*)WKV, G, bx};
        EpiP1 E{HA, GLU, SZB, SZX, Q, SGA, SGB, SGX, KB, VT, PAT, GAH, conv_a_w};
        gemm_phase(lds, 1024, 1024, 1024, S, E, widx);
    }
    GRID_SYNC();

    {
        int tid_ = tid_of(widx); asm volatile("" : "+v"(tid_)); const int tid = tid_;
        for (int i = bx * 512 + tid; i < 512 * 256; i += G * 512) {
            const int blk = i >> 8, ch = (i & 255) * 4;
            if ((blk & 127) != 0) {
                const f32x4 w0 = *(const f32x4*)(conv_a_w + ch), w1 = *(const f32x4*)(conv_a_w + 1024 + ch);
                const f32x4 pt0 = unpk4(*(const u32x2*)(PAT + (size_t)((blk - 1) * 2 + 0) * 1024 + ch)), pt1 = unpk4(*(const u32x2*)(PAT + (size_t)((blk - 1) * 2 + 1) * 1024 + ch));
                const f32x4 g0 = unpk4(*(const u32x2*)(GAH + (size_t)(blk * 2 + 0) * 1024 + ch)), g1 = unpk4(*(const u32x2*)(GAH + (size_t)(blk * 2 + 1) * 1024 + ch));
                u32x2* h0 = (u32x2*)(HA + (size_t)(blk * 64) * 1024 + ch); u32x2* h1 = (u32x2*)(HA + (size_t)(blk * 64 + 1) * 1024 + ch);
                *h0 = pk4(unpk4(*h0) + g0 * (w1 * pt1 + w0 * pt0));
                *h1 = pk4(unpk4(*h1) + g1 * (w0 * pt1));
            }
        }
        { SchedAttn S{(const char*)Q, (const char*)KB, TILE, (size_t)512, G, bx}; EpiS E{Q, RSUM}; gemm_phase(lds, 1024, 1024, 256, S, E, widx); }
        conv31_phase(lds, GLU, SZB, conv_b_w, conv_b_b, ln_b_g, ln_b_b, G, bx, widx);
    }
    asm volatile("s_waitcnt vmcnt(0) lgkmcnt(0)" ::: "memory"); __syncthreads();
    __builtin_amdgcn_fence(__ATOMIC_ACQUIRE, "agent"); asm volatile("s_waitcnt vmcnt(0)" ::: "memory"); __syncthreads();

    { SchedAttn S{(const char*)Q, (const char*)VT, (size_t)1024 * 256 * 2, (size_t)256 * 256 * 2, G, bx}; EpiPV E{SZX, U  , RSUM}; gemm_phase(lds, 1024, 256, 256, S, E, widx); }
    GRID_SYNC();

    { SchedOut S{(const char*)HA, (const char*)U, (const char*)WOUT, G, bx}; EpiOut E{SGA, SGB, SGX, MERGED}; gemm_phase(lds, 1024, 1024, 1024, S, E, widx); }
    GRID_SYNC();

    { SchedWo S{(const char*)MERGED, (const char*)WO, G, bx}; EpiWo E{x, HA  , ROWSS}; gemm_phase(lds, 1024, 1024, 1024, S, E, widx); }
    GRID_SYNC();

    {
        int tid_ = tid_of(widx); asm volatile("" : "+v"(tid_)); const int lane = tid_ & 63, w4 = tid_ >> 6, wr = w4 >> 2, wc = w4 & 3, fr = lane & 15, fq = lane >> 4;
        for (int L = bx; L < 512; L += G) {
            int pm, pn; remap_tile(L, 128, 4, pm, pn);
#pragma unroll
            for (int ai = 0; ai < 2; ++ai) {
                u32x2 hv[4][2][2]; float rs[4]; f32x4 gg[2][2];
#pragma unroll
                for (int m = 0; m < 4; ++m) {
                    rs[m] = ROWSS[pm * 256 + ai * 128 + wr * 64 + m * 16 + fr];
#pragma unroll
                    for (int bj = 0; bj < 2; ++bj)
#pragma unroll
                        for (int n = 0; n < 2; ++n) hv[m][bj][n] = ((const u32x2*)HA)[native_slot(pm, pn, w4, ai, m, bj, n, fq * 16 + fr)];
                }
#pragma unroll
                for (int bj = 0; bj < 2; ++bj)
#pragma unroll
                    for (int n = 0; n < 2; ++n) gg[bj][n] = *(const f32x4*)(final_g + pn * 256 + bj * 128 + wc * 32 + n * 16 + fq * 4);
#pragma unroll
                for (int m = 0; m < 4; ++m) {
                    const float rstd = 1.0f / sqrtf(rs[m] * (1.f / 1024.f) + EPS);
#pragma unroll
                    for (int bj = 0; bj < 2; ++bj)
#pragma unroll
                        for (int n = 0; n < 2; ++n)
                            *(f32x4*)(p.out + (size_t)(pm * 256 + ai * 128 + wr * 64 + m * 16 + fr) * 1024 + pn * 256 + bj * 128 + wc * 32 + n * 16 + fq * 4) = unpk4(hv[m][bj][n]) * rstd * gg[bj][n];
                }
            }
        }
    }
}

extern "C" void kernel_launch(void* const* d_in, const int* in_sizes, int n_in, void* d_out, int out_size, void* d_ws, size_t ws_size, hipStream_t stream) {
    static int grid_blocks = 0;
    if (!grid_blocks) {
        int dev = 0, cus = 0, per_cu = 0;
        hipGetDevice(&dev);
        hipDeviceGetAttribute(&cus, hipDeviceAttributeMultiprocessorCount, dev);
        hipFuncSetAttribute((const void*)fwd_megakernel, hipFuncAttributeMaxDynamicSharedMemorySize, LDS_BYTES);
        hipOccupancyMaxActiveBlocksPerMultiprocessor(&per_cu, (const void*)fwd_megakernel, 512, LDS_BYTES);
        if (per_cu < 1) { fprintf(stderr, "kernel_launch: occupancy query reports %d blocks per CU\n", per_cu); per_cu = 1; }
        if (per_cu > 1) per_cu = 1;
        grid_blocks = cus * per_cu;
        if (ws_size < WS_END) fprintf(stderr, "kernel_launch: workspace too small: %zu < %zu\n", ws_size, (size_t)WS_END);
    }
    (void)hipMemsetAsync((char*)d_ws + WS_BAR, 0, XCD_BAR_WORDS * 4, stream);
    if (ws_size < WS_END) return;
    Params p{};
    for (int i = 0; i < 16; ++i) p.in[i] = (const float*)d_in[i];
    p.out = (float*)d_out; p.ws = (unsigned char*)d_ws;
    void* args[] = {&p};
    hipError_t e = hipLaunchCooperativeKernel((const void*)fwd_megakernel, dim3(grid_blocks), dim3(512), args, LDS_BYTES, stream);
    if (e != hipSuccess) fprintf(stderr, "cooperative launch failed: %s (grid %d)\n", hipGetErrorString(e), grid_blocks);
}
```

```cpp
#include <hip/hip_runtime.h>
#include <cstdio>

#define LAS __attribute__((address_space(3)))
typedef unsigned short bf16_t;
typedef short bf16x8 __attribute__((ext_vector_type(8)));
typedef float f32x4 __attribute__((ext_vector_type(4)));
typedef float f32x2 __attribute__((ext_vector_type(2)));
typedef unsigned u32x4 __attribute__((ext_vector_type(4)));
typedef unsigned u32x2 __attribute__((ext_vector_type(2)));

constexpr int BM = 256, BK = 64, HALF = 128, HTB = HALF * BK * 2, STAGE_BYTES = 8 * HTB;
constexpr int LDS_BYTES = 147456;
constexpr int NTOK = 32768, DM = 1024, SEQ = 8192;
constexpr float EPS = 1e-6f;
constexpr size_t MiB = 1u << 20;
constexpr size_t TILE = (size_t)256 * 1024 * 2;
constexpr size_t WS_WIN = 0, WS_WOUT = 24 * MiB, WS_WO = 30 * MiB, WS_WKV = 32 * MiB, WS_MEMN = 36 * MiB, WS_KB = 38 * MiB, WS_VT = 40 * MiB;
constexpr size_t WS_ROWSS = 42 * MiB, WS_RSUM = 42 * MiB + 131072, WS_PAT = 43 * MiB, WS_GAH = 45 * MiB;
constexpr size_t WS_BAR = 47 * MiB;
constexpr size_t WS_HA = 48 * MiB, WS_SZB = 112 * MiB, WS_SZX = 176 * MiB, WS_GLU = 240 * MiB, WS_Q = 304 * MiB, WS_SGA = 368 * MiB, WS_SGB = 432 * MiB, WS_END = 496 * MiB;
constexpr size_t OUT_U = 0, OUT_SGX = 64 * MiB;

#define XB_TMO      128
#define XB_XCNT(j)  (256  + 64 * (j))
#define XB_XSUB(j)  (1280 + 64 * (j))
#define XB_XGEN(j)  (2304 + 64 * (j))
#define XB_TOP      3328
#define XB_TOPGEN   3392
#define XCD_BAR_WORDS 3456
#define XB_SPIN_CAP (1u << 18)

__device__ __forceinline__ unsigned xb_ld(unsigned* p)              { return __hip_atomic_load(p, __ATOMIC_RELAXED, __HIP_MEMORY_SCOPE_AGENT); }
__device__ __forceinline__ unsigned xb_add(unsigned* p, unsigned v) { return __hip_atomic_fetch_add(p, v, __ATOMIC_RELAXED, __HIP_MEMORY_SCOPE_AGENT); }
__device__ __forceinline__ unsigned xb_xcc_id() { return (unsigned)__builtin_amdgcn_s_getreg((3 << 11) | 20) & 0xFu; }
#define XB_SPIN(cond, bar) do { unsigned _sp = 0; while (cond) { __builtin_amdgcn_s_sleep(1); \
    if ((++_sp & 255u) == 0u) { if (xb_ld(&(bar)[XB_TMO])) break; if (_sp > XB_SPIN_CAP) { atomicAdd(&(bar)[XB_TMO], 1u); break; } } } } while (0)

struct XcdBarrier {
    unsigned* bar; unsigned x;
    volatile LAS unsigned* st;
};

__device__ __forceinline__ XcdBarrier xcd_barrier_post(unsigned* bar, volatile LAS unsigned* st, bool leader) {
    XcdBarrier b; b.bar = bar; b.x = xb_xcc_id(); b.st = st;
    if (leader) (void)xb_add(&bar[XB_XCNT(b.x)], 1u);
    return b;
}
__device__ __forceinline__ void xcd_barrier_complete(unsigned* bar, unsigned x, unsigned& nloc, unsigned& nx) {
    const unsigned G = gridDim.x * gridDim.y * gridDim.z;
    unsigned sum, cnt, mine, sp = 0u;
    for (;;) {
        sum = 0u; cnt = 0u; mine = 0u;
#pragma unroll
        for (unsigned j = 0; j < 16; ++j) { const unsigned c = xb_ld(&bar[XB_XCNT(j)]); sum += c; cnt += (c > 0u) ? 1u : 0u; mine = (j == x) ? c : mine; }
        if (sum == G) break;
        __builtin_amdgcn_s_sleep(1);
        if ((++sp & 255u) == 0u) { if (xb_ld(&bar[XB_TMO])) break; if (sp > XB_SPIN_CAP) { atomicAdd(&bar[XB_TMO], 1u); break; } }
    }
    nloc = mine > 0u ? mine : 1u; nx = cnt > 0u ? cnt : 1u;
}

__device__ __forceinline__ void xcd_barrier(const XcdBarrier& b, bool leader) {
    asm volatile("s_waitcnt vmcnt(0)" ::: "memory");
    __syncthreads();
    if (leader) {
        unsigned* bar = b.bar;
        __builtin_amdgcn_s_waitcnt(0);
        unsigned nloc = b.st[0], nx = b.st[1];
        if (nloc == 0u) { xcd_barrier_complete(bar, b.x, nloc, nx); b.st[0] = nloc; b.st[1] = nx; }
        const unsigned old = xb_add(&bar[XB_XSUB(b.x)], 1u);
        const unsigned gen = old / nloc;
        if (old + 1u == (gen + 1u) * nloc) {
            __builtin_amdgcn_fence(__ATOMIC_RELEASE, "agent");
            asm volatile("s_waitcnt vmcnt(0)" ::: "memory");
            const unsigned og = xb_add(&bar[XB_TOP], 1u);
            const unsigned tg = og / nx;
            if (og + 1u == (tg + 1u) * nx) xb_add(&bar[XB_TOPGEN], 1u);
            else XB_SPIN(xb_ld(&bar[XB_TOPGEN]) == tg, bar);
            __builtin_amdgcn_fence(__ATOMIC_ACQUIRE, "agent");
            xb_add(&bar[XB_XGEN(b.x)], 1u);
            asm volatile("s_waitcnt vmcnt(0)" ::: "memory");
        } else {
            XB_SPIN(xb_ld(&bar[XB_XGEN(b.x)]) == gen, bar);
            __builtin_amdgcn_fence(__ATOMIC_ACQUIRE, "agent");
            asm volatile("s_waitcnt vmcnt(0)" ::: "memory");
        }
    }
    __syncthreads();
}

#define GRID_SYNC() xcd_barrier(xb, tid_of(widx) == 0)

struct Params { const float* in[16]; float* out; unsigned char* ws; };

typedef __bf16 bf16x2_t __attribute__((ext_vector_type(2)));
__device__ __forceinline__ unsigned pk_bf16(float lo, float hi) { const f32x2 v = {lo, hi}; return __builtin_bit_cast(unsigned, __builtin_convertvector(v, bf16x2_t)); }
__device__ __forceinline__ float bf_lo(unsigned u) { return __uint_as_float(u << 16); }
__device__ __forceinline__ float bf_hi(unsigned u) { return __uint_as_float(u & 0xffff0000u); }
__device__ __forceinline__ float sigmoidf_(float x) { return __builtin_amdgcn_rcpf(1.0f + __builtin_amdgcn_exp2f(-1.44269504089f * x)); }
__device__ __forceinline__ float siluf_(float x) { return x * sigmoidf_(x); }
__device__ __forceinline__ u32x2 pk4(f32x4 v) { u32x2 r; r.x = pk_bf16(v[0], v[1]); r.y = pk_bf16(v[2], v[3]); return r; }
__device__ __forceinline__ f32x4 unpk4(u32x2 v) { return (f32x4){bf_lo(v.x), bf_hi(v.x), bf_lo(v.y), bf_hi(v.y)}; }
template <int CTRL> __device__ __forceinline__ float dppf(float old, float v) { return __int_as_float(__builtin_amdgcn_update_dpp(__float_as_int(old), __float_as_int(v), CTRL, 0xf, 0xf, false)); }
__device__ __forceinline__ float wave_sum(float v) {
#pragma unroll
    for (int o = 1; o < 64; o <<= 1) v += __shfl_xor(v, o);
    return v;
}

__device__ __forceinline__ int lds_byte(int r, int c) { const int st = (r >> 4) * 2 + (c >> 5), rr = r & 15, cc = c & 31, ob = rr * 64 + cc * 2; return st * 1024 + (ob ^ (((ob >> 9) & 1) << 5)); }
__device__ __forceinline__ void stage_rc(int b, int& R, int& C) { const int st = b / 1024, sb = b % 1024, swz = sb ^ (((sb >> 9) & 1) << 5); R = (st >> 1) * 16 + swz / 64; C = (st & 1) * 32 + (swz % 64) / 2; }

__device__ __forceinline__ int tid_of(int widx) { int l; asm volatile("v_mbcnt_lo_u32_b32 %0, -1, 0\n\tv_mbcnt_hi_u32_b32 %0, -1, %0" : "=v"(l)); return widx * 64 + l; }
struct Unit { const char* A; const char* B; int pm, pn, kind; };
__device__ __forceinline__ size_t native_slot(int pm, int pn4, int w4, int ai, int m, int bj, int n, int lane) {
    return ((((size_t)(pm * 4 + pn4) * 8 + w4) * 32 + (((ai * 4 + m) * 2 + bj) * 2 + n)) * 64 + lane);
}

template <int WG = 8> __device__ __forceinline__ void remap_tile(int L, int nM, int nN, int& pm, int& pn) {
    const int nwg = nM * nN; int wgid = L;
    { const int q = nwg / 8, r = nwg % 8, xcd = wgid % 8, off = wgid / 8; wgid = (xcd < r ? xcd * (q + 1) : r * (q + 1) + (xcd - r) * q) + off; }
    const int nig = WG * nN, gid = wgid / nig, fm = gid * WG, gsz = (nM - fm) < WG ? (nM - fm) : WG;
    pm = fm + ((wgid % nig) % gsz); pn = (wgid % nig) / gsz;
}

struct EpiOut;
template <class Epi> __device__ __forceinline__ bool epi_keeps(const Epi&, const Unit&) { return false; }
__device__ __forceinline__ bool epi_keeps(const EpiOut&, const Unit& u) { return u.kind < 2; }
template <class Epi, class Sched>
__device__ __forceinline__ void gemm_phase(LAS unsigned char* lds, const int lda, const int ldb, const int K, const Sched& S, const Epi& E, const int widx) {
    int tid_ = tid_of(widx); asm volatile("" : "+v"(tid_));
    const int tid = tid_, wid = __builtin_amdgcn_readfirstlane(tid >> 6), lane = tid & 63, wr = wid >> 2, wc = wid & 3, fr = lane & 15, fq = lane >> 4;
    const int nt = K / BK;
    unsigned voffA[2], voffB[2];
#pragma unroll
    for (int i = 0; i < 2; ++i) { int R, C; stage_rc(tid * 16 + i * 8192, R, C); voffA[i] = (unsigned)(R * lda + C) * 2u; voffB[i] = (unsigned)(R * ldb + C) * 2u; }
    const size_t kstep = (size_t)(BK * 2);
    const size_t hstepA = (size_t)HALF * lda * 2, hstepB = (size_t)HALF * ldb * 2;
    const unsigned ldsw = (unsigned)wid * 1024u;
    const int aoff = lds_byte(wr * 64 + fr, fq * 8), boff = lds_byte(wc * 32 + fr, fq * 8);
#define GP_SA(b, h) (((b) * 2 + (h)) * HTB)
#define GP_SB(b, h) ((4 + (b) * 2 + (h)) * HTB)
#define GP_STAGE(bufoff, gbase, voff) do { _Pragma("unroll") for (int _i = 0; _i < 2; ++_i) \
        __builtin_amdgcn_global_load_lds((const unsigned*)((const char*)(gbase) + (voff)[_i]), (LAS unsigned*)(lds + (bufoff) + ldsw + _i * 8192), 16, 0, 0); } while (0)
#define GP_LDA(dst, b, h) do { _Pragma("unroll") for (int m = 0; m < 4; ++m) _Pragma("unroll") for (int k = 0; k < 2; ++k) dst[m][k] = *(const LAS bf16x8*)(lds + GP_SA(b, h) + aoff + m * 2048 + k * 1024); } while (0)
#define GP_LDB(dst, b, h) do { _Pragma("unroll") for (int n = 0; n < 2; ++n) _Pragma("unroll") for (int k = 0; k < 2; ++k) dst[n][k] = *(const LAS bf16x8*)(lds + GP_SB(b, h) + boff + n * 2048 + k * 1024); } while (0)
#define GP_MMA(ai, bj, At, Bt) do { __builtin_amdgcn_s_setprio(1); _Pragma("unroll") for (int m = 0; m < 4; ++m) _Pragma("unroll") for (int n = 0; n < 2; ++n) _Pragma("unroll") for (int k = 0; k < 2; ++k) \
        acc[ai][bj][m][n] = __builtin_amdgcn_mfma_f32_16x16x32_bf16(Bt[n][k], At[m][k], acc[ai][bj][m][n], 0, 0, 0); __builtin_amdgcn_s_setprio(0); } while (0)
#define GP_WAIT_V(n) asm volatile("s_waitcnt vmcnt(" #n ")" ::: "memory")
#define GP_WAIT_L(n) asm volatile("s_waitcnt lgkmcnt(" #n ")" ::: "memory")
#define GP_BAR __builtin_amdgcn_s_barrier()
#define GP_SCHED __builtin_amdgcn_sched_barrier(0)
    Unit cur, nxt; int ui = 0;
    if (!S.next(0, cur)) return;
    f32x4 acc[2][2][4][2];
#pragma unroll
    for (int a = 0; a < 2; ++a)
#pragma unroll
        for (int b = 0; b < 2; ++b)
#pragma unroll
            for (int m = 0; m < 4; ++m)
#pragma unroll
                for (int n = 0; n < 2; ++n) acc[a][b][m][n] = (f32x4){0.f, 0.f, 0.f, 0.f};
    bf16x8 At[4][2], B0[2][2], B1[2][2];
    const char* cA = cur.A; const char* cB = cur.B;
    GP_STAGE(GP_SB(0, 0), cB, voffB); GP_STAGE(GP_SB(0, 1), cB + hstepB, voffB); GP_STAGE(GP_SA(0, 0), cA, voffA); GP_STAGE(GP_SA(0, 1), cA + hstepA, voffA);
    if (wr == 1) GP_BAR;
    GP_WAIT_V(2); GP_BAR;
    GP_STAGE(GP_SB(1, 0), cB + kstep, voffB); GP_STAGE(GP_SA(1, 0), cA + kstep, voffA); GP_STAGE(GP_SB(1, 1), cB + hstepB + kstep, voffB);
    GP_WAIT_V(6); GP_BAR;
    for (;;) {
        const bool has_next = S.next(ui + 1, nxt);
        const char* nA = has_next ? nxt.A : cA; const char* nB = has_next ? nxt.B : cB;
        for (int t = 0; t < nt; t += 2) {
            const bool last = (t == nt - 2);
            const char* a1 = cA + (size_t)(t + 1) * kstep;
            const char* a2 = last ? nA : cA + (size_t)(t + 2) * kstep; const char* b2 = last ? nB : cB + (size_t)(t + 2) * kstep;
            const char* a3 = a2 + kstep; const char* b3 = b2 + kstep;
            GP_LDB(B0, 0, 0); GP_LDB(B1, 0, 1); GP_SCHED; GP_LDA(At, 0, 0); GP_STAGE(GP_SA(1, 1), a1 + hstepA, voffA);
            GP_WAIT_V(8); GP_WAIT_L(0); GP_BAR; GP_MMA(0, 0, At, B0); GP_MMA(0, 1, At, B1); GP_BAR; GP_SCHED;
            GP_LDA(At, 0, 1); GP_STAGE(GP_SB(0, 0), b2, voffB); GP_STAGE(GP_SB(0, 1), b2 + hstepB, voffB); GP_STAGE(GP_SA(0, 0), a2, voffA);
            GP_WAIT_V(8); GP_WAIT_L(0); GP_BAR; GP_MMA(1, 0, At, B0); GP_MMA(1, 1, At, B1); GP_BAR; GP_SCHED;
            GP_LDB(B0, 1, 0); GP_LDB(B1, 1, 1); GP_SCHED; GP_LDA(At, 1, 0); GP_STAGE(GP_SA(0, 1), a2 + hstepA, voffA);
            GP_WAIT_V(8); GP_WAIT_L(0); GP_BAR; GP_MMA(0, 0, At, B0); GP_MMA(0, 1, At, B1); GP_BAR; GP_SCHED;
            GP_LDA(At, 1, 1); GP_STAGE(GP_SB(1, 0), b3, voffB); GP_STAGE(GP_SB(1, 1), b3 + hstepB, voffB); GP_STAGE(GP_SA(1, 0), a3, voffA);
            GP_WAIT_V(8); GP_WAIT_L(0); GP_BAR; GP_MMA(1, 0, At, B0); GP_MMA(1, 1, At, B1); GP_BAR; GP_SCHED;
        }
        if (wr == 0) GP_BAR;
        E(acc, cur, wr, wc, fr, fq);
        if (!has_next) break;
        if (!epi_keeps(E, cur)) {
#pragma unroll
        for (int a = 0; a < 2; ++a)
#pragma unroll
            for (int b = 0; b < 2; ++b)
#pragma unroll
                for (int m = 0; m < 4; ++m)
#pragma unroll
                    for (int n = 0; n < 2; ++n) acc[a][b][m][n] = (f32x4){0.f, 0.f, 0.f, 0.f};
        }
        cur = nxt; cA = nA; cB = nB; ++ui;
        if (wr == 1) GP_BAR;
    }
    GP_WAIT_V(0);
    GP_BAR;
#undef GP_SA
#undef GP_SB
#undef GP_STAGE
#undef GP_LDA
#undef GP_LDB
#undef GP_MMA
#undef GP_WAIT_V
#undef GP_WAIT_L
#undef GP_BAR
#undef GP_SCHED
}

struct SchedP1 {
    const char *U, *Win, *Memn, *Wkv; int G, c;
    __device__ __forceinline__ bool next(int i, Unit& u) const {
        if (G == 256) {
            if (i < 24) { const int l = i * 32 + (c >> 3); int pm = l / 6, pn = 6 * (c & 7) + l % 6; pn = (pn % 3) * 16 + pn / 3;
                u.pm = pm; u.pn = pn; u.kind = pn >> 4; u.A = U + (size_t)pm * TILE; u.B = Win + (size_t)pn * TILE; return true; }
            if (i > 24 || c >= 32) return false;
            int L = c;
            if (L < 16) { u.pm = L >> 2; u.pn = L & 3; u.kind = 3; u.A = Memn + (size_t)u.pm * TILE; u.B = Wkv + (size_t)u.pn * TILE; }
            else { L -= 16; u.pm = L >> 2; u.pn = L & 3; u.kind = 4; u.A = Wkv + (size_t)(4 + u.pm) * TILE; u.B = Memn + (size_t)u.pn * TILE; }
            return true;
        }
        int L = i * G + c;
        if (L < 6144) { int pm, pn; remap_tile<4>(L, 128, 48, pm, pn); pn = (pn % 3) * 16 + pn / 3; u.pm = pm; u.pn = pn; u.kind = pn >> 4; u.A = U + (size_t)pm * TILE; u.B = Win + (size_t)pn * TILE; return true; }
        L -= 6144; if (L >= 32) return false;
        if (L < 16) { u.pm = L >> 2; u.pn = L & 3; u.kind = 3; u.A = Memn + (size_t)u.pm * TILE; u.B = Wkv + (size_t)u.pn * TILE; }
        else { L -= 16; u.pm = L >> 2; u.pn = L & 3; u.kind = 4; u.A = Wkv + (size_t)(4 + u.pm) * TILE; u.B = Memn + (size_t)u.pn * TILE; }
        return true;
    }
};
struct SchedAttn {
    const char *Aq, *Bm; size_t bstride_b, bstride_h; int G, c;
    __device__ __forceinline__ bool next(int i, Unit& u) const {
        const int L = i * G + c; if (L >= 512) return false;
        u.pm = L >> 2; u.pn = L & 3; u.kind = 0;
        u.A = Aq + (size_t)u.pm * TILE + (size_t)u.pn * 512; u.B = Bm + (size_t)(u.pm >> 5) * bstride_b + (size_t)u.pn * bstride_h; return true;
    }
};
struct SchedOut {
    const char *H, *HXp, *W; int G, c;
    __device__ __forceinline__ bool next(int i, Unit& u) const {
        const int ti = i / 3, g = i - 3 * ti; const int L = ti * G + c; if (L >= 512) return false;
        int pm, pn; remap_tile(L, 128, 4, pm, pn); u.pm = pm; u.pn = pn; u.kind = g;
        if (g == 2) u.A = HXp + (size_t)pm * TILE; else u.A = H + ((size_t)g * 128 + pm) * TILE;
        u.B = W + ((size_t)g * 4 + pn) * TILE; return true;
    }
};
struct SchedWo {
    const char *A, *W; int G, c;
    __device__ __forceinline__ bool next(int i, Unit& u) const {
        const int L = i * G + c; if (L >= 512) return false;
        int pm, pn; remap_tile(L, 128, 4, pm, pn); u.pm = pm; u.pn = pn; u.kind = 0; u.A = A + (size_t)pm * TILE; u.B = W + (size_t)pn * TILE; return true;
    }
};

__device__ __forceinline__ int pf(int fq) { return (fq >> 1) | ((fq & 1) << 1); }
__device__ __forceinline__ void store_pair16(bf16_t* rowbase  , u32x2 a  , u32x2 b  , int fq) {
    const auto rx = __builtin_amdgcn_permlane32_swap(a.x, b.x, false, false), ry = __builtin_amdgcn_permlane32_swap(a.y, b.y, false, false);
    *(u32x4*)(rowbase + (size_t)((fq >> 1) * 16) * 1024 + (fq & 1) * 8) = (u32x4){rx[0], ry[0], rx[1], ry[1]};
}
struct EpiP1 {
    bf16_t *HA, *GLU, *SZB, *SZX, *Q, *SGA, *SGB, *SGX, *KB, *VT, *PAT, *GAH; const float* convw;
    __device__ __forceinline__ void operator()(const f32x4 (&acc)[2][2][4][2], const Unit& u, int wr, int wc, int fr, int fq) const {
        if (u.kind <= 2) {
            const int chw = (u.pn & 15) * 64 + wc * 16, ch = chw + pf(fq) * 4;
            const int rowb = u.pm * 256 + wr * 64 + fr;
            if (u.kind == 0) {
                const f32x4 w0 = *(const f32x4*)(convw + ch), w1 = *(const f32x4*)(convw + 1024 + ch), w2 = *(const f32x4*)(convw + 2048 + ch);
#pragma unroll
                for (int ai = 0; ai < 2; ++ai) {
                    const int blk = u.pm * 4 + ai * 2 + wr;
                    f32x4 pprev = (f32x4){0.f, 0.f, 0.f, 0.f}; u32x2 hv[4];
#pragma unroll
                    for (int m = 0; m < 4; ++m) {
                        const f32x4 Bv = acc[ai][0][m][0], Cv = acc[ai][0][m][1], Xv = acc[ai][1][m][0], Zv = acc[ai][1][m][1];
                        const f32x4 p = Cv * Xv; f32x4 ga, p1, p2;
#pragma unroll
                        for (int j = 0; j < 4; ++j) {
                            ga[j] = siluf_(Zv[j]) * Bv[j];
                            const float r1 = (m > 0) ? dppf<0x121>(0.f, pprev[j]) : 0.f, r2 = (m > 0) ? dppf<0x122>(0.f, pprev[j]) : 0.f;
                            p1[j] = dppf<0x111>(r1, p[j]); p2[j] = dppf<0x112>(r2, p[j]);
                        }
                        const f32x4 cv = w2 * p + w1 * p1 + w0 * p2;
                        hv[m] = pk4(ga * cv);
                        if (m == 3 && fr >= 14) *(u32x2*)(PAT + (size_t)(blk * 2 + (fr - 14)) * 1024 + ch) = pk4(p);
                        if (m == 0 && fr < 2) *(u32x2*)(GAH + (size_t)(blk * 2 + fr) * 1024 + ch) = pk4(ga);
                        pprev = p;
                    }
#pragma unroll
                    for (int pr = 0; pr < 2; ++pr) store_pair16(HA + (size_t)(rowb + ai * 128 + pr * 32) * 1024 + chw, hv[2 * pr], hv[2 * pr + 1], fq);
                }
            } else if (u.kind == 1) {
#pragma unroll
                for (int ai = 0; ai < 2; ++ai) {
                    u32x2 gv[4], zv[4];
#pragma unroll
                    for (int m = 0; m < 4; ++m) {
                        const f32x4 Vv = acc[ai][0][m][0], Gv = acc[ai][0][m][1], Zb = acc[ai][1][m][0], Zx = acc[ai][1][m][1]; f32x4 o0, o1, o2;
#pragma unroll
                        for (int j = 0; j < 4; ++j) { o0[j] = Vv[j] * sigmoidf_(Gv[j]); o1[j] = siluf_(Zb[j]); o2[j] = siluf_(Zx[j]); }
                        gv[m] = pk4(o0); zv[m] = pk4(o1);
                        { const int c = (u.pn & 3) * 64 + wc * 16;
                          ((u32x2*)SZX)[native_slot(u.pm, (u.pn & 15) >> 2, wr * 4 + ((c >> 5) & 3), ai, m, c >> 7, (c >> 4) & 1, pf(fq) * 16 + fr)] = pk4(o2); }
                    }
#pragma unroll
                    for (int pr = 0; pr < 2; ++pr) {
                        store_pair16(GLU + (size_t)(rowb + ai * 128 + pr * 32) * 1024 + chw, gv[2 * pr], gv[2 * pr + 1], fq);
                        store_pair16(SZB + (size_t)(rowb + ai * 128 + pr * 32) * 1024 + chw, zv[2 * pr], zv[2 * pr + 1], fq);
                    }
                }
            } else {
#pragma unroll
                for (int ai = 0; ai < 2; ++ai) {
                    u32x2 qv[4];
#pragma unroll
                    for (int m = 0; m < 4; ++m) {
                        const f32x4 Qv = acc[ai][0][m][0], Ga = acc[ai][0][m][1], Gb = acc[ai][1][m][0], Gx = acc[ai][1][m][1]; f32x4 o1, o2, o3;
#pragma unroll
                        for (int j = 0; j < 4; ++j) { const float sa = sigmoidf_(Ga[j]), sb = sigmoidf_(Gb[j]), sx = sigmoidf_(Gx[j]);
                            o1[j] = sa * __builtin_amdgcn_rcpf(fmaxf(sb, 1e-30f)); o2[j] = sb * __builtin_amdgcn_rcpf(fmaxf(sx, 1e-30f)); o3[j] = sx; }
                        qv[m] = pk4(Qv * 0.0625f);
                        const int c = (u.pn & 3) * 64 + wc * 16;
                        const size_t ns = native_slot(u.pm, (u.pn & 15) >> 2, wr * 4 + ((c >> 5) & 3), ai, m, c >> 7, (c >> 4) & 1, pf(fq) * 16 + fr);
                        ((u32x2*)SGA)[ns] = pk4(o1); ((u32x2*)SGB)[ns] = pk4(o2); ((u32x2*)SGX)[ns] = pk4(o3);
                    }
#pragma unroll
                    for (int pr = 0; pr < 2; ++pr) store_pair16(Q + (size_t)(rowb + ai * 128 + pr * 32) * 1024 + chw, qv[2 * pr], qv[2 * pr + 1], fq);
                }
            }
        } else {
            const int r0 = wr * 64 + fr, c0 = wc * 32 + fq * 4;
#pragma unroll
            for (int ai = 0; ai < 2; ++ai)
#pragma unroll
                for (int m = 0; m < 4; ++m)
#pragma unroll
                    for (int bj = 0; bj < 2; ++bj)
#pragma unroll
                        for (int n = 0; n < 2; ++n) {
                            const int r = r0 + ai * 128 + m * 16, c = c0 + bj * 128 + n * 16;
                            if (u.kind == 3) *(u32x2*)(KB + (size_t)(u.pm * 256 + r) * 1024 + u.pn * 256 + c) = pk4(acc[ai][bj][m][n]);
                            else             *(u32x2*)(VT + ((size_t)u.pn * 1024 + u.pm * 256 + r) * 256 + c) = pk4(acc[ai][bj][m][n]);
                        }
        }
    }
};
struct EpiS {
    bf16_t* Q; float* RSUM;
    __device__ __forceinline__ void operator()(const f32x4 (&acc)[2][2][4][2], const Unit& u, int wr, int wc, int fr, int fq) const {
#pragma unroll
        for (int ai = 0; ai < 2; ++ai)
#pragma unroll
            for (int m = 0; m < 4; ++m) {
                const int row = u.pm * 256 + ai * 128 + wr * 64 + m * 16 + fr; float rs = 0.f;
#pragma unroll
                for (int bj = 0; bj < 2; ++bj)
#pragma unroll
                    for (int n = 0; n < 2; ++n) {
                        const f32x4 s = acc[ai][bj][m][n]; f32x4 e;
#pragma unroll
                        for (int j = 0; j < 4; ++j) e[j] = __builtin_amdgcn_exp2f(1.44269504089f * s[j]);
                        const u32x2 w = pk4(e); const f32x4 er = unpk4(w); rs += (er[0] + er[1]) + (er[2] + er[3]);
                        *(u32x2*)(Q + (size_t)row * 1024 + u.pn * 256 + bj * 128 + wc * 32 + n * 16 + fq * 4) = w;
                    }
                rs += __shfl_xor(rs, 16); rs += __shfl_xor(rs, 32);
                if (fq == 0) unsafeAtomicAdd(RSUM + row * 4 + u.pn, rs);
            }
    }
};
struct EpiPV {
    const bf16_t* SZXN; bf16_t* HX; const float* RSUM;
    __device__ __forceinline__ void operator()(const f32x4 (&acc)[2][2][4][2], const Unit& u, int wr, int wc, int fr_in, int fq_in) const {
        int fr = fr_in, fq = fq_in; asm volatile("" : "+v"(fr), "+v"(fq));
        const int w4 = wr * 4 + wc, lane = fq * 16 + fr;
#pragma unroll
        for (int ai = 0; ai < 2; ++ai) {
            u32x2 z[4][2][2]; float rs[4];
#pragma unroll
            for (int m = 0; m < 4; ++m) {
                rs[m] = RSUM[(u.pm * 256 + ai * 128 + wr * 64 + m * 16 + fr) * 4 + u.pn];
#pragma unroll
                for (int bj = 0; bj < 2; ++bj)
#pragma unroll
                    for (int n = 0; n < 2; ++n) z[m][bj][n] = ((const u32x2*)SZXN)[native_slot(u.pm, u.pn, w4, ai, m, bj, n, lane)];
            }
#pragma unroll
            for (int m = 0; m < 4; ++m) {
                const int row = u.pm * 256 + ai * 128 + wr * 64 + m * 16 + fr; const float inv = __builtin_amdgcn_rcpf(rs[m]);
#pragma unroll
                for (int bj = 0; bj < 2; ++bj)
#pragma unroll
                    for (int n = 0; n < 2; ++n)
                        *(u32x2*)(HX + (size_t)row * 1024 + u.pn * 256 + bj * 128 + wc * 32 + n * 16 + fq * 4) = pk4(unpk4(z[m][bj][n]) * (acc[ai][bj][m][n] * inv));
            }
        }
    }
};
__device__ __forceinline__ void ld8(u32x2 (&d)[8], const u32x2* p) {
    asm volatile("global_load_dwordx2 %0, %1, off"             : "=v"(d[0]) : "v"(p) : "memory");
    asm volatile("global_load_dwordx2 %0, %1, off offset:512"  : "=v"(d[1]) : "v"(p) : "memory");
    asm volatile("global_load_dwordx2 %0, %1, off offset:1024" : "=v"(d[2]) : "v"(p) : "memory");
    asm volatile("global_load_dwordx2 %0, %1, off offset:1536" : "=v"(d[3]) : "v"(p) : "memory");
    asm volatile("global_load_dwordx2 %0, %1, off offset:2048" : "=v"(d[4]) : "v"(p) : "memory");
    asm volatile("global_load_dwordx2 %0, %1, off offset:2560" : "=v"(d[5]) : "v"(p) : "memory");
    asm volatile("global_load_dwordx2 %0, %1, off offset:3072" : "=v"(d[6]) : "v"(p) : "memory");
    asm volatile("global_load_dwordx2 %0, %1, off offset:3584" : "=v"(d[7]) : "v"(p) : "memory");
}
__device__ __forceinline__ void ld4(u32x2 (&d)[4], const u32x2* p) {
    asm volatile("global_load_dwordx2 %0, %1, off"             : "=v"(d[0]) : "v"(p) : "memory");
    asm volatile("global_load_dwordx2 %0, %1, off offset:512"  : "=v"(d[1]) : "v"(p) : "memory");
    asm volatile("global_load_dwordx2 %0, %1, off offset:1024" : "=v"(d[2]) : "v"(p) : "memory");
    asm volatile("global_load_dwordx2 %0, %1, off offset:1536" : "=v"(d[3]) : "v"(p) : "memory");
}
__device__ __forceinline__ void tie4(u32x2 (&d)[4]) { asm volatile("" : "+v"(d[0]), "+v"(d[1]), "+v"(d[2]), "+v"(d[3])); }
__device__ __forceinline__ void tie8(u32x2 (&d)[8]) { asm volatile("" : "+v"(d[0]), "+v"(d[1]), "+v"(d[2]), "+v"(d[3]), "+v"(d[4]), "+v"(d[5]), "+v"(d[6]), "+v"(d[7])); }

struct EpiOut {
    const bf16_t *F1, *F2, *F3; bf16_t* MERGED;
    template <int POS> __device__ __forceinline__ void run(f32x4 (&acc)[2][2][4][2], const Unit& u, const bf16_t* F, int wr, int wc, int fr, int fq) const {
        const int w4 = wr * 4 + wc, lane = fq * 16 + fr;
        const u32x2* s0 = (const u32x2*)F + native_slot(u.pm, u.pn, w4, 0, 0, 0, 0, lane);
        u32x2 ga[2][4];
        ld4(ga[0], s0); ld4(ga[1], s0 + 256);
#pragma unroll
        for (int e = 0; e < 8; ++e) {
            if (POS < 2) { if (e < 7) asm volatile("s_waitcnt vmcnt(4)" ::: "memory"); else asm volatile("s_waitcnt vmcnt(0)" ::: "memory"); }
            else { if (e == 0) asm volatile("s_waitcnt vmcnt(4)" ::: "memory"); else if (e < 7) asm volatile("s_waitcnt vmcnt(8)" ::: "memory"); else asm volatile("s_waitcnt vmcnt(4)" ::: "memory"); }
            tie4(ga[e & 1]);
            const int ai = e >> 2, m = e & 3;
#pragma unroll
            for (int k = 0; k < 4; ++k) { const int bj = k >> 1, n = k & 1;
                const f32x4 f = unpk4(ga[e & 1][k]);
                if (POS < 2) acc[ai][bj][m][n] *= f;
                else *(u32x2*)(MERGED + (size_t)(u.pm * 256 + ai * 128 + wr * 64 + m * 16 + fr) * 1024 + u.pn * 256 + bj * 128 + wc * 32 + n * 16 + fq * 4) = pk4(f * acc[ai][bj][m][n]);
            }
            if (e + 2 < 8) ld4(ga[e & 1], s0 + (e + 2) * 256);
        }
    }
    __device__ __forceinline__ void operator()(f32x4 (&acc)[2][2][4][2], const Unit& u, int wr, int wc, int fr, int fq) const {
        if (u.kind < 2) run<0>(acc, u, F1 + ((size_t)u.kind << 25)  , wr, wc, fr, fq);
        else run<2>(acc, u, F3, wr, wc, fr, fq);
    }
};
struct EpiWo {
    const float* X; bf16_t* HN; float* ROWSS;
    __device__ __forceinline__ void operator()(const f32x4 (&acc)[2][2][4][2], const Unit& u, int wr, int wc, int fr, int fq) const {
        const int w4 = wr * 4 + wc, lane = fq * 16 + fr;
#pragma unroll
        for (int ai = 0; ai < 2; ++ai) {
            f32x4 xv[4][2][2];
#pragma unroll
            for (int m = 0; m < 4; ++m)
#pragma unroll
                for (int bj = 0; bj < 2; ++bj)
#pragma unroll
                    for (int n = 0; n < 2; ++n)
                        xv[m][bj][n] = *(const f32x4*)(X + (size_t)(u.pm * 256 + ai * 128 + wr * 64 + m * 16 + fr) * 1024 + u.pn * 256 + bj * 128 + wc * 32 + n * 16 + fq * 4);
#pragma unroll
            for (int m = 0; m < 4; ++m) {
                const int row = u.pm * 256 + ai * 128 + wr * 64 + m * 16 + fr; float ss = 0.f;
#pragma unroll
                for (int bj = 0; bj < 2; ++bj)
#pragma unroll
                    for (int n = 0; n < 2; ++n) {
                        const u32x2 hw = pk4(xv[m][bj][n] + acc[ai][bj][m][n]); const f32x4 h = unpk4(hw);
                        ((u32x2*)HN)[native_slot(u.pm, u.pn, w4, ai, m, bj, n, lane)] = hw; ss += (h[0] * h[0] + h[1] * h[1]) + (h[2] * h[2] + h[3] * h[3]);
                    }
                ss += __shfl_xor(ss, 16); ss += __shfl_xor(ss, 32);
                if (fq == 0) unsafeAtomicAdd(ROWSS + row, ss);
            }
        }
    }
};

__device__ __forceinline__ int win_src_col(int R) {
    const int unit = R >> 8, rho = R & 255, kind = unit >> 4, cu = unit & 15;
    const int fqb = (rho >> 2) & 3;
    const int gi = ((rho >> 7) & 1) * 2 + ((rho >> 4) & 1), chl = ((rho >> 5) & 3) * 16 + (((fqb >> 1) | ((fqb & 1) << 1)) << 2) + (rho & 3);
    int base;
    if (kind == 0) base = gi * 1024;
    else if (kind == 1) base = (gi < 3) ? 4096 + gi * 1024 : 8192;
    else base = (gi == 0) ? 7168 : 9216 + (gi - 1) * 1024;
    return base + cu * 64 + chl;
}
__device__ __forceinline__ void p0_transpose_item(const float* W, int ldw, bf16_t* WT, int dst_row0, int k0, bool perm, LAS float* scr, int lane) {
    const int li = lane & 31; const int drow = dst_row0 + (perm ? ((li & 15) + ((li >> 4) << 5)) : li); const int scol = perm ? win_src_col(drow) : drow;
#pragma unroll
    for (int i = 0; i < 32; ++i) { const int kk = 2 * i + (lane >> 5); scr[kk * 33 + (lane & 31)] = W[(size_t)(k0 + kk) * ldw + scol]; }
    asm volatile("s_waitcnt lgkmcnt(0)" ::: "memory");
    const int c = lane & 7;
#pragma unroll
    for (int j = 0; j < 4; ++j) { const int n = (lane >> 3) + 8 * j; const LAS float* s = scr + (8 * c) * 33 + n;
        u32x4 o; o.x = pk_bf16(s[0 * 33], s[1 * 33]); o.y = pk_bf16(s[2 * 33], s[3 * 33]); o.z = pk_bf16(s[4 * 33], s[5 * 33]); o.w = pk_bf16(s[6 * 33], s[7 * 33]);
        const int orow = dst_row0 + (perm ? ((n & 15) + ((n >> 4) << 5)) : n);
        *(u32x4*)(WT + (size_t)orow * 1024 + k0 + 8 * c) = o; }
    asm volatile("s_waitcnt lgkmcnt(0)" ::: "memory");
}
__device__ __forceinline__ void rms_row_to_bf16(const float* xrow, const float* g, bf16_t* orow, int lane) {
    const f32x4* xr = (const f32x4*)xrow + lane; const f32x4* gr = (const f32x4*)g + lane;
    f32x4 v[4]; float s = 0.f;
#pragma unroll
    for (int j = 0; j < 4; ++j) { v[j] = xr[64 * j]; s += (v[j][0] * v[j][0] + v[j][1] * v[j][1]) + (v[j][2] * v[j][2] + v[j][3] * v[j][3]); }
    const float rstd = 1.0f / sqrtf(wave_sum(s) * (1.f / 1024.f) + EPS);
    u32x2* o8 = (u32x2*)orow + lane;
#pragma unroll
    for (int j = 0; j < 4; ++j) { const f32x4 gg = gr[64 * j]; o8[64 * j] = pk4(v[j] * rstd * gg); }
}

template <int PH>
__device__ __forceinline__ void conv31_chunk(LAS unsigned char* lds, LAS float* red, LAS float* stats, const bf16_t* GLU, bf16_t* SZB, const float* cw, const float* cb, const float* lng, const float* lnb,
                                            const int t0, const bool has_next, const int tid_in) {
    int tid_o = tid_in; asm volatile("" : "+v"(tid_o));
    const int tid = tid_o, lane = tid & 63, wid = tid >> 6, c2 = tid * 2;
    u32x4 nx[4];
    if (has_next) {
        int tf = tid; asm volatile("" : "+v"(tf));
#pragma unroll
        for (int q = 0; q < 4; ++q) { const int i = tf + q * 512; nx[q] = *(const u32x4*)(GLU + (size_t)(t0 + 16 + (i >> 7)) * 1024 + (i & 127) * 8); }
    }
    const f32x2 bias = *(const f32x2*)(cb + c2);
    f32x2 outv[16];
#pragma unroll
    for (int t = 0; t < 16; ++t) outv[t] = bias;
#pragma unroll
    for (int ps = 0; ps < 2; ++ps) {
        const int kb = ps * 16, ntap = ps == 0 ? 16 : 15;
        f32x2 w[16];
#pragma unroll
        for (int k = 0; k < 16; ++k) if (k < ntap) w[k] = *(const f32x2*)(cw + (kb + k) * 1024 + c2);
#pragma unroll
        for (int r = 0; r < 31; ++r) if (r < ntap + 15) {
            const unsigned v = *(const LAS unsigned*)(lds + ((34 + 16 * PH + kb + r) & 63) * 2048 + tid * 4);
            const f32x2 x = (f32x2){bf_lo(v), bf_hi(v)};
#pragma unroll
            for (int t = 0; t < 16; ++t) { const int k = r - t; if (k >= 0 && k < ntap) outv[t] = __builtin_elementwise_fma(w[k], x, outv[t]); }
            if ((r & 7) == 7) asm volatile("" ::: "memory");
        }
    }
    {
        float s[16], q[16];
#pragma unroll
        for (int t = 0; t < 16; ++t) { s[t] = outv[t][0] + outv[t][1]; q[t] = outv[t][0] * outv[t][0] + outv[t][1] * outv[t][1]; }
#pragma unroll
        for (int lvl = 0; lvl < 4; ++lvl) {
            const int half = 8 >> lvl, off = 32 >> lvl; const bool hi = (lane & off) != 0;
#pragma unroll
            for (int i = 0; i < half; ++i) {
                const float ks = hi ? s[i + half] : s[i], ss = hi ? s[i] : s[i + half]; s[i] = ks + __shfl_xor(ss, off);
                const float kq = hi ? q[i + half] : q[i], sq = hi ? q[i] : q[i + half]; q[i] = kq + __shfl_xor(sq, off);
            }
        }
        s[0] += __shfl_xor(s[0], 2); q[0] += __shfl_xor(q[0], 2);
        s[0] += __shfl_xor(s[0], 1); q[0] += __shfl_xor(q[0], 1);
        if ((lane & 3) == 0) *(LAS f32x2*)(red + ((lane >> 2) * 8 + wid) * 2) = (f32x2){s[0], q[0]};
    }
    __syncthreads();
    if (has_next) {
#pragma unroll
        for (int q = 0; q < 4; ++q) { const int i = tid + q * 512; *(LAS u32x4*)(lds + ((34 + 16 * PH + 46 + (i >> 7)) & 63) * 2048 + (i & 127) * 16) = nx[q]; }
    }
    if (tid < 16) {
        float S = 0.f, Q2 = 0.f;
#pragma unroll
        for (int wv = 0; wv < 8; ++wv) { const f32x2 t = *(const LAS f32x2*)(red + (tid * 8 + wv) * 2); S += t[0]; Q2 += t[1]; }
        const float mean = S * (1.f / 1024.f), var = fmaxf(Q2 * (1.f / 1024.f) - mean * mean, 0.f);
        *(LAS f32x2*)(stats + tid * 2) = (f32x2){mean, 1.0f / sqrtf(var + EPS)};
    }
    __syncthreads();
    const f32x2 lg = *(const f32x2*)(lng + c2), lb = *(const f32x2*)(lnb + c2);
    unsigned zz[16];
#pragma unroll
    for (int t = 0; t < 16; ++t) zz[t] = *(const unsigned*)(SZB + (size_t)(t0 + t) * 1024 + c2);
#pragma unroll
    for (int t = 0; t < 16; ++t) {
        const f32x2 st = *(const LAS f32x2*)(stats + t * 2);
        const float y0 = (outv[t][0] - st[0]) * st[1] * lg[0] + lb[0], y1 = (outv[t][1] - st[0]) * st[1] * lg[1] + lb[1];
        *(unsigned*)(SZB + (size_t)(t0 + t) * 1024 + c2) = pk_bf16(bf_lo(zz[t]) * siluf_(y0), bf_hi(zz[t]) * siluf_(y1));
    }
}
__device__ __forceinline__ void conv31_phase(LAS unsigned char* lds, const bf16_t* GLU, bf16_t* SZB, const float* cw, const float* cb, const float* lng, const float* lnb, int G, int c, const int widx) {
    int tid_ = tid_of(widx); asm volatile("" : "+v"(tid_));
    const int tid = tid_;
    LAS float* red = (LAS float*)(lds + 131072 + 1024);
    LAS float* stats = (LAS float*)(lds + 131072 + 3072);
    for (int run = c; run < NTOK / 128; run += G) {
        const int T0 = run * 128, tpos = T0 & (SEQ - 1);
        __syncthreads();
#pragma unroll
        for (int h = 0; h < 2; ++h) {
            int tf = tid; asm volatile("" : "+v"(tf));
            u32x4 tv[6];
#pragma unroll
            for (int q = 0; q < 6; ++q) { const int i = tf + (h * 6 + q) * 512, r = (i >> 7) < 46 ? (i >> 7) : 45; const int gr = (tpos - 30 + r >= 0) ? (T0 - 30 + r) : T0;
                tv[q] = *(const u32x4*)(GLU + (size_t)gr * 1024 + (i & 127) * 8); }
#pragma unroll
            for (int q = 0; q < 6; ++q) { const int i = tf + (h * 6 + q) * 512, r = i >> 7;
                if (r < 46) *(LAS u32x4*)(lds + ((34 + r) & 63) * 2048 + (i & 127) * 16) = (tpos - 30 + r >= 0) ? tv[q] : (u32x4){0u, 0u, 0u, 0u}; }
        }
        __syncthreads();
        conv31_chunk<0>(lds, red, stats, GLU, SZB, cw, cb, lng, lnb, T0, true, tid);
        conv31_chunk<1>(lds, red, stats, GLU, SZB, cw, cb, lng, lnb, T0 + 16, true, tid);
        conv31_chunk<2>(lds, red, stats, GLU, SZB, cw, cb, lng, lnb, T0 + 32, true, tid);
        conv31_chunk<3>(lds, red, stats, GLU, SZB, cw, cb, lng, lnb, T0 + 48, true, tid);
        conv31_chunk<0>(lds, red, stats, GLU, SZB, cw, cb, lng, lnb, T0 + 64, true, tid);
        conv31_chunk<1>(lds, red, stats, GLU, SZB, cw, cb, lng, lnb, T0 + 80, true, tid);
        conv31_chunk<2>(lds, red, stats, GLU, SZB, cw, cb, lng, lnb, T0 + 96, true, tid);
        conv31_chunk<3>(lds, red, stats, GLU, SZB, cw, cb, lng, lnb, T0 + 112, false, tid);
    }
    __syncthreads();
}

__global__ void __launch_bounds__(512, 2) fwd_megakernel(Params p) {
    extern __shared__ __attribute__((aligned(16))) unsigned char lds_raw[];
    LAS unsigned char* lds = (LAS unsigned char*)lds_raw;
    const int G = gridDim.x, bx = blockIdx.x;
    unsigned char* ws = p.ws; unsigned char* ob = (unsigned char*)p.out;
    const float *x = p.in[0], *mem = p.in[1], *norm_g = p.in[2], *w_in = p.in[3], *conv_a_w = p.in[4], *w_out_a = p.in[5], *conv_b_w = p.in[6], *conv_b_b = p.in[7],
                *ln_b_g = p.in[8], *ln_b_b = p.in[9], *w_out_b = p.in[10], *mem_norm_g = p.in[11], *w_kv = p.in[12], *w_out_x = p.in[13], *w_o = p.in[14], *final_g = p.in[15];
    bf16_t *WIN = (bf16_t*)(ws + WS_WIN), *WOUT = (bf16_t*)(ws + WS_WOUT), *WO = (bf16_t*)(ws + WS_WO), *WKV = (bf16_t*)(ws + WS_WKV), *MEMN = (bf16_t*)(ws + WS_MEMN),
           *KB = (bf16_t*)(ws + WS_KB), *VT = (bf16_t*)(ws + WS_VT), *PAT = (bf16_t*)(ws + WS_PAT), *GAH = (bf16_t*)(ws + WS_GAH), *HA = (bf16_t*)(ws + WS_HA), *SZB = (bf16_t*)(ws + WS_SZB),
           *SZX = (bf16_t*)(ws + WS_SZX), *GLU = (bf16_t*)(ws + WS_GLU), *Q = (bf16_t*)(ws + WS_Q), *SGA = (bf16_t*)(ws + WS_SGA), *SGB = (bf16_t*)(ws + WS_SGB),
           *U = (bf16_t*)(ob + OUT_U), *SGX = (bf16_t*)(ob + OUT_SGX);
    float *ROWSS = (float*)(ws + WS_ROWSS), *RSUM = (float*)(ws + WS_RSUM);
    bf16_t* MERGED = GLU;
    volatile LAS unsigned* xst = (volatile LAS unsigned*)(lds + 131072 + 512);
    const int widx = __builtin_amdgcn_readfirstlane((int)threadIdx.x >> 6);
    if (threadIdx.x < 4) xst[threadIdx.x] = 0u;
    __syncthreads();
    XcdBarrier xb = xcd_barrier_post((unsigned*)(ws + WS_BAR), xst, threadIdx.x == 0);

    {
        int tid_ = tid_of(widx); asm volatile("" : "+v"(tid_)); const int tid = tid_, lane = tid & 63, wave = tid >> 6;
        LAS float* scr = (LAS float*)(lds + wave * 16384);
        const int gw = bx * 8 + wave, NGW = G * 8;
        for (int it = gw; it < 9216; it += NGW) {
            int r = it;
            if (r < 6144) { const int g = r % 384; p0_transpose_item(w_in, 12288, WIN, (g >> 1) * 64 + (g & 1) * 16, (r / 384) * 64, true, scr, lane); continue; } r -= 6144;
            if (r < 512) { p0_transpose_item(w_out_a, 1024, WOUT, (r & 31) * 32, (r >> 5) * 64, false, scr, lane); continue; } r -= 512;
            if (r < 512) { p0_transpose_item(w_out_b, 1024, WOUT + (size_t)1024 * 1024, (r & 31) * 32, (r >> 5) * 64, false, scr, lane); continue; } r -= 512;
            if (r < 512) { p0_transpose_item(w_out_x, 1024, WOUT + (size_t)2048 * 1024, (r & 31) * 32, (r >> 5) * 64, false, scr, lane); continue; } r -= 512;
            if (r < 512) { p0_transpose_item(w_o, 1024, WO, (r & 31) * 32, (r >> 5) * 64, false, scr, lane); continue; } r -= 512;
            p0_transpose_item(w_kv, 2048, WKV, (r & 63) * 32, (r >> 6) * 64, false, scr, lane);
        }
        {
            const f32x4* gr = (const f32x4*)norm_g + lane; f32x4 gg[4];
#pragma unroll
            for (int j = 0; j < 4; ++j) gg[j] = gr[64 * j];
            for (int m = gw; m < NTOK; m += 4 * NGW) {
                f32x4 v[4][4];
#pragma unroll
                for (int r = 0; r < 4; ++r) { const f32x4* xr = (const f32x4*)(x + (size_t)(m + r * NGW) * 1024) + lane;
#pragma unroll
                    for (int j = 0; j < 4; ++j) v[r][j] = xr[64 * j]; }
#pragma unroll
                for (int r = 0; r < 4; ++r) {
                    float sq = 0.f;
#pragma unroll
                    for (int j = 0; j < 4; ++j) sq += (v[r][j][0] * v[r][j][0] + v[r][j][1] * v[r][j][1]) + (v[r][j][2] * v[r][j][2] + v[r][j][3] * v[r][j][3]);
                    const float rstd = 1.0f / sqrtf(wave_sum(sq) * (1.f / 1024.f) + EPS);
                    u32x2* o8 = (u32x2*)(U + (size_t)(m + r * NGW) * 1024) + lane;
#pragma unroll
                    for (int j = 0; j < 4; ++j) o8[64 * j] = pk4(v[r][j] * rstd * gg[j]);
                }
            }
        }
        for (int m = gw; m < 1024; m += NGW) rms_row_to_bf16(mem + (size_t)m * 1024, mem_norm_g, MEMN + (size_t)m * 1024, lane);
        for (int i = bx * 512 + tid; i < NTOK * 5; i += G * 512) ROWSS[i] = 0.f;
    }
    GRID_SYNC();

    {
        SchedP1 S{(const char*)U, (const char*)WIN, (const char*)MEMN, (const char*)WKV, G, bx};
        EpiP1 E{HA, GLU, SZB, SZX, Q, SGA, SGB, SGX, KB, VT, PAT, GAH, conv_a_w};
        gemm_phase(lds, 1024, 1024, 1024, S, E, widx);
    }
    GRID_SYNC();

    {
        int tid_ = tid_of(widx); asm volatile("" : "+v"(tid_)); const int tid = tid_;
        for (int i = bx * 512 + tid; i < 512 * 256; i += G * 512) {
            const int blk = i >> 8, ch = (i & 255) * 4;
            if ((blk & 127) != 0) {
                const f32x4 w0 = *(const f32x4*)(conv_a_w + ch), w1 = *(const f32x4*)(conv_a_w + 1024 + ch);
                const f32x4 pt0 = unpk4(*(const u32x2*)(PAT + (size_t)((blk - 1) * 2 + 0) * 1024 + ch)), pt1 = unpk4(*(const u32x2*)(PAT + (size_t)((blk - 1) * 2 + 1) * 1024 + ch));
                const f32x4 g0 = unpk4(*(const u32x2*)(GAH + (size_t)(blk * 2 + 0) * 1024 + ch)), g1 = unpk4(*(const u32x2*)(GAH + (size_t)(blk * 2 + 1) * 1024 + ch));
                u32x2* h0 = (u32x2*)(HA + (size_t)(blk * 64) * 1024 + ch); u32x2* h1 = (u32x2*)(HA + (size_t)(blk * 64 + 1) * 1024 + ch);
                *h0 = pk4(unpk4(*h0) + g0 * (w1 * pt1 + w0 * pt0));
                *h1 = pk4(unpk4(*h1) + g1 * (w0 * pt1));
            }
        }
        { SchedAttn S{(const char*)Q, (const char*)KB, TILE, (size_t)512, G, bx}; EpiS E{Q, RSUM}; gemm_phase(lds, 1024, 1024, 256, S, E, widx); }
        conv31_phase(lds, GLU, SZB, conv_b_w, conv_b_b, ln_b_g, ln_b_b, G, bx, widx);
    }
    asm volatile("s_waitcnt vmcnt(0) lgkmcnt(0)" ::: "memory"); __syncthreads();
    __builtin_amdgcn_fence(__ATOMIC_ACQUIRE, "agent"); asm volatile("s_waitcnt vmcnt(0)" ::: "memory"); __syncthreads();

    { SchedAttn S{(const char*)Q, (const char*)VT, (size_t)1024 * 256 * 2, (size_t)256 * 256 * 2, G, bx}; EpiPV E{SZX, U  , RSUM}; gemm_phase(lds, 1024, 256, 256, S, E, widx); }
    GRID_SYNC();

    { SchedOut S{(const char*)HA, (const char*)U, (const char*)WOUT, G, bx}; EpiOut E{SGA, SGB, SGX, MERGED}; gemm_phase(lds, 1024, 1024, 1024, S, E, widx); }
    GRID_SYNC();

    { SchedWo S{(const char*)MERGED, (const char*)WO, G, bx}; EpiWo E{x, HA  , ROWSS}; gemm_phase(lds, 1024, 1024, 1024, S, E, widx); }
    GRID_SYNC();

    {
        int tid_ = tid_of(widx); asm volatile("" : "+v"(tid_)); const int lane = tid_ & 63, w4 = tid_ >> 6, wr = w4 >> 2, wc = w4 & 3, fr = lane & 15, fq = lane >> 4;
        for (int L = bx; L < 512; L += G) {
            int pm, pn; remap_tile(L, 128, 4, pm, pn);
#pragma unroll
            for (int ai = 0; ai < 2; ++ai) {
                u32x2 hv[4][2][2]; float rs[4]; f32x4 gg[2][2];
#pragma unroll
                for (int m = 0; m < 4; ++m) {
                    rs[m] = ROWSS[pm * 256 + ai * 128 + wr * 64 + m * 16 + fr];
#pragma unroll
                    for (int bj = 0; bj < 2; ++bj)
#pragma unroll
                        for (int n = 0; n < 2; ++n) hv[m][bj][n] = ((const u32x2*)HA)[native_slot(pm, pn, w4, ai, m, bj, n, fq * 16 + fr)];
                }
#pragma unroll
                for (int bj = 0; bj < 2; ++bj)
#pragma unroll
                    for (int n = 0; n < 2; ++n) gg[bj][n] = *(const f32x4*)(final_g + pn * 256 + bj * 128 + wc * 32 + n * 16 + fq * 4);
#pragma unroll
                for (int m = 0; m < 4; ++m) {
                    const float rstd = 1.0f / sqrtf(rs[m] * (1.f / 1024.f) + EPS);
#pragma unroll
                    for (int bj = 0; bj < 2; ++bj)
#pragma unroll
                        for (int n = 0; n < 2; ++n)
                            *(f32x4*)(p.out + (size_t)(pm * 256 + ai * 128 + wr * 64 + m * 16 + fr) * 1024 + pn * 256 + bj * 128 + wc * 32 + n * 16 + fq * 4) = unpk4(hv[m][bj][n]) * rstd * gg[bj][n];
                }
            }
        }
    }
}

extern "C" void kernel_launch(void* const* d_in, const int* in_sizes, int n_in, void* d_out, int out_size, void* d_ws, size_t ws_size, hipStream_t stream) {
    static int grid_blocks = 0;
    if (!grid_blocks) {
        int dev = 0, cus = 0, per_cu = 0;
        hipGetDevice(&dev);
        hipDeviceGetAttribute(&cus, hipDeviceAttributeMultiprocessorCount, dev);
        hipFuncSetAttribute((const void*)fwd_megakernel, hipFuncAttributeMaxDynamicSharedMemorySize, LDS_BYTES);
        hipOccupancyMaxActiveBlocksPerMultiprocessor(&per_cu, (const void*)fwd_megakernel, 512, LDS_BYTES);
        if (per_cu < 1) { fprintf(stderr, "kernel_launch: occupancy query reports %d blocks per CU\n", per_cu); per_cu = 1; }
        if (per_cu > 1) per_cu = 1;
        grid_blocks = cus * per_cu;
        if (ws_size < WS_END) fprintf(stderr, "kernel_launch: workspace too small: %zu < %zu\n", ws_size, (size_t)WS_END);
    }
    (void)hipMemsetAsync((char*)d_ws + WS_BAR, 0, XCD_BAR_WORDS * 4, stream);
    if (ws_size < WS_END) return;
    Params p{};
    for (int i = 0; i < 16; ++i) p.in[i] = (const float*)d_in[i];
    p.out = (float*)d_out; p.ws = (unsigned char*)d_ws;
    void* args[] = {&p};
    hipError_t e = hipLaunchCooperativeKernel((const void*)fwd_megakernel, dim3(grid_blocks), dim3(512), args, LDS_BYTES, stream);
    if (e != hipSuccess) fprintf(stderr, "cooperative launch failed: %s (grid %d)\n", hipGetErrorString(e), grid_blocks);
}
```

```cpp
#include <hip/hip_runtime.h>
#include <cstdio>

#define LAS __attribute__((address_space(3)))
typedef unsigned short bf16_t;
typedef short bf16x8 __attribute__((ext_vector_type(8)));
typedef float f32x4 __attribute__((ext_vector_type(4)));
typedef float f32x2 __attribute__((ext_vector_type(2)));
typedef unsigned u32x4 __attribute__((ext_vector_type(4)));
typedef unsigned u32x2 __attribute__((ext_vector_type(2)));

constexpr int BM = 256, BK = 64, HALF = 128, HTB = HALF * BK * 2, STAGE_BYTES = 8 * HTB;
constexpr int LDS_BYTES = 147456;
constexpr int NTOK = 32768, DM = 1024, SEQ = 8192;
constexpr float EPS = 1e-6f;
constexpr size_t MiB = 1u << 20;
constexpr size_t TILE = (size_t)256 * 1024 * 2;
constexpr size_t WS_WIN = 0, WS_WOUT = 24 * MiB, WS_WO = 30 * MiB, WS_WKV = 32 * MiB, WS_MEMN = 36 * MiB, WS_KB = 38 * MiB, WS_VT = 40 * MiB;
constexpr size_t WS_ROWSS = 42 * MiB, WS_RSUM = 42 * MiB + 131072, WS_PAT = 43 * MiB, WS_GAH = 45 * MiB;
constexpr size_t WS_BAR = 47 * MiB;
constexpr size_t WS_HA = 48 * MiB, WS_SZB = 112 * MiB, WS_SZX = 176 * MiB, WS_GLU = 240 * MiB, WS_Q = 304 * MiB, WS_SGA = 368 * MiB, WS_SGB = 432 * MiB, WS_END = 496 * MiB;
constexpr size_t OUT_U = 0, OUT_SGX = 64 * MiB;

#define XB_TMO      128
#define XB_XCNT(j)  (256  + 64 * (j))
#define XB_XSUB(j)  (1280 + 64 * (j))
#define XB_XGEN(j)  (2304 + 64 * (j))
#define XB_TOP      3328
#define XB_TOPGEN   3392
#define XCD_BAR_WORDS 3456
#define XB_SPIN_CAP (1u << 18)

__device__ __forceinline__ unsigned xb_ld(unsigned* p)              { return __hip_atomic_load(p, __ATOMIC_RELAXED, __HIP_MEMORY_SCOPE_AGENT); }
__device__ __forceinline__ unsigned xb_add(unsigned* p, unsigned v) { return __hip_atomic_fetch_add(p, v, __ATOMIC_RELAXED, __HIP_MEMORY_SCOPE_AGENT); }
__device__ __forceinline__ unsigned xb_xcc_id() { return (unsigned)__builtin_amdgcn_s_getreg((3 << 11) | 20) & 0xFu; }
#define XB_SPIN(cond, bar) do { unsigned _sp = 0; while (cond) { __builtin_amdgcn_s_sleep(1); \
    if ((++_sp & 255u) == 0u) { if (xb_ld(&(bar)[XB_TMO])) break; if (_sp > XB_SPIN_CAP) { atomicAdd(&(bar)[XB_TMO], 1u); break; } } } } while (0)

struct XcdBarrier {
    unsigned* bar; unsigned x;
    volatile LAS unsigned* st;
};

__device__ __forceinline__ XcdBarrier xcd_barrier_post(unsigned* bar, volatile LAS unsigned* st, bool leader) {
    XcdBarrier b; b.bar = bar; b.x = xb_xcc_id(); b.st = st;
    if (leader) (void)xb_add(&bar[XB_XCNT(b.x)], 1u);
    return b;
}
__device__ __forceinline__ void xcd_barrier_complete(unsigned* bar, unsigned x, unsigned& nloc, unsigned& nx) {
    const unsigned G = gridDim.x * gridDim.y * gridDim.z;
    unsigned sum, cnt, mine, sp = 0u;
    for (;;) {
        sum = 0u; cnt = 0u; mine = 0u;
#pragma unroll
        for (unsigned j = 0; j < 16; ++j) { const unsigned c = xb_ld(&bar[XB_XCNT(j)]); sum += c; cnt += (c > 0u) ? 1u : 0u; mine = (j == x) ? c : mine; }
        if (sum == G) break;
        __builtin_amdgcn_s_sleep(1);
        if ((++sp & 255u) == 0u) { if (xb_ld(&bar[XB_TMO])) break; if (sp > XB_SPIN_CAP) { atomicAdd(&bar[XB_TMO], 1u); break; } }
    }
    nloc = mine > 0u ? mine : 1u; nx = cnt > 0u ? cnt : 1u;
}

__device__ __forceinline__ void xcd_barrier(const XcdBarrier& b, bool leader) {
    asm volatile("s_waitcnt vmcnt(0)" ::: "memory");
    __syncthreads();
    if (leader) {
        unsigned* bar = b.bar;
        __builtin_amdgcn_s_waitcnt(0);
        unsigned nloc = b.st[0], nx = b.st[1];
        if (nloc == 0u) { xcd_barrier_complete(bar, b.x, nloc, nx); b.st[0] = nloc; b.st[1] = nx; }
        const unsigned old = xb_add(&bar[XB_XSUB(b.x)], 1u);
        const unsigned gen = old / nloc;
        if (old + 1u == (gen + 1u) * nloc) {
            __builtin_amdgcn_fence(__ATOMIC_RELEASE, "agent");
            asm volatile("s_waitcnt vmcnt(0)" ::: "memory");
            const unsigned og = xb_add(&bar[XB_TOP], 1u);
            const unsigned tg = og / nx;
            if (og + 1u == (tg + 1u) * nx) xb_add(&bar[XB_TOPGEN], 1u);
            else XB_SPIN(xb_ld(&bar[XB_TOPGEN]) == tg, bar);
            __builtin_amdgcn_fence(__ATOMIC_ACQUIRE, "agent");
            xb_add(&bar[XB_XGEN(b.x)], 1u);
            asm volatile("s_waitcnt vmcnt(0)" ::: "memory");
        } else {
            XB_SPIN(xb_ld(&bar[XB_XGEN(b.x)]) == gen, bar);
            __builtin_amdgcn_fence(__ATOMIC_ACQUIRE, "agent");
            asm volatile("s_waitcnt vmcnt(0)" ::: "memory");
        }
    }
    __syncthreads();
}

#define GRID_SYNC() xcd_barrier(xb, tid_of(widx) == 0)

struct Params { const float* in[16]; float* out; unsigned char* ws; };

typedef __bf16 bf16x2_t __attribute__((ext_vector_type(2)));
__device__ __forceinline__ unsigned pk_bf16(float lo, float hi) { const f32x2 v = {lo, hi}; return __builtin_bit_cast(unsigned, __builtin_convertvector(v, bf16x2_t)); }
__device__ __forceinline__ float bf_lo(unsigned u) { return __uint_as_float(u << 16); }
__device__ __forceinline__ float bf_hi(unsigned u) { return __uint_as_float(u & 0xffff0000u); }
__device__ __forceinline__ float sigmoidf_(float x) { return __builtin_amdgcn_rcpf(1.0f + __builtin_amdgcn_exp2f(-1.44269504089f * x)); }
__device__ __forceinline__ float siluf_(float x) { return x * sigmoidf_(x); }
__device__ __forceinline__ u32x2 pk4(f32x4 v) { u32x2 r; r.x = pk_bf16(v[0], v[1]); r.y = pk_bf16(v[2], v[3]); return r; }
__device__ __forceinline__ f32x4 unpk4(u32x2 v) { return (f32x4){bf_lo(v.x), bf_hi(v.x), bf_lo(v.y), bf_hi(v.y)}; }
template <int CTRL> __device__ __forceinline__ float dppf(float old, float v) { return __int_as_float(__builtin_amdgcn_update_dpp(__float_as_int(old), __float_as_int(v), CTRL, 0xf, 0xf, false)); }
__device__ __forceinline__ float wave_sum(float v) {
#pragma unroll
    for (int o = 1; o < 64; o <<= 1) v += __shfl_xor(v, o);
    return v;
}

__device__ __forceinline__ int lds_byte(int r, int c) { const int st = (r >> 4) * 2 + (c >> 5), rr = r & 15, cc = c & 31, ob = rr * 64 + cc * 2; return st * 1024 + (ob ^ (((ob >> 9) & 1) << 5)); }
__device__ __forceinline__ void stage_rc(int b, int& R, int& C) { const int st = b / 1024, sb = b % 1024, swz = sb ^ (((sb >> 9) & 1) << 5); R = (st >> 1) * 16 + swz / 64; C = (st & 1) * 32 + (swz % 64) / 2; }

__device__ __forceinline__ int tid_of(int widx) { int l; asm volatile("v_mbcnt_lo_u32_b32 %0, -1, 0\n\tv_mbcnt_hi_u32_b32 %0, -1, %0" : "=v"(l)); return widx * 64 + l; }
struct Unit { const char* A; const char* B; int pm, pn, kind; };
__device__ __forceinline__ size_t native_slot(int pm, int pn4, int w4, int ai, int m, int bj, int n, int lane) {
    return ((((size_t)(pm * 4 + pn4) * 8 + w4) * 32 + (((ai * 4 + m) * 2 + bj) * 2 + n)) * 64 + lane);
}

template <int WG = 8> __device__ __forceinline__ void remap_tile(int L, int nM, int nN, int& pm, int& pn) {
    const int nwg = nM * nN; int wgid = L;
    { const int q = nwg / 8, r = nwg % 8, xcd = wgid % 8, off = wgid / 8; wgid = (xcd < r ? xcd * (q + 1) : r * (q + 1) + (xcd - r) * q) + off; }
    const int nig = WG * nN, gid = wgid / nig, fm = gid * WG, gsz = (nM - fm) < WG ? (nM - fm) : WG;
    pm = fm + ((wgid % nig) % gsz); pn = (wgid % nig) / gsz;
}

struct EpiOut;
template <class Epi> __device__ __forceinline__ bool epi_keeps(const Epi&, const Unit&) { return false; }
__device__ __forceinline__ bool epi_keeps(const EpiOut&, const Unit& u) { return u.kind < 2; }
template <class Epi, class Sched>
__device__ __forceinline__ void gemm_phase(LAS unsigned char* lds, const int lda, const int ldb, const int K, const Sched& S, const Epi& E, const int widx) {
    int tid_ = tid_of(widx); asm volatile("" : "+v"(tid_));
    const int tid = tid_, wid = __builtin_amdgcn_readfirstlane(tid >> 6), lane = tid & 63, wr = wid >> 2, wc = wid & 3, fr = lane & 15, fq = lane >> 4;
    const int nt = K / BK;
    unsigned voffA[2], voffB[2];
#pragma unroll
    for (int i = 0; i < 2; ++i) { int R, C; stage_rc(tid * 16 + i * 8192, R, C); voffA[i] = (unsigned)(R * lda + C) * 2u; voffB[i] = (unsigned)(R * ldb + C) * 2u; }
    const size_t kstep = (size_t)(BK * 2);
    const size_t hstepA = (size_t)HALF * lda * 2, hstepB = (size_t)HALF * ldb * 2;
    const unsigned ldsw = (unsigned)wid * 1024u;
    const int aoff = lds_byte(wr * 64 + fr, fq * 8), boff = lds_byte(wc * 32 + fr, fq * 8);
#define GP_SA(b, h) (((b) * 2 + (h)) * HTB)
#define GP_SB(b, h) ((4 + (b) * 2 + (h)) * HTB)
#define GP_STAGE(bufoff, gbase, voff) do { _Pragma("unroll") for (int _i = 0; _i < 2; ++_i) \
        __builtin_amdgcn_global_load_lds((const unsigned*)((const char*)(gbase) + (voff)[_i]), (LAS unsigned*)(lds + (bufoff) + ldsw + _i * 8192), 16, 0, 0); } while (0)
#define GP_LDA(dst, b, h) do { _Pragma("unroll") for (int m = 0; m < 4; ++m) _Pragma("unroll") for (int k = 0; k < 2; ++k) dst[m][k] = *(const LAS bf16x8*)(lds + GP_SA(b, h) + aoff + m * 2048 + k * 1024); } while (0)
#define GP_LDB(dst, b, h) do { _Pragma("unroll") for (int n = 0; n < 2; ++n) _Pragma("unroll") for (int k = 0; k < 2; ++k) dst[n][k] = *(const LAS bf16x8*)(lds + GP_SB(b, h) + boff + n * 2048 + k * 1024); } while (0)
#define GP_MMA(ai, bj, At, Bt) do { __builtin_amdgcn_s_setprio(1); _Pragma("unroll") for (int m = 0; m < 4; ++m) _Pragma("unroll") for (int n = 0; n < 2; ++n) _Pragma("unroll") for (int k = 0; k < 2; ++k) \
        acc[ai][bj][m][n] = __builtin_amdgcn_mfma_f32_16x16x32_bf16(Bt[n][k], At[m][k], acc[ai][bj][m][n], 0, 0, 0); __builtin_amdgcn_s_setprio(0); } while (0)
#define GP_WAIT_V(n) asm volatile("s_waitcnt vmcnt(" #n ")" ::: "memory")
#define GP_WAIT_L(n) asm volatile("s_waitcnt lgkmcnt(" #n ")" ::: "memory")
#define GP_BAR __builtin_amdgcn_s_barrier()
#define GP_SCHED __builtin_amdgcn_sched_barrier(0)
    Unit cur, nxt; int ui = 0;
    if (!S.next(0, cur)) return;
    f32x4 acc[2][2][4][2];
#pragma unroll
    for (int a = 0; a < 2; ++a)
#pragma unroll
        for (int b = 0; b < 2; ++b)
#pragma unroll
            for (int m = 0; m < 4; ++m)
#pragma unroll
                for (int n = 0; n < 2; ++n) acc[a][b][m][n] = (f32x4){0.f, 0.f, 0.f, 0.f};
    bf16x8 At[4][2], B0[2][2], B1[2][2];
    const char* cA = cur.A; const char* cB = cur.B;
    GP_STAGE(GP_SB(0, 0), cB, voffB); GP_STAGE(GP_SB(0, 1), cB + hstepB, voffB); GP_STAGE(GP_SA(0, 0), cA, voffA); GP_STAGE(GP_SA(0, 1), cA + hstepA, voffA);
    if (wr == 1) GP_BAR;
    GP_WAIT_V(2); GP_BAR;
    GP_STAGE(GP_SB(1, 0), cB + kstep, voffB); GP_STAGE(GP_SA(1, 0), cA + kstep, voffA); GP_STAGE(GP_SB(1, 1), cB + hstepB + kstep, voffB);
    GP_WAIT_V(6); GP_BAR;
    for (;;) {
        const bool has_next = S.next(ui + 1, nxt);
        const char* nA = has_next ? nxt.A : cA; const char* nB = has_next ? nxt.B : cB;
        for (int t = 0; t < nt; t += 2) {
            const bool last = (t == nt - 2);
            const char* a1 = cA + (size_t)(t + 1) * kstep;
            const char* a2 = last ? nA : cA + (size_t)(t + 2) * kstep; const char* b2 = last ? nB : cB + (size_t)(t + 2) * kstep;
            const char* a3 = a2 + kstep; const char* b3 = b2 + kstep;
            GP_LDB(B0, 0, 0); GP_LDB(B1, 0, 1); GP_SCHED; GP_LDA(At, 0, 0); GP_STAGE(GP_SA(1, 1), a1 + hstepA, voffA);
            GP_WAIT_V(8); GP_WAIT_L(0); GP_BAR; GP_MMA(0, 0, At, B0); GP_MMA(0, 1, At, B1); GP_BAR; GP_SCHED;
            GP_LDA(At, 0, 1); GP_STAGE(GP_SB(0, 0), b2, voffB); GP_STAGE(GP_SB(0, 1), b2 + hstepB, voffB); GP_STAGE(GP_SA(0, 0), a2, voffA);
            GP_WAIT_V(8); GP_WAIT_L(0); GP_BAR; GP_MMA(1, 0, At, B0); GP_MMA(1, 1, At, B1); GP_BAR; GP_SCHED;
            GP_LDB(B0, 1, 0); GP_LDB(B1, 1, 1); GP_SCHED; GP_LDA(At, 1, 0); GP_STAGE(GP_SA(0, 1), a2 + hstepA, voffA);
            GP_WAIT_V(8); GP_WAIT_L(0); GP_BAR; GP_MMA(0, 0, At, B0); GP_MMA(0, 1, At, B1); GP_BAR; GP_SCHED;
            GP_LDA(At, 1, 1); GP_STAGE(GP_SB(1, 0), b3, voffB); GP_STAGE(GP_SB(1, 1), b3 + hstepB, voffB); GP_STAGE(GP_SA(1, 0), a3, voffA);
            GP_WAIT_V(8); GP_WAIT_L(0); GP_BAR; GP_MMA(1, 0, At, B0); GP_MMA(1, 1, At, B1); GP_BAR; GP_SCHED;
        }
        if (wr == 0) GP_BAR;
        E(acc, cur, wr, wc, fr, fq);
        if (!has_next) break;
        if (!epi_keeps(E, cur)) {
#pragma unroll
        for (int a = 0; a < 2; ++a)
#pragma unroll
            for (int b = 0; b < 2; ++b)
#pragma unroll
                for (int m = 0; m < 4; ++m)
#pragma unroll
                    for (int n = 0; n < 2; ++n) acc[a][b][m][n] = (f32x4){0.f, 0.f, 0.f, 0.f};
        }
        cur = nxt; cA = nA; cB = nB; ++ui;
        if (wr == 1) GP_BAR;
    }
    GP_WAIT_V(0);
    GP_BAR;
#undef GP_SA
#undef GP_SB
#undef GP_STAGE
#undef GP_LDA
#undef GP_LDB
#undef GP_MMA
#undef GP_WAIT_V
#undef GP_WAIT_L
#undef GP_BAR
#undef GP_SCHED
}

struct SchedP1 {
    const char *U, *Win, *Memn, *Wkv; int G, c;
    __device__ __forceinline__ bool next(int i, Unit& u) const {
        if (G == 256) {
            if (i < 24) { const int l = i * 32 + (c >> 3); int pm = l / 6, pn = 6 * (c & 7) + l % 6; pn = (pn % 3) * 16 + pn / 3;
                u.pm = pm; u.pn = pn; u.kind = pn >> 4; u.A = U + (size_t)pm * TILE; u.B = Win + (size_t)pn * TILE; return true; }
            if (i > 24 || c >= 32) return false;
            int L = c;
            if (L < 16) { u.pm = L >> 2; u.pn = L & 3; u.kind = 3; u.A = Memn + (size_t)u.pm * TILE; u.B = Wkv + (size_t)u.pn * TILE; }
            else { L -= 16; u.pm = L >> 2; u.pn = L & 3; u.kind = 4; u.A = Wkv + (size_t)(4 + u.pm) * TILE; u.B = Memn + (size_t)u.pn * TILE; }
            return true;
        }
        int L = i * G + c;
        if (L < 6144) { int pm, pn; remap_tile<4>(L, 128, 48, pm, pn); pn = (pn % 3) * 16 + pn / 3; u.pm = pm; u.pn = pn; u.kind = pn >> 4; u.A = U + (size_t)pm * TILE; u.B = Win + (size_t)pn * TILE; return true; }
        L -= 6144; if (L >= 32) return false;
        if (L < 16) { u.pm = L >> 2; u.pn = L & 3; u.kind = 3; u.A = Memn + (size_t)u.pm * TILE; u.B = Wkv + (size_t)u.pn * TILE; }
        else { L -= 16; u.pm = L >> 2; u.pn = L & 3; u.kind = 4; u.A = Wkv + (size_t)(4 + u.pm) * TILE; u.B = Memn + (size_t)u.pn * TILE; }
        return true;
    }
};
struct SchedAttn {
    const char *Aq, *Bm; size_t bstride_b, bstride_h; int G, c;
    __device__ __forceinline__ bool next(int i, Unit& u) const {
        const int L = i * G + c; if (L >= 512) return false;
        u.pm = L >> 2; u.pn = L & 3; u.kind = 0;
        u.A = Aq + (size_t)u.pm * TILE + (size_t)u.pn * 512; u.B = Bm + (size_t)(u.pm >> 5) * bstride_b + (size_t)u.pn * bstride_h; return true;
    }
};
struct SchedOut {
    const char *H, *HXp, *W; int G, c;
    __device__ __forceinline__ bool next(int i, Unit& u) const {
        const int ti = i / 3, g = i - 3 * ti; const int L = ti * G + c; if (L >= 512) return false;
        int pm, pn; remap_tile(L, 128, 4, pm, pn); u.pm = pm; u.pn = pn; u.kind = g;
        if (g == 2) u.A = HXp + (size_t)pm * TILE; else u.A = H + ((size_t)g * 128 + pm) * TILE;
        u.B = W + ((size_t)g * 4 + pn) * TILE; return true;
    }
};
struct SchedWo {
    const char *A, *W; int G, c;
    __device__ __forceinline__ bool next(int i, Unit& u) const {
        const int L = i * G + c; if (L >= 512) return false;
        int pm, pn; remap_tile(L, 128, 4, pm, pn); u.pm = pm; u.pn = pn; u.kind = 0; u.A = A + (size_t)pm * TILE; u.B = W + (size_t)pn * TILE; return true;
    }
};

__device__ __forceinline__ int pf(int fq) { return (fq >> 1) | ((fq & 1) << 1); }
__device__ __forceinline__ void store_pair16(bf16_t* rowbase  , u32x2 a  , u32x2 b  , int fq) {
    const auto rx = __builtin_amdgcn_permlane32_swap(a.x, b.x, false, false), ry = __builtin_amdgcn_permlane32_swap(a.y, b.y, false, false);
    *(u32x4*)(rowbase + (size_t)((fq >> 1) * 16) * 1024 + (fq & 1) * 8) = (u32x4){rx[0], ry[0], rx[1], ry[1]};
}
struct EpiP1 {
    bf16_t *HA, *GLU, *SZB, *SZX, *Q, *SGA, *SGB, *SGX, *KB, *VT, *PAT, *GAH; const float* convw;
    __device__ __forceinline__ void operator()(const f32x4 (&acc)[2][2][4][2], const Unit& u, int wr, int wc, int fr, int fq) const {
        if (u.kind <= 2) {
            const int chw = (u.pn & 15) * 64 + wc * 16, ch = chw + pf(fq) * 4;
            const int rowb = u.pm * 256 + wr * 64 + fr;
            if (u.kind == 0) {
                const f32x4 w0 = *(const f32x4*)(convw + ch), w1 = *(const f32x4*)(convw + 1024 + ch), w2 = *(const f32x4*)(convw + 2048 + ch);
#pragma unroll
                for (int ai = 0; ai < 2; ++ai) {
                    const int blk = u.pm * 4 + ai * 2 + wr;
                    f32x4 pprev = (f32x4){0.f, 0.f, 0.f, 0.f}; u32x2 hv[4];
#pragma unroll
                    for (int m = 0; m < 4; ++m) {
                        const f32x4 Bv = acc[ai][0][m][0], Cv = acc[ai][0][m][1], Xv = acc[ai][1][m][0], Zv = acc[ai][1][m][1];
                        const f32x4 p = Cv * Xv; f32x4 ga, p1, p2;
#pragma unroll
                        for (int j = 0; j < 4; ++j) {
                            ga[j] = siluf_(Zv[j]) * Bv[j];
                            const float r1 = (m > 0) ? dppf<0x121>(0.f, pprev[j]) : 0.f, r2 = (m > 0) ? dppf<0x122>(0.f, pprev[j]) : 0.f;
                            p1[j] = dppf<0x111>(r1, p[j]); p2[j] = dppf<0x112>(r2, p[j]);
                        }
                        const f32x4 cv = w2 * p + w1 * p1 + w0 * p2;
                        hv[m] = pk4(ga * cv);
                        if (m == 3 && fr >= 14) *(u32x2*)(PAT + (size_t)(blk * 2 + (fr - 14)) * 1024 + ch) = pk4(p);
                        if (m == 0 && fr < 2) *(u32x2*)(GAH + (size_t)(blk * 2 + fr) * 1024 + ch) = pk4(ga);
                        pprev = p;
                    }
#pragma unroll
                    for (int pr = 0; pr < 2; ++pr) store_pair16(HA + (size_t)(rowb + ai * 128 + pr * 32) * 1024 + chw, hv[2 * pr], hv[2 * pr + 1], fq);
                }
            } else if (u.kind == 1) {
#pragma unroll
                for (int ai = 0; ai < 2; ++ai) {
                    u32x2 gv[4], zv[4];
#pragma unroll
                    for (int m = 0; m < 4; ++m) {
                        const f32x4 Vv = acc[ai][0][m][0], Gv = acc[ai][0][m][1], Zb = acc[ai][1][m][0], Zx = acc[ai][1][m][1]; f32x4 o0, o1, o2;
#pragma unroll
                        for (int j = 0; j < 4; ++j) { o0[j] = Vv[j] * sigmoidf_(Gv[j]); o1[j] = siluf_(Zb[j]); o2[j] = siluf_(Zx[j]); }
                        gv[m] = pk4(o0); zv[m] = pk4(o1);
                        { const int c = (u.pn & 3) * 64 + wc * 16;
                          ((u32x2*)SZX)[native_slot(u.pm, (u.pn & 15) >> 2, wr * 4 + ((c >> 5) & 3), ai, m, c >> 7, (c >> 4) & 1, pf(fq) * 16 + fr)] = pk4(o2); }
                    }
#pragma unroll
                    for (int pr = 0; pr < 2; ++pr) {
                        store_pair16(GLU + (size_t)(rowb + ai * 128 + pr * 32) * 1024 + chw, gv[2 * pr], gv[2 * pr + 1], fq);
                        store_pair16(SZB + (size_t)(rowb + ai * 128 + pr * 32) * 1024 + chw, zv[2 * pr], zv[2 * pr + 1], fq);
                    }
                }
            } else {
#pragma unroll
                for (int ai = 0; ai < 2; ++ai) {
                    u32x2 qv[4];
#pragma unroll
                    for (int m = 0; m < 4; ++m) {
                        const f32x4 Qv = acc[ai][0][m][0], Ga = acc[ai][0][m][1], Gb = acc[ai][1][m][0], Gx = acc[ai][1][m][1]; f32x4 o1, o2, o3;
#pragma unroll
                        for (int j = 0; j < 4; ++j) { const float sa = sigmoidf_(Ga[j]), sb = sigmoidf_(Gb[j]), sx = sigmoidf_(Gx[j]);
                            o1[j] = sa * __builtin_amdgcn_rcpf(fmaxf(sb, 1e-30f)); o2[j] = sb * __builtin_amdgcn_rcpf(fmaxf(sx, 1e-30f)); o3[j] = sx; }
                        qv[m] = pk4(Qv * 0.0625f);
                        const int c = (u.pn & 3) * 64 + wc * 16;
                        const size_t ns = native_slot(u.pm, (u.pn & 15) >> 2, wr * 4 + ((c >> 5) & 3), ai, m, c >> 7, (c >> 4) & 1, pf(fq) * 16 + fr);
                        ((u32x2*)SGA)[ns] = pk4(o1); ((u32x2*)SGB)[ns] = pk4(o2); ((u32x2*)SGX)[ns] = pk4(o3);
                    }
#pragma unroll
                    for (int pr = 0; pr < 2; ++pr) store_pair16(Q + (size_t)(rowb + ai * 128 + pr * 32) * 1024 + chw, qv[2 * pr], qv[2 * pr + 1], fq);
                }
            }
        } else {
            const int r0 = wr * 64 + fr, c0 = wc * 32 + fq * 4;
#pragma unroll
            for (int ai = 0; ai < 2; ++ai)
#pragma unroll
                for (int m = 0; m < 4; ++m)
#pragma unroll
                    for (int bj = 0; bj < 2; ++bj)
#pragma unroll
                        for (int n = 0; n < 2; ++n) {
                            const int r = r0 + ai * 128 + m * 16, c = c0 + bj * 128 + n * 16;
                            if (u.kind == 3) *(u32x2*)(KB + (size_t)(u.pm * 256 + r) * 1024 + u.pn * 256 + c) = pk4(acc[ai][bj][m][n]);
                            else             *(u32x2*)(VT + ((size_t)u.pn * 1024 + u.pm * 256 + r) * 256 + c) = pk4(acc[ai][bj][m][n]);
                        }
        }
    }
};
struct EpiS {
    bf16_t* Q; float* RSUM;
    __device__ __forceinline__ void operator()(const f32x4 (&acc)[2][2][4][2], const Unit& u, int wr, int wc, int fr, int fq) const {
#pragma unroll
        for (int ai = 0; ai < 2; ++ai)
#pragma unroll
            for (int m = 0; m < 4; ++m) {
                const int row = u.pm * 256 + ai * 128 + wr * 64 + m * 16 + fr; float rs = 0.f;
#pragma unroll
                for (int bj = 0; bj < 2; ++bj)
#pragma unroll
                    for (int n = 0; n < 2; ++n) {
                        const f32x4 s = acc[ai][bj][m][n]; f32x4 e;
#pragma unroll
                        for (int j = 0; j < 4; ++j) e[j] = __builtin_amdgcn_exp2f(1.44269504089f * s[j]);
                        const u32x2 w = pk4(e); const f32x4 er = unpk4(w); rs += (er[0] + er[1]) + (er[2] + er[3]);
                        *(u32x2*)(Q + (size_t)row * 1024 + u.pn * 256 + bj * 128 + wc * 32 + n * 16 + fq * 4) = w;
                    }
                rs += __shfl_xor(rs, 16); rs += __shfl_xor(rs, 32);
                if (fq == 0) unsafeAtomicAdd(RSUM + row * 4 + u.pn, rs);
            }
    }
};
struct EpiPV {
    const bf16_t* SZXN; bf16_t* HX; const float* RSUM;
    __device__ __forceinline__ void operator()(const f32x4 (&acc)[2][2][4][2], const Unit& u, int wr, int wc, int fr_in, int fq_in) const {
        int fr = fr_in, fq = fq_in; asm volatile("" : "+v"(fr), "+v"(fq));
        const int w4 = wr * 4 + wc, lane = fq * 16 + fr;
#pragma unroll
        for (int ai = 0; ai < 2; ++ai) {
            u32x2 z[4][2][2]; float rs[4];
#pragma unroll
            for (int m = 0; m < 4; ++m) {
                rs[m] = RSUM[(u.pm * 256 + ai * 128 + wr * 64 + m * 16 + fr) * 4 + u.pn];
#pragma unroll
                for (int bj = 0; bj < 2; ++bj)
#pragma unroll
                    for (int n = 0; n < 2; ++n) z[m][bj][n] = ((const u32x2*)SZXN)[native_slot(u.pm, u.pn, w4, ai, m, bj, n, lane)];
            }
#pragma unroll
            for (int m = 0; m < 4; ++m) {
                const int row = u.pm * 256 + ai * 128 + wr * 64 + m * 16 + fr; const float inv = __builtin_amdgcn_rcpf(rs[m]);
#pragma unroll
                for (int bj = 0; bj < 2; ++bj)
#pragma unroll
                    for (int n = 0; n < 2; ++n)
                        *(u32x2*)(HX + (size_t)row * 1024 + u.pn * 256 + bj * 128 + wc * 32 + n * 16 + fq * 4) = pk4(unpk4(z[m][bj][n]) * (acc[ai][bj][m][n] * inv));
            }
        }
    }
};
__device__ __forceinline__ void ld8(u32x2 (&d)[8], const u32x2* p) {
    asm volatile("global_load_dwordx2 %0, %1, off"             : "=v"(d[0]) : "v"(p) : "memory");
    asm volatile("global_load_dwordx2 %0, %1, off offset:512"  : "=v"(d[1]) : "v"(p) : "memory");
    asm volatile("global_load_dwordx2 %0, %1, off offset:1024" : "=v"(d[2]) : "v"(p) : "memory");
    asm volatile("global_load_dwordx2 %0, %1, off offset:1536" : "=v"(d[3]) : "v"(p) : "memory");
    asm volatile("global_load_dwordx2 %0, %1, off offset:2048" : "=v"(d[4]) : "v"(p) : "memory");
    asm volatile("global_load_dwordx2 %0, %1, off offset:2560" : "=v"(d[5]) : "v"(p) : "memory");
    asm volatile("global_load_dwordx2 %0, %1, off offset:3072" : "=v"(d[6]) : "v"(p) : "memory");
    asm volatile("global_load_dwordx2 %0, %1, off offset:3584" : "=v"(d[7]) : "v"(p) : "memory");
}
__device__ __forceinline__ void ld4(u32x2 (&d)[4], const u32x2* p) {
    asm volatile("global_load_dwordx2 %0, %1, off"             : "=v"(d[0]) : "v"(p) : "memory");
    asm volatile("global_load_dwordx2 %0, %1, off offset:512"  : "=v"(d[1]) : "v"(p) : "memory");
    asm volatile("global_load_dwordx2 %0, %1, off offset:1024" : "=v"(d[2]) : "v"(p) : "memory");
    asm volatile("global_load_dwordx2 %0, %1, off offset:1536" : "=v"(d[3]) : "v"(p) : "memory");
}
__device__ __forceinline__ void tie4(u32x2 (&d)[4]) { asm volatile("" : "+v"(d[0]), "+v"(d[1]), "+v"(d[2]), "+v"(d[3])); }
__device__ __forceinline__ void tie8(u32x2 (&d)[8]) { asm volatile("" : "+v"(d[0]), "+v"(d[1]), "+v"(d[2]), "+v"(d[3]), "+v"(d[4]), "+v"(d[5]), "+v"(d[6]), "+v"(d[7])); }

struct EpiOut {
    const bf16_t *F1, *F2, *F3; bf16_t* MERGED;
    template <int POS> __device__ __forceinline__ void run(f32x4 (&acc)[2][2][4][2], const Unit& u, const bf16_t* F, int wr, int wc, int fr, int fq) const {
        const int w4 = wr * 4 + wc, lane = fq * 16 + fr;
        const u32x2* s0 = (const u32x2*)F + native_slot(u.pm, u.pn, w4, 0, 0, 0, 0, lane);
        u32x2 ga[2][4];
        ld4(ga[0], s0); ld4(ga[1], s0 + 256);
#pragma unroll
        for (int e = 0; e < 8; ++e) {
            if (POS < 2) { if (e < 7) asm volatile("s_waitcnt vmcnt(4)" ::: "memory"); else asm volatile("s_waitcnt vmcnt(0)" ::: "memory"); }
            else { if (e == 0) asm volatile("s_waitcnt vmcnt(4)" ::: "memory"); else if (e < 7) asm volatile("s_waitcnt vmcnt(8)" ::: "memory"); else asm volatile("s_waitcnt vmcnt(4)" ::: "memory"); }
            tie4(ga[e & 1]);
            const int ai = e >> 2, m = e & 3;
#pragma unroll
            for (int k = 0; k < 4; ++k) { const int bj = k >> 1, n = k & 1;
                const f32x4 f = unpk4(ga[e & 1][k]);
                if (POS < 2) acc[ai][bj][m][n] *= f;
                else *(u32x2*)(MERGED + (size_t)(u.pm * 256 + ai * 128 + wr * 64 + m * 16 + fr) * 1024 + u.pn * 256 + bj * 128 + wc * 32 + n * 16 + fq * 4) = pk4(f * acc[ai][bj][m][n]);
            }
            if (e + 2 < 8) ld4(ga[e & 1], s0 + (e + 2) * 256);
        }
    }
    __device__ __forceinline__ void operator()(f32x4 (&acc)[2][2][4][2], const Unit& u, int wr, int wc, int fr, int fq) const {
        if (u.kind < 2) run<0>(acc, u, F1 + ((size_t)u.kind << 25)  , wr, wc, fr, fq);
        else run<2>(acc, u, F3, wr, wc, fr, fq);
    }
};
struct EpiWo {
    const float* X; bf16_t* HN; float* ROWSS;
    __device__ __forceinline__ void operator()(const f32x4 (&acc)[2][2][4][2], const Unit& u, int wr, int wc, int fr, int fq) const {
        const int w4 = wr * 4 + wc, lane = fq * 16 + fr;
#pragma unroll
        for (int ai = 0; ai < 2; ++ai) {
            f32x4 xv[4][2][2];
#pragma unroll
            for (int m = 0; m < 4; ++m)
#pragma unroll
                for (int bj = 0; bj < 2; ++bj)
#pragma unroll
                    for (int n = 0; n < 2; ++n)
                        xv[m][bj][n] = *(const f32x4*)(X + (size_t)(u.pm * 256 + ai * 128 + wr * 64 + m * 16 + fr) * 1024 + u.pn * 256 + bj * 128 + wc * 32 + n * 16 + fq * 4);
#pragma unroll
            for (int m = 0; m < 4; ++m) {
                const int row = u.pm * 256 + ai * 128 + wr * 64 + m * 16 + fr; float ss = 0.f;
#pragma unroll
                for (int bj = 0; bj < 2; ++bj)
#pragma unroll
                    for (int n = 0; n < 2; ++n) {
                        const u32x2 hw = pk4(xv[m][bj][n] + acc[ai][bj][m][n]); const f32x4 h = unpk4(hw);
                        ((u32x2*)HN)[native_slot(u.pm, u.pn, w4, ai, m, bj, n, lane)] = hw; ss += (h[0] * h[0] + h[1] * h[1]) + (h[2] * h[2] + h[3] * h[3]);
                    }
                ss += __shfl_xor(ss, 16); ss += __shfl_xor(ss, 32);
                if (fq == 0) unsafeAtomicAdd(ROWSS + row, ss);
            }
        }
    }
};

__device__ __forceinline__ int win_src_col(int R) {
    const int unit = R >> 8, rho = R & 255, kind = unit >> 4, cu = unit & 15;
    const int fqb = (rho >> 2) & 3;
    const int gi = ((rho >> 7) & 1) * 2 + ((rho >> 4) & 1), chl = ((rho >> 5) & 3) * 16 + (((fqb >> 1) | ((fqb & 1) << 1)) << 2) + (rho & 3);
    int base;
    if (kind == 0) base = gi * 1024;
    else if (kind == 1) base = (gi < 3) ? 4096 + gi * 1024 : 8192;
    else base = (gi == 0) ? 7168 : 9216 + (gi - 1) * 1024;
    return base + cu * 64 + chl;
}
__device__ __forceinline__ void p0_transpose_item(const float* W, int ldw, bf16_t* WT, int dst_row0, int k0, bool perm, LAS float* scr, int lane) {
    const int li = lane & 31; const int drow = dst_row0 + (perm ? ((li & 15) + ((li >> 4) << 5)) : li); const int scol = perm ? win_src_col(drow) : drow;
#pragma unroll
    for (int i = 0; i < 32; ++i) { const int kk = 2 * i + (lane >> 5); scr[kk * 33 + (lane & 31)] = W[(size_t)(k0 + kk) * ldw + scol]; }
    asm volatile("s_waitcnt lgkmcnt(0)" ::: "memory");
    const int c = lane & 7;
#pragma unroll
    for (int j = 0; j < 4; ++j) { const int n = (lane >> 3) + 8 * j; const LAS float* s = scr + (8 * c) * 33 + n;
        u32x4 o; o.x = pk_bf16(s[0 * 33], s[1 * 33]); o.y = pk_bf16(s[2 * 33], s[3 * 33]); o.z = pk_bf16(s[4 * 33], s[5 * 33]); o.w = pk_bf16(s[6 * 33], s[7 * 33]);
        const int orow = dst_row0 + (perm ? ((n & 15) + ((n >> 4) << 5)) : n);
        *(u32x4*)(WT + (size_t)orow * 1024 + k0 + 8 * c) = o; }
    asm volatile("s_waitcnt lgkmcnt(0)" ::: "memory");
}
__device__ __forceinline__ void rms_row_to_bf16(const float* xrow, const float* g, bf16_t* orow, int lane) {
    const f32x4* xr = (const f32x4*)xrow + lane; const f32x4* gr = (const f32x4*)g + lane;
    f32x4 v[4]; float s = 0.f;
#pragma unroll
    for (int j = 0; j < 4; ++j) { v[j] = xr[64 * j]; s += (v[j][0] * v[j][0] + v[j][1] * v[j][1]) + (v[j][2] * v[j][2] + v[j][3] * v[j][3]); }
    const float rstd = 1.0f / sqrtf(wave_sum(s) * (1.f / 1024.f) + EPS);
    u32x2* o8 = (u32x2*)orow + lane;
#pragma unroll
    for (int j = 0; j < 4; ++j) { const f32x4 gg = gr[64 * j]; o8[64 * j] = pk4(v[j] * rstd * gg); }
}

template <int PH>
__device__ __forceinline__ void conv31_chunk(LAS unsigned char* lds, LAS float* red, LAS float* stats, const bf16_t* GLU, bf16_t* SZB, const float* cw, const float* cb, const float* lng, const float* lnb,
                                            const int t0, const bool has_next, const int tid_in) {
    int tid_o = tid_in; asm volatile("" : "+v"(tid_o));
    const int tid = tid_o, lane = tid & 63, wid = tid >> 6, c2 = tid * 2;
    u32x4 nx[4];
    if (has_next) {
        int tf = tid; asm volatile("" : "+v"(tf));
#pragma unroll
        for (int q = 0; q < 4; ++q) { const int i = tf + q * 512; nx[q] = *(const u32x4*)(GLU + (size_t)(t0 + 16 + (i >> 7)) * 1024 + (i & 127) * 8); }
    }
    const f32x2 bias = *(const f32x2*)(cb + c2);
    f32x2 outv[16];
#pragma unroll
    for (int t = 0; t < 16; ++t) outv[t] = bias;
#pragma unroll
    for (int ps = 0; ps < 2; ++ps) {
        const int kb = ps * 16, ntap = ps == 0 ? 16 : 15;
        f32x2 w[16];
#pragma unroll
        for (int k = 0; k < 16; ++k) if (k < ntap) w[k] = *(const f32x2*)(cw + (kb + k) * 1024 + c2);
#pragma unroll
        for (int r = 0; r < 31; ++r) if (r < ntap + 15) {
            const unsigned v = *(const LAS unsigned*)(lds + ((34 + 16 * PH + kb + r) & 63) * 2048 + tid * 4);
            const f32x2 x = (f32x2){bf_lo(v), bf_hi(v)};
#pragma unroll
            for (int t = 0; t < 16; ++t) { const int k = r - t; if (k >= 0 && k < ntap) outv[t] = __builtin_elementwise_fma(w[k], x, outv[t]); }
            if ((r & 7) == 7) asm volatile("" ::: "memory");
        }
    }
    {
        float s[16], q[16];
#pragma unroll
        for (int t = 0; t < 16; ++t) { s[t] = outv[t][0] + outv[t][1]; q[t] = outv[t][0] * outv[t][0] + outv[t][1] * outv[t][1]; }
#pragma unroll
        for (int lvl = 0; lvl < 4; ++lvl) {
            const int half = 8 >> lvl, off = 32 >> lvl; const bool hi = (lane & off) != 0;
#pragma unroll
            for (int i = 0; i < half; ++i) {
                const float ks = hi ? s[i + half] : s[i], ss = hi ? s[i] : s[i + half]; s[i] = ks + __shfl_xor(ss, off);
                const float kq = hi ? q[i + half] : q[i], sq = hi ? q[i] : q[i + half]; q[i] = kq + __shfl_xor(sq, off);
            }
        }
        s[0] += __shfl_xor(s[0], 2); q[0] += __shfl_xor(q[0], 2);
        s[0] += __shfl_xor(s[0], 1); q[0] += __shfl_xor(q[0], 1);
        if ((lane & 3) == 0) *(LAS f32x2*)(red + ((lane >> 2) * 8 + wid) * 2) = (f32x2){s[0], q[0]};
    }
    __syncthreads();
    if (has_next) {
#pragma unroll
        for (int q = 0; q < 4; ++q) { const int i = tid + q * 512; *(LAS u32x4*)(lds + ((34 + 16 * PH + 46 + (i >> 7)) & 63) * 2048 + (i & 127) * 16) = nx[q]; }
    }
    if (tid < 16) {
        float S = 0.f, Q2 = 0.f;
#pragma unroll
        for (int wv = 0; wv < 8; ++wv) { const f32x2 t = *(const LAS f32x2*)(red + (tid * 8 + wv) * 2); S += t[0]; Q2 += t[1]; }
        const float mean = S * (1.f / 1024.f), var = fmaxf(Q2 * (1.f / 1024.f) - mean * mean, 0.f);
        *(LAS f32x2*)(stats + tid * 2) = (f32x2){mean, 1.0f / sqrtf(var + EPS)};
    }
    __syncthreads();
    const f32x2 lg = *(const f32x2*)(lng + c2), lb = *(const f32x2*)(lnb + c2);
    unsigned zz[16];
#pragma unroll
    for (int t = 0; t < 16; ++t) zz[t] = *(const unsigned*)(SZB + (size_t)(t0 + t) * 1024 + c2);
#pragma unroll
    for (int t = 0; t < 16; ++t) {
        const f32x2 st = *(const LAS f32x2*)(stats + t * 2);
        const float y0 = (outv[t][0] - st[0]) * st[1] * lg[0] + lb[0], y1 = (outv[t][1] - st[0]) * st[1] * lg[1] + lb[1];
        *(unsigned*)(SZB + (size_t)(t0 + t) * 1024 + c2) = pk_bf16(bf_lo(zz[t]) * siluf_(y0), bf_hi(zz[t]) * siluf_(y1));
    }
}
__device__ __forceinline__ void conv31_phase(LAS unsigned char* lds, const bf16_t* GLU, bf16_t* SZB, const float* cw, const float* cb, const float* lng, const float* lnb, int G, int c, const int widx) {
    int tid_ = tid_of(widx); asm volatile("" : "+v"(tid_));
    const int tid = tid_;
    LAS float* red = (LAS float*)(lds + 131072 + 1024);
    LAS float* stats = (LAS float*)(lds + 131072 + 3072);
    for (int run = c; run < NTOK / 128; run += G) {
        const int T0 = run * 128, tpos = T0 & (SEQ - 1);
        __syncthreads();
#pragma unroll
        for (int h = 0; h < 2; ++h) {
            int tf = tid; asm volatile("" : "+v"(tf));
            u32x4 tv[6];
#pragma unroll
            for (int q = 0; q < 6; ++q) { const int i = tf + (h * 6 + q) * 512, r = (i >> 7) < 46 ? (i >> 7) : 45; const int gr = (tpos - 30 + r >= 0) ? (T0 - 30 + r) : T0;
                tv[q] = *(const u32x4*)(GLU + (size_t)gr * 1024 + (i & 127) * 8); }
#pragma unroll
            for (int q = 0; q < 6; ++q) { const int i = tf + (h * 6 + q) * 512, r = i >> 7;
                if (r < 46) *(LAS u32x4*)(lds + ((34 + r) & 63) * 2048 + (i & 127) * 16) = (tpos - 30 + r >= 0) ? tv[q] : (u32x4){0u, 0u, 0u, 0u}; }
        }
        __syncthreads();
        conv31_chunk<0>(lds, red, stats, GLU, SZB, cw, cb, lng, lnb, T0, true, tid);
        conv31_chunk<1>(lds, red, stats, GLU, SZB, cw, cb, lng, lnb, T0 + 16, true, tid);
        conv31_chunk<2>(lds, red, stats, GLU, SZB, cw, cb, lng, lnb, T0 + 32, true, tid);
        conv31_chunk<3>(lds, red, stats, GLU, SZB, cw, cb, lng, lnb, T0 + 48, true, tid);
        conv31_chunk<0>(lds, red, stats, GLU, SZB, cw, cb, lng, lnb, T0 + 64, true, tid);
        conv31_chunk<1>(lds, red, stats, GLU, SZB, cw, cb, lng, lnb, T0 + 80, true, tid);
        conv31_chunk<2>(lds, red, stats, GLU, SZB, cw, cb, lng, lnb, T0 + 96, true, tid);
        conv31_chunk<3>(lds, red, stats, GLU, SZB, cw, cb, lng, lnb, T0 + 112, false, tid);
    }
    __syncthreads();
}

__global__ void __launch_bounds__(512, 2) fwd_megakernel(Params p) {
    extern __shared__ __attribute__((aligned(16))) unsigned char lds_raw[];
    LAS unsigned char* lds = (LAS unsigned char*)lds_raw;
    const int G = gridDim.x, bx = blockIdx.x;
    unsigned char* ws = p.ws; unsigned char* ob = (unsigned char*)p.out;
    const float *x = p.in[0], *mem = p.in[1], *norm_g = p.in[2], *w_in = p.in[3], *conv_a_w = p.in[4], *w_out_a = p.in[5], *conv_b_w = p.in[6], *conv_b_b = p.in[7],
                *ln_b_g = p.in[8], *ln_b_b = p.in[9], *w_out_b = p.in[10], *mem_norm_g = p.in[11], *w_kv = p.in[12], *w_out_x = p.in[13], *w_o = p.in[14], *final_g = p.in[15];
    bf16_t *WIN = (bf16_t*)(ws + WS_WIN), *WOUT = (bf16_t*)(ws + WS_WOUT), *WO = (bf16_t*)(ws + WS_WO), *WKV = (bf16_t*)(ws + WS_WKV), *MEMN = (bf16_t*)(ws + WS_MEMN),
           *KB = (bf16_t*)(ws + WS_KB), *VT = (bf16_t*)(ws + WS_VT), *PAT = (bf16_t*)(ws + WS_PAT), *GAH = (bf16_t*)(ws + WS_GAH), *HA = (bf16_t*)(ws + WS_HA), *SZB = (bf16_t*)(ws + WS_SZB),
           *SZX = (bf16_t*)(ws + WS_SZX), *GLU = (bf16_t*)(ws + WS_GLU), *Q = (bf16_t*)(ws + WS_Q), *SGA = (bf16_t*)(ws + WS_SGA), *SGB = (bf16_t*)(ws + WS_SGB),
           *U = (bf16_t*)(ob + OUT_U), *SGX = (bf16_t*)(ob + OUT_SGX);
    float *ROWSS = (float*)(ws + WS_ROWSS), *RSUM = (float*)(ws + WS_RSUM);
    bf16_t* MERGED = GLU;
    volatile LAS unsigned* xst = (volatile LAS unsigned*)(lds + 131072 + 512);
    const int widx = __builtin_amdgcn_readfirstlane((int)threadIdx.x >> 6);
    if (threadIdx.x < 4) xst[threadIdx.x] = 0u;
    __syncthreads();
    XcdBarrier xb = xcd_barrier_post((unsigned*)(ws + WS_BAR), xst, threadIdx.x == 0);

    {
        int tid_ = tid_of(widx); asm volatile("" : "+v"(tid_)); const int tid = tid_, lane = tid & 63, wave = tid >> 6;
        LAS float* scr = (LAS float*)(lds + wave * 16384);
        const int gw = bx * 8 + wave, NGW = G * 8;
        for (int it = gw; it < 9216; it += NGW) {
            int r = it;
            if (r < 6144) { const int g = r % 384; p0_transpose_item(w_in, 12288, WIN, (g >> 1) * 64 + (g & 1) * 16, (r / 384) * 64, true, scr, lane); continue; } r -= 6144;
            if (r < 512) { p0_transpose_item(w_out_a, 1024, WOUT, (r & 31) * 32, (r >> 5) * 64, false, scr, lane); continue; } r -= 512;
            if (r < 512) { p0_transpose_item(w_out_b, 1024, WOUT + (size_t)1024 * 1024, (r & 31) * 32, (r >> 5) * 64, false, scr, lane); continue; } r -= 512;
            if (r < 512) { p0_transpose_item(w_out_x, 1024, WOUT + (size_t)2048 * 1024, (r & 31) * 32, (r >> 5) * 64, false, scr, lane); continue; } r -= 512;
            if (r < 512) { p0_transpose_item(w_o, 1024, WO, (r & 31) * 32, (r >> 5) * 64, false, scr, lane); continue; } r -= 512;
            p0_transpose_item(w_kv, 2048, WKV, (r & 63) * 32, (r >> 6) * 64, false, scr, lane);
        }
        {
            const f32x4* gr = (const f32x4*)norm_g + lane; f32x4 gg[4];
#pragma unroll
            for (int j = 0; j < 4; ++j) gg[j] = gr[64 * j];
            for (int m = gw; m < NTOK; m += 4 * NGW) {
                f32x4 v[4][4];
#pragma unroll
                for (int r = 0; r < 4; ++r) { const f32x4* xr = (const f32x4*)(x + (size_t)(m + r * NGW) * 1024) + lane;
#pragma unroll
                    for (int j = 0; j < 4; ++j) v[r][j] = __builtin_nontemporal_load(xr + 64 * j); }
#pragma unroll
                for (int r = 0; r < 4; ++r) {
                    float sq = 0.f;
#pragma unroll
                    for (int j = 0; j < 4; ++j) sq += (v[r][j][0] * v[r][j][0] + v[r][j][1] * v[r][j][1]) + (v[r][j][2] * v[r][j][2] + v[r][j][3] * v[r][j][3]);
                    const float rstd = 1.0f / sqrtf(wave_sum(sq) * (1.f / 1024.f) + EPS);
                    u32x2* o8 = (u32x2*)(U + (size_t)(m + r * NGW) * 1024) + lane;
#pragma unroll
                    for (int j = 0; j < 4; ++j) o8[64 * j] = pk4(v[r][j] * rstd * gg[j]);
                }
            }
        }
        for (int m = gw; m < 1024; m += NGW) rms_row_to_bf16(mem + (size_t)m * 1024, mem_norm_g, MEMN + (size_t)m * 1024, lane);
        for (int i = bx * 512 + tid; i < NTOK * 5; i += G * 512) ROWSS[i] = 0.f;
    }
    GRID_SYNC();

    {
        SchedP1 S{(const char*)U, (const char*)WIN, (const char*)MEMN, (const char*)WKV, G, bx};
        EpiP1 E{HA, GLU, SZB, SZX, Q, SGA, SGB, SGX, KB, VT, PAT, GAH, conv_a_w};
        gemm_phase(lds, 1024, 1024, 1024, S, E, widx);
    }
    GRID_SYNC();

    {
        int tid_ = tid_of(widx); asm volatile("" : "+v"(tid_)); const int tid = tid_;
        for (int i = bx * 512 + tid; i < 512 * 256; i += G * 512) {
            const int blk = i >> 8, ch = (i & 255) * 4;
            if ((blk & 127) != 0) {
                const f32x4 w0 = *(const f32x4*)(conv_a_w + ch), w1 = *(const f32x4*)(conv_a_w + 1024 + ch);
                const f32x4 pt0 = unpk4(*(const u32x2*)(PAT + (size_t)((blk - 1) * 2 + 0) * 1024 + ch)), pt1 = unpk4(*(const u32x2*)(PAT + (size_t)((blk - 1) * 2 + 1) * 1024 + ch));
                const f32x4 g0 = unpk4(*(const u32x2*)(GAH + (size_t)(blk * 2 + 0) * 1024 + ch)), g1 = unpk4(*(const u32x2*)(GAH + (size_t)(blk * 2 + 1) * 1024 + ch));
                u32x2* h0 = (u32x2*)(HA + (size_t)(blk * 64) * 1024 + ch); u32x2* h1 = (u32x2*)(HA + (size_t)(blk * 64 + 1) * 1024 + ch);
                *h0 = pk4(unpk4(*h0) + g0 * (w1 * pt1 + w0 * pt0));
                *h1 = pk4(unpk4(*h1) + g1 * (w0 * pt1));
            }
        }
        { SchedAttn S{(const char*)Q, (const char*)KB, TILE, (size_t)512, G, bx}; EpiS E{Q, RSUM}; gemm_phase(lds, 1024, 1024, 256, S, E, widx); }
        conv31_phase(lds, GLU, SZB, conv_b_w, conv_b_b, ln_b_g, ln_b_b, G, bx, widx);
    }
    asm volatile("s_waitcnt vmcnt(0) lgkmcnt(0)" ::: "memory"); __syncthreads();
    __builtin_amdgcn_fence(__ATOMIC_ACQUIRE, "agent"); asm volatile("s_waitcnt vmcnt(0)" ::: "memory"); __syncthreads();

    { SchedAttn S{(const char*)Q, (const char*)VT, (size_t)1024 * 256 * 2, (size_t)256 * 256 * 2, G, bx}; EpiPV E{SZX, U  , RSUM}; gemm_phase(lds, 1024, 256, 256, S, E, widx); }
    GRID_SYNC();

    { SchedOut S{(const char*)HA, (const char*)U, (const char*)WOUT, G, bx}; EpiOut E{SGA, SGB, SGX, MERGED}; gemm_phase(lds, 1024, 1024, 1024, S, E, widx); }
    GRID_SYNC();

    { SchedWo S{(const char*)MERGED, (const char*)WO, G, bx}; EpiWo E{x, HA  , ROWSS}; gemm_phase(lds, 1024, 1024, 1024, S, E, widx); }
    GRID_SYNC();

    {
        int tid_ = tid_of(widx); asm volatile("" : "+v"(tid_)); const int lane = tid_ & 63, w4 = tid_ >> 6, wr = w4 >> 2, wc = w4 & 3, fr = lane & 15, fq = lane >> 4;
        for (int L = bx; L < 512; L += G) {
            int pm, pn; remap_tile(L, 128, 4, pm, pn);
#pragma unroll
            for (int ai = 0; ai < 2; ++ai) {
                u32x2 hv[4][2][2]; float rs[4]; f32x4 gg[2][2];
#pragma unroll
                for (int m = 0; m < 4; ++m) {
                    rs[m] = ROWSS[pm * 256 + ai * 128 + wr * 64 + m * 16 + fr];
#pragma unroll
                    for (int bj = 0; bj < 2; ++bj)
#pragma unroll
                        for (int n = 0; n < 2; ++n) hv[m][bj][n] = ((const u32x2*)HA)[native_slot(pm, pn, w4, ai, m, bj, n, fq * 16 + fr)];
                }
#pragma unroll
                for (int bj = 0; bj < 2; ++bj)
#pragma unroll
                    for (int n = 0; n < 2; ++n) gg[bj][n] = *(const f32x4*)(final_g + pn * 256 + bj * 128 + wc * 32 + n * 16 + fq * 4);
#pragma unroll
                for (int m = 0; m < 4; ++m) {
                    const float rstd = 1.0f / sqrtf(rs[m] * (1.f / 1024.f) + EPS);
#pragma unroll
                    for (int bj = 0; bj < 2; ++bj)
#pragma unroll
                        for (int n = 0; n < 2; ++n)
                            *(f32x4*)(p.out + (size_t)(pm * 256 + ai * 128 + wr * 64 + m * 16 + fr) * 1024 + pn * 256 + bj * 128 + wc * 32 + n * 16 + fq * 4) = unpk4(hv[m][bj][n]) * rstd * gg[bj][n];
                }
            }
        }
    }
}

extern "C" void kernel_launch(void* const* d_in, const int* in_sizes, int n_in, void* d_out, int out_size, void* d_ws, size_t ws_size, hipStream_t stream) {
    static int grid_blocks = 0;
    if (!grid_blocks) {
        int dev = 0, cus = 0, per_cu = 0;
        hipGetDevice(&dev);
        hipDeviceGetAttribute(&cus, hipDeviceAttributeMultiprocessorCount, dev);
        hipFuncSetAttribute((const void*)fwd_megakernel, hipFuncAttributeMaxDynamicSharedMemorySize, LDS_BYTES);
        hipOccupancyMaxActiveBlocksPerMultiprocessor(&per_cu, (const void*)fwd_megakernel, 512, LDS_BYTES);
        if (per_cu < 1) { fprintf(stderr, "kernel_launch: occupancy query reports %d blocks per CU\n", per_cu); per_cu = 1; }
        if (per_cu > 1) per_cu = 1;
        grid_blocks = cus * per_cu;
        if (ws_size < WS_END) fprintf(stderr, "kernel_launch: workspace too small: %zu < %zu\n", ws_size, (size_t)WS_END);
    }
    (void)hipMemsetAsync((char*)d_ws + WS_BAR, 0, XCD_BAR_WORDS * 4, stream);
    if (ws_size < WS_END) return;
    Params p{};
    for (int i = 0; i < 16; ++i) p.in[i] = (const float*)d_in[i];
    p.out = (float*)d_out; p.ws = (unsigned char*)d_ws;
    void* args[] = {&p};
    hipError_t e = hipLaunchCooperativeKernel((const void*)fwd_megakernel, dim3(grid_blocks), dim3(512), args, LDS_BYTES, stream);
    if (e != hipSuccess) fprintf(stderr, "cooperative launch failed: %s (grid %d)\n", hipGetErrorString(e), grid_blocks);
}
```

```cpp
#include <hip/hip_runtime.h>
#include <cstdio>

#define LAS __attribute__((address_space(3)))
typedef unsigned short bf16_t;
typedef short bf16x8 __attribute__((ext_vector_type(8)));
typedef float f32x4 __attribute__((ext_vector_type(4)));
typedef float f32x2 __attribute__((ext_vector_type(2)));
typedef unsigned u32x4 __attribute__((ext_vector_type(4)));
typedef unsigned u32x2 __attribute__((ext_vector_type(2)));

constexpr int BM = 256, BK = 64, HALF = 128, HTB = HALF * BK * 2, STAGE_BYTES = 8 * HTB;
constexpr int LDS_BYTES = 147456;
constexpr int NTOK = 32768, DM = 1024, SEQ = 8192;
constexpr float EPS = 1e-6f;
constexpr size_t MiB = 1u << 20;
constexpr size_t TILE = (size_t)256 * 1024 * 2;
constexpr size_t WS_WIN = 0, WS_WOUT = 24 * MiB, WS_WO = 30 * MiB, WS_WKV = 32 * MiB, WS_MEMN = 36 * MiB, WS_KB = 38 * MiB, WS_VT = 40 * MiB;
constexpr size_t WS_ROWSS = 42 * MiB, WS_RSUM = 42 * MiB + 131072, WS_PAT = 43 * MiB, WS_GAH = 45 * MiB;
constexpr size_t WS_BAR = 47 * MiB;
constexpr size_t WS_HA = 48 * MiB, WS_SZB = 112 * MiB, WS_SZX = 176 * MiB, WS_GLU = 240 * MiB, WS_Q = 304 * MiB, WS_SGA = 368 * MiB, WS_SGB = 432 * MiB, WS_END = 496 * MiB;
constexpr size_t OUT_U = 0, OUT_SGX = 64 * MiB;

#define XB_TMO      128
#define XB_XCNT(j)  (256  + 64 * (j))
#define XB_XSUB(j)  (1280 + 64 * (j))
#define XB_XGEN(j)  (2304 + 64 * (j))
#define XB_TOP      3328
#define XB_TOPGEN   3392
#define XCD_BAR_WORDS 3456
#define XB_SPIN_CAP (1u << 18)

__device__ __forceinline__ unsigned xb_ld(unsigned* p)              { return __hip_atomic_load(p, __ATOMIC_RELAXED, __HIP_MEMORY_SCOPE_AGENT); }
__device__ __forceinline__ unsigned xb_add(unsigned* p, unsigned v) { return __hip_atomic_fetch_add(p, v, __ATOMIC_RELAXED, __HIP_MEMORY_SCOPE_AGENT); }
__device__ __forceinline__ unsigned xb_xcc_id() { return (unsigned)__builtin_amdgcn_s_getreg((3 << 11) | 20) & 0xFu; }
#define XB_SPIN(cond, bar) do { unsigned _sp = 0; while (cond) { __builtin_amdgcn_s_sleep(1); \
    if ((++_sp & 255u) == 0u) { if (xb_ld(&(bar)[XB_TMO])) break; if (_sp > XB_SPIN_CAP) { atomicAdd(&(bar)[XB_TMO], 1u); break; } } } } while (0)

struct XcdBarrier {
    unsigned* bar; unsigned x;
    volatile LAS unsigned* st;
};

__device__ __forceinline__ XcdBarrier xcd_barrier_post(unsigned* bar, volatile LAS unsigned* st, bool leader) {
    XcdBarrier b; b.bar = bar; b.x = xb_xcc_id(); b.st = st;
    if (leader) (void)xb_add(&bar[XB_XCNT(b.x)], 1u);
    return b;
}
__device__ __forceinline__ void xcd_barrier_complete(unsigned* bar, unsigned x, unsigned& nloc, unsigned& nx) {
    const unsigned G = gridDim.x * gridDim.y * gridDim.z;
    unsigned sum, cnt, mine, sp = 0u;
    for (;;) {
        sum = 0u; cnt = 0u; mine = 0u;
#pragma unroll
        for (unsigned j = 0; j < 16; ++j) { const unsigned c = xb_ld(&bar[XB_XCNT(j)]); sum += c; cnt += (c > 0u) ? 1u : 0u; mine = (j == x) ? c : mine; }
        if (sum == G) break;
        __builtin_amdgcn_s_sleep(1);
        if ((++sp & 255u) == 0u) { if (xb_ld(&bar[XB_TMO])) break; if (sp > XB_SPIN_CAP) { atomicAdd(&bar[XB_TMO], 1u); break; } }
    }
    nloc = mine > 0u ? mine : 1u; nx = cnt > 0u ? cnt : 1u;
}

__device__ __forceinline__ void xcd_barrier(const XcdBarrier& b, bool leader) {
    asm volatile("s_waitcnt vmcnt(0)" ::: "memory");
    __syncthreads();
    if (leader) {
        unsigned* bar = b.bar;
        __builtin_amdgcn_s_waitcnt(0);
        unsigned nloc = b.st[0], nx = b.st[1];
        if (nloc == 0u) { xcd_barrier_complete(bar, b.x, nloc, nx); b.st[0] = nloc; b.st[1] = nx; }
        const unsigned old = xb_add(&bar[XB_XSUB(b.x)], 1u);
        const unsigned gen = old / nloc;
        if (old + 1u == (gen + 1u) * nloc) {
            __builtin_amdgcn_fence(__ATOMIC_RELEASE, "agent");
            asm volatile("s_waitcnt vmcnt(0)" ::: "memory");
            const unsigned og = xb_add(&bar[XB_TOP], 1u);
            const unsigned tg = og / nx;
            if (og + 1u == (tg + 1u) * nx) xb_add(&bar[XB_TOPGEN], 1u);
            else XB_SPIN(xb_ld(&bar[XB_TOPGEN]) == tg, bar);
            __builtin_amdgcn_fence(__ATOMIC_ACQUIRE, "agent");
            xb_add(&bar[XB_XGEN(b.x)], 1u);
            asm volatile("s_waitcnt vmcnt(0)" ::: "memory");
        } else {
            XB_SPIN(xb_ld(&bar[XB_XGEN(b.x)]) == gen, bar);
            __builtin_amdgcn_fence(__ATOMIC_ACQUIRE, "agent");
            asm volatile("s_waitcnt vmcnt(0)" ::: "memory");
        }
    }
    __syncthreads();
}

#define GRID_SYNC() xcd_barrier(xb, tid_of(widx) == 0)

struct Params { const float* in[16]; float* out; unsigned char* ws; };

typedef __bf16 bf16x2_t __attribute__((ext_vector_type(2)));
__device__ __forceinline__ unsigned pk_bf16(float lo, float hi) { const f32x2 v = {lo, hi}; return __builtin_bit_cast(unsigned, __builtin_convertvector(v, bf16x2_t)); }
__device__ __forceinline__ float bf_lo(unsigned u) { return __uint_as_float(u << 16); }
__device__ __forceinline__ float bf_hi(unsigned u) { return __uint_as_float(u & 0xffff0000u); }
__device__ __forceinline__ float sigmoidf_(float x) { return __builtin_amdgcn_rcpf(1.0f + __builtin_amdgcn_exp2f(-1.44269504089f * x)); }
__device__ __forceinline__ float siluf_(float x) { return x * sigmoidf_(x); }
__device__ __forceinline__ u32x2 pk4(f32x4 v) { u32x2 r; r.x = pk_bf16(v[0], v[1]); r.y = pk_bf16(v[2], v[3]); return r; }
__device__ __forceinline__ f32x4 unpk4(u32x2 v) { return (f32x4){bf_lo(v.x), bf_hi(v.x), bf_lo(v.y), bf_hi(v.y)}; }
template <int CTRL> __device__ __forceinline__ float dppf(float old, float v) { return __int_as_float(__builtin_amdgcn_update_dpp(__float_as_int(old), __float_as_int(v), CTRL, 0xf, 0xf, false)); }
__device__ __forceinline__ float wave_sum(float v) {
#pragma unroll
    for (int o = 1; o < 64; o <<= 1) v += __shfl_xor(v, o);
    return v;
}

__device__ __forceinline__ int lds_byte(int r, int c) { const int st = (r >> 4) * 2 + (c >> 5), rr = r & 15, cc = c & 31, ob = rr * 64 + cc * 2; return st * 1024 + (ob ^ (((ob >> 9) & 1) << 5)); }
__device__ __forceinline__ void stage_rc(int b, int& R, int& C) { const int st = b / 1024, sb = b % 1024, swz = sb ^ (((sb >> 9) & 1) << 5); R = (st >> 1) * 16 + swz / 64; C = (st & 1) * 32 + (swz % 64) / 2; }

__device__ __forceinline__ int tid_of(int widx) { int l; asm volatile("v_mbcnt_lo_u32_b32 %0, -1, 0\n\tv_mbcnt_hi_u32_b32 %0, -1, %0" : "=v"(l)); return widx * 64 + l; }
struct Unit { const char* A; const char* B; int pm, pn, kind; };
__device__ __forceinline__ size_t native_slot(int pm, int pn4, int w4, int ai, int m, int bj, int n, int lane) {
    return ((((size_t)(pm * 4 + pn4) * 8 + w4) * 32 + (((ai * 4 + m) * 2 + bj) * 2 + n)) * 64 + lane);
}

template <int WG = 8> __device__ __forceinline__ void remap_tile(int L, int nM, int nN, int& pm, int& pn) {
    const int nwg = nM * nN; int wgid = L;
    { const int q = nwg / 8, r = nwg % 8, xcd = wgid % 8, off = wgid / 8; wgid = (xcd < r ? xcd * (q + 1) : r * (q + 1) + (xcd - r) * q) + off; }
    const int nig = WG * nN, gid = wgid / nig, fm = gid * WG, gsz = (nM - fm) < WG ? (nM - fm) : WG;
    pm = fm + ((wgid % nig) % gsz); pn = (wgid % nig) / gsz;
}

struct EpiOut;
template <class Epi> __device__ __forceinline__ bool epi_keeps(const Epi&, const Unit&) { return false; }
__device__ __forceinline__ bool epi_keeps(const EpiOut&, const Unit& u) { return u.kind < 2; }
template <class Epi, class Sched>
__device__ __forceinline__ void gemm_phase(LAS unsigned char* lds, const int lda, const int ldb, const int K, const Sched& S, const Epi& E, const int widx) {
    int tid_ = tid_of(widx); asm volatile("" : "+v"(tid_));
    const int tid = tid_, wid = __builtin_amdgcn_readfirstlane(tid >> 6), lane = tid & 63, wr = wid >> 2, wc = wid & 3, fr = lane & 15, fq = lane >> 4;
    const int nt = K / BK;
    unsigned voffA[2], voffB[2];
#pragma unroll
    for (int i = 0; i < 2; ++i) { int R, C; stage_rc(tid * 16 + i * 8192, R, C); voffA[i] = (unsigned)(R * lda + C) * 2u; voffB[i] = (unsigned)(R * ldb + C) * 2u; }
    const size_t kstep = (size_t)(BK * 2);
    const size_t hstepA = (size_t)HALF * lda * 2, hstepB = (size_t)HALF * ldb * 2;
    const unsigned ldsw = (unsigned)wid * 1024u;
    const int aoff = lds_byte(wr * 64 + fr, fq * 8), boff = lds_byte(wc * 32 + fr, fq * 8);
#define GP_SA(b, h) (((b) * 2 + (h)) * HTB)
#define GP_SB(b, h) ((4 + (b) * 2 + (h)) * HTB)
#define GP_STAGE(bufoff, gbase, voff) do { _Pragma("unroll") for (int _i = 0; _i < 2; ++_i) \
        __builtin_amdgcn_global_load_lds((const unsigned*)((const char*)(gbase) + (voff)[_i]), (LAS unsigned*)(lds + (bufoff) + ldsw + _i * 8192), 16, 0, 0); } while (0)
#define GP_LDA(dst, b, h) do { _Pragma("unroll") for (int m = 0; m < 4; ++m) _Pragma("unroll") for (int k = 0; k < 2; ++k) dst[m][k] = *(const LAS bf16x8*)(lds + GP_SA(b, h) + aoff + m * 2048 + k * 1024); } while (0)
#define GP_LDB(dst, b, h) do { _Pragma("unroll") for (int n = 0; n < 2; ++n) _Pragma("unroll") for (int k = 0; k < 2; ++k) dst[n][k] = *(const LAS bf16x8*)(lds + GP_SB(b, h) + boff + n * 2048 + k * 1024); } while (0)
#define GP_MMA(ai, bj, At, Bt) do { __builtin_amdgcn_s_setprio(1); _Pragma("unroll") for (int m = 0; m < 4; ++m) _Pragma("unroll") for (int n = 0; n < 2; ++n) _Pragma("unroll") for (int k = 0; k < 2; ++k) \
        acc[ai][bj][m][n] = __builtin_amdgcn_mfma_f32_16x16x32_bf16(Bt[n][k], At[m][k], acc[ai][bj][m][n], 0, 0, 0); __builtin_amdgcn_s_setprio(0); } while (0)
#define GP_WAIT_V(n) asm volatile("s_waitcnt vmcnt(" #n ")" ::: "memory")
#define GP_WAIT_L(n) asm volatile("s_waitcnt lgkmcnt(" #n ")" ::: "memory")
#define GP_BAR __builtin_amdgcn_s_barrier()
#define GP_SCHED __builtin_amdgcn_sched_barrier(0)
    Unit cur, nxt; int ui = 0;
    if (!S.next(0, cur)) return;
    f32x4 acc[2][2][4][2];
#pragma unroll
    for (int a = 0; a < 2; ++a)
#pragma unroll
        for (int b = 0; b < 2; ++b)
#pragma unroll
            for (int m = 0; m < 4; ++m)
#pragma unroll
                for (int n = 0; n < 2; ++n) acc[a][b][m][n] = (f32x4){0.f, 0.f, 0.f, 0.f};
    bf16x8 At[4][2], B0[2][2], B1[2][2];
    const char* cA = cur.A; const char* cB = cur.B;
    GP_STAGE(GP_SB(0, 0), cB, voffB); GP_STAGE(GP_SB(0, 1), cB + hstepB, voffB); GP_STAGE(GP_SA(0, 0), cA, voffA); GP_STAGE(GP_SA(0, 1), cA + hstepA, voffA);
    if (wr == 1) GP_BAR;
    GP_WAIT_V(2); GP_BAR;
    GP_STAGE(GP_SB(1, 0), cB + kstep, voffB); GP_STAGE(GP_SA(1, 0), cA + kstep, voffA); GP_STAGE(GP_SB(1, 1), cB + hstepB + kstep, voffB);
    GP_WAIT_V(6); GP_BAR;
    for (;;) {
        const bool has_next = S.next(ui + 1, nxt);
        const char* nA = has_next ? nxt.A : cA; const char* nB = has_next ? nxt.B : cB;
        for (int t = 0; t < nt; t += 2) {
            const bool last = (t == nt - 2);
            const char* a1 = cA + (size_t)(t + 1) * kstep;
            const char* a2 = last ? nA : cA + (size_t)(t + 2) * kstep; const char* b2 = last ? nB : cB + (size_t)(t + 2) * kstep;
            const char* a3 = a2 + kstep; const char* b3 = b2 + kstep;
            GP_LDB(B0, 0, 0); GP_LDB(B1, 0, 1); GP_SCHED; GP_LDA(At, 0, 0); GP_STAGE(GP_SA(1, 1), a1 + hstepA, voffA);
            GP_WAIT_V(8); GP_WAIT_L(0); GP_BAR; GP_MMA(0, 0, At, B0); GP_MMA(0, 1, At, B1); GP_BAR; GP_SCHED;
            GP_LDA(At, 0, 1); GP_STAGE(GP_SB(0, 0), b2, voffB); GP_STAGE(GP_SB(0, 1), b2 + hstepB, voffB); GP_STAGE(GP_SA(0, 0), a2, voffA);
            GP_WAIT_V(8); GP_WAIT_L(0); GP_BAR; GP_MMA(1, 0, At, B0); GP_MMA(1, 1, At, B1); GP_BAR; GP_SCHED;
            GP_LDB(B0, 1, 0); GP_LDB(B1, 1, 1); GP_SCHED; GP_LDA(At, 1, 0); GP_STAGE(GP_SA(0, 1), a2 + hstepA, voffA);
            GP_WAIT_V(8); GP_WAIT_L(0); GP_BAR; GP_MMA(0, 0, At, B0); GP_MMA(0, 1, At, B1); GP_BAR; GP_SCHED;
            GP_LDA(At, 1, 1); GP_STAGE(GP_SB(1, 0), b3, voffB); GP_STAGE(GP_SB(1, 1), b3 + hstepB, voffB); GP_STAGE(GP_SA(1, 0), a3, voffA);
            GP_WAIT_V(8); GP_WAIT_L(0); GP_BAR; GP_MMA(1, 0, At, B0); GP_MMA(1, 1, At, B1); GP_BAR; GP_SCHED;
        }
        if (wr == 0) GP_BAR;
        E(acc, cur, wr, wc, fr, fq);
        if (!has_next) break;
        if (!epi_keeps(E, cur)) {
#pragma unroll
        for (int a = 0; a < 2; ++a)
#pragma unroll
            for (int b = 0; b < 2; ++b)
#pragma unroll
                for (int m = 0; m < 4; ++m)
#pragma unroll
                    for (int n = 0; n < 2; ++n) acc[a][b][m][n] = (f32x4){0.f, 0.f, 0.f, 0.f};
        }
        cur = nxt; cA = nA; cB = nB; ++ui;
        if (wr == 1) GP_BAR;
    }
    GP_WAIT_V(0);
    GP_BAR;
#undef GP_SA
#undef GP_SB
#undef GP_STAGE
#undef GP_LDA
#undef GP_LDB
#undef GP_MMA
#undef GP_WAIT_V
#undef GP_WAIT_L
#undef GP_BAR
#undef GP_SCHED
}

struct SchedP1 {
    const char *U, *Win, *Memn, *Wkv; int G, c;
    __device__ __forceinline__ bool next(int i, Unit& u) const {
        if (G == 256) {
            if (i < 24) { const int l = i * 32 + (c >> 3); int pm = l / 6, pn = 6 * (c & 7) + l % 6; pn = (pn % 3) * 16 + pn / 3;
                u.pm = pm; u.pn = pn; u.kind = pn >> 4; u.A = U + (size_t)pm * TILE; u.B = Win + (size_t)pn * TILE; return true; }
            if (i > 24 || c >= 32) return false;
            int L = c;
            if (L < 16) { u.pm = L >> 2; u.pn = L & 3; u.kind = 3; u.A = Memn + (size_t)u.pm * TILE; u.B = Wkv + (size_t)u.pn * TILE; }
            else { L -= 16; u.pm = L >> 2; u.pn = L & 3; u.kind = 4; u.A = Wkv + (size_t)(4 + u.pm) * TILE; u.B = Memn + (size_t)u.pn * TILE; }
            return true;
        }
        int L = i * G + c;
        if (L < 6144) { int pm, pn; remap_tile<4>(L, 128, 48, pm, pn); pn = (pn % 3) * 16 + pn / 3; u.pm = pm; u.pn = pn; u.kind = pn >> 4; u.A = U + (size_t)pm * TILE; u.B = Win + (size_t)pn * TILE; return true; }
        L -= 6144; if (L >= 32) return false;
        if (L < 16) { u.pm = L >> 2; u.pn = L & 3; u.kind = 3; u.A = Memn + (size_t)u.pm * TILE; u.B = Wkv + (size_t)u.pn * TILE; }
        else { L -= 16; u.pm = L >> 2; u.pn = L & 3; u.kind = 4; u.A = Wkv + (size_t)(4 + u.pm) * TILE; u.B = Memn + (size_t)u.pn * TILE; }
        return true;
    }
};
struct SchedAttn {
    const char *Aq, *Bm; size_t bstride_b, bstride_h; int G, c;
    __device__ __forceinline__ bool next(int i, Unit& u) const {
        const int L = i * G + c; if (L >= 512) return false;
        u.pm = L >> 2; u.pn = L & 3; u.kind = 0;
        u.A = Aq + (size_t)u.pm * TILE + (size_t)u.pn * 512; u.B = Bm + (size_t)(u.pm >> 5) * bstride_b + (size_t)u.pn * bstride_h; return true;
    }
};
struct SchedOut {
    const char *H, *HXp, *W; int G, c;
    __device__ __forceinline__ bool next(int i, Unit& u) const {
        const int ti = i / 3, g = i - 3 * ti; const int L = ti * G + c; if (L >= 512) return false;
        int pm, pn; remap_tile(L, 128, 4, pm, pn); u.pm = pm; u.pn = pn; u.kind = g;
        if (g == 2) u.A = HXp + (size_t)pm * TILE; else u.A = H + ((size_t)g * 128 + pm) * TILE;
        u.B = W + ((size_t)g * 4 + pn) * TILE; return true;
    }
};
struct SchedWo {
    const char *A, *W; int G, c;
    __device__ __forceinline__ bool next(int i, Unit& u) const {
        const int L = i * G + c; if (L >= 512) return false;
        int pm, pn; remap_tile(L, 128, 4, pm, pn); u.pm = pm; u.pn = pn; u.kind = 0; u.A = A + (size_t)pm * TILE; u.B = W + (size_t)pn * TILE; return true;
    }
};

__device__ __forceinline__ int pf(int fq) { return (fq >> 1) | ((fq & 1) << 1); }
__device__ __forceinline__ void store_pair16(bf16_t* rowbase  , u32x2 a  , u32x2 b  , int fq) {
    const auto rx = __builtin_amdgcn_permlane32_swap(a.x, b.x, false, false), ry = __builtin_amdgcn_permlane32_swap(a.y, b.y, false, false);
    *(u32x4*)(rowbase + (size_t)((fq >> 1) * 16) * 1024 + (fq & 1) * 8) = (u32x4){rx[0], ry[0], rx[1], ry[1]};
}
struct EpiP1 {
    bf16_t *HA, *GLU, *SZB, *SZX, *Q, *SGA, *SGB, *SGX, *KB, *VT, *PAT, *GAH; const float* convw;
    __device__ __forceinline__ void operator()(const f32x4 (&acc)[2][2][4][2], const Unit& u, int wr, int wc, int fr, int fq) const {
        if (u.kind <= 2) {
            const int chw = (u.pn & 15) * 64 + wc * 16, ch = chw + pf(fq) * 4;
            const int rowb = u.pm * 256 + wr * 64 + fr;
            if (u.kind == 0) {
                const f32x4 w0 = *(const f32x4*)(convw + ch), w1 = *(const f32x4*)(convw + 1024 + ch), w2 = *(const f32x4*)(convw + 2048 + ch);
#pragma unroll
                for (int ai = 0; ai < 2; ++ai) {
                    const int blk = u.pm * 4 + ai * 2 + wr;
                    f32x4 pprev = (f32x4){0.f, 0.f, 0.f, 0.f}; u32x2 hv[4];
#pragma unroll
                    for (int m = 0; m < 4; ++m) {
                        const f32x4 Bv = acc[ai][0][m][0], Cv = acc[ai][0][m][1], Xv = acc[ai][1][m][0], Zv = acc[ai][1][m][1];
                        const f32x4 p = Cv * Xv; f32x4 ga, p1, p2;
#pragma unroll
                        for (int j = 0; j < 4; ++j) {
                            ga[j] = siluf_(Zv[j]) * Bv[j];
                            const float r1 = (m > 0) ? dppf<0x121>(0.f, pprev[j]) : 0.f, r2 = (m > 0) ? dppf<0x122>(0.f, pprev[j]) : 0.f;
                            p1[j] = dppf<0x111>(r1, p[j]); p2[j] = dppf<0x112>(r2, p[j]);
                        }
                        const f32x4 cv = w2 * p + w1 * p1 + w0 * p2;
                        hv[m] = pk4(ga * cv);
                        if (m == 3 && fr >= 14) *(u32x2*)(PAT + (size_t)(blk * 2 + (fr - 14)) * 1024 + ch) = pk4(p);
                        if (m == 0 && fr < 2) *(u32x2*)(GAH + (size_t)(blk * 2 + fr) * 1024 + ch) = pk4(ga);
                        pprev = p;
                    }
#pragma unroll
                    for (int pr = 0; pr < 2; ++pr) store_pair16(HA + (size_t)(rowb + ai * 128 + pr * 32) * 1024 + chw, hv[2 * pr], hv[2 * pr + 1], fq);
                }
            } else if (u.kind == 1) {
#pragma unroll
                for (int ai = 0; ai < 2; ++ai) {
                    u32x2 gv[4], zv[4];
#pragma unroll
                    for (int m = 0; m < 4; ++m) {
                        const f32x4 Vv = acc[ai][0][m][0], Gv = acc[ai][0][m][1], Zb = acc[ai][1][m][0], Zx = acc[ai][1][m][1]; f32x4 o0, o1, o2;
#pragma unroll
                        for (int j = 0; j < 4; ++j) { o0[j] = Vv[j] * sigmoidf_(Gv[j]); o1[j] = siluf_(Zb[j]); o2[j] = siluf_(Zx[j]); }
                        gv[m] = pk4(o0); zv[m] = pk4(o1);
                        { const int c = (u.pn & 3) * 64 + wc * 16;
                          __builtin_nontemporal_store(pk4(o2), (u32x2*)SZX + native_slot(u.pm, (u.pn & 15) >> 2, wr * 4 + ((c >> 5) & 3), ai, m, c >> 7, (c >> 4) & 1, pf(fq) * 16 + fr)); }
                    }
#pragma unroll
                    for (int pr = 0; pr < 2; ++pr) {
                        store_pair16(GLU + (size_t)(rowb + ai * 128 + pr * 32) * 1024 + chw, gv[2 * pr], gv[2 * pr + 1], fq);
                        store_pair16(SZB + (size_t)(rowb + ai * 128 + pr * 32) * 1024 + chw, zv[2 * pr], zv[2 * pr + 1], fq);
                    }
                }
            } else {
#pragma unroll
                for (int ai = 0; ai < 2; ++ai) {
                    u32x2 qv[4];
#pragma unroll
                    for (int m = 0; m < 4; ++m) {
                        const f32x4 Qv = acc[ai][0][m][0], Ga = acc[ai][0][m][1], Gb = acc[ai][1][m][0], Gx = acc[ai][1][m][1]; f32x4 o1, o2, o3;
#pragma unroll
                        for (int j = 0; j < 4; ++j) { const float sa = sigmoidf_(Ga[j]), sb = sigmoidf_(Gb[j]), sx = sigmoidf_(Gx[j]);
                            o1[j] = sa * __builtin_amdgcn_rcpf(fmaxf(sb, 1e-30f)); o2[j] = sb * __builtin_amdgcn_rcpf(fmaxf(sx, 1e-30f)); o3[j] = sx; }
                        qv[m] = pk4(Qv * 0.0625f);
                        const int c = (u.pn & 3) * 64 + wc * 16;
                        const size_t ns = native_slot(u.pm, (u.pn & 15) >> 2, wr * 4 + ((c >> 5) & 3), ai, m, c >> 7, (c >> 4) & 1, pf(fq) * 16 + fr);
                        __builtin_nontemporal_store(pk4(o1), (u32x2*)SGA + ns); __builtin_nontemporal_store(pk4(o2), (u32x2*)SGB + ns); __builtin_nontemporal_store(pk4(o3), (u32x2*)SGX + ns);
                    }
#pragma unroll
                    for (int pr = 0; pr < 2; ++pr) store_pair16(Q + (size_t)(rowb + ai * 128 + pr * 32) * 1024 + chw, qv[2 * pr], qv[2 * pr + 1], fq);
                }
            }
        } else {
            const int r0 = wr * 64 + fr, c0 = wc * 32 + fq * 4;
#pragma unroll
            for (int ai = 0; ai < 2; ++ai)
#pragma unroll
                for (int m = 0; m < 4; ++m)
#pragma unroll
                    for (int bj = 0; bj < 2; ++bj)
#pragma unroll
                        for (int n = 0; n < 2; ++n) {
                            const int r = r0 + ai * 128 + m * 16, c = c0 + bj * 128 + n * 16;
                            if (u.kind == 3) *(u32x2*)(KB + (size_t)(u.pm * 256 + r) * 1024 + u.pn * 256 + c) = pk4(acc[ai][bj][m][n]);
                            else             *(u32x2*)(VT + ((size_t)u.pn * 1024 + u.pm * 256 + r) * 256 + c) = pk4(acc[ai][bj][m][n]);
                        }
        }
    }
};
struct EpiS {
    bf16_t* Q; float* RSUM;
    __device__ __forceinline__ void operator()(const f32x4 (&acc)[2][2][4][2], const Unit& u, int wr, int wc, int fr, int fq) const {
#pragma unroll
        for (int ai = 0; ai < 2; ++ai)
#pragma unroll
            for (int m = 0; m < 4; ++m) {
                const int row = u.pm * 256 + ai * 128 + wr * 64 + m * 16 + fr; float rs = 0.f;
#pragma unroll
                for (int bj = 0; bj < 2; ++bj)
#pragma unroll
                    for (int n = 0; n < 2; ++n) {
                        const f32x4 s = acc[ai][bj][m][n]; f32x4 e;
#pragma unroll
                        for (int j = 0; j < 4; ++j) e[j] = __builtin_amdgcn_exp2f(1.44269504089f * s[j]);
                        const u32x2 w = pk4(e); const f32x4 er = unpk4(w); rs += (er[0] + er[1]) + (er[2] + er[3]);
                        *(u32x2*)(Q + (size_t)row * 1024 + u.pn * 256 + bj * 128 + wc * 32 + n * 16 + fq * 4) = w;
                    }
                rs += __shfl_xor(rs, 16); rs += __shfl_xor(rs, 32);
                if (fq == 0) unsafeAtomicAdd(RSUM + row * 4 + u.pn, rs);
            }
    }
};
struct EpiPV {
    const bf16_t* SZXN; bf16_t* HX; const float* RSUM;
    __device__ __forceinline__ void operator()(const f32x4 (&acc)[2][2][4][2], const Unit& u, int wr, int wc, int fr_in, int fq_in) const {
        int fr = fr_in, fq = fq_in; asm volatile("" : "+v"(fr), "+v"(fq));
        const int w4 = wr * 4 + wc, lane = fq * 16 + fr;
#pragma unroll
        for (int ai = 0; ai < 2; ++ai) {
            u32x2 z[4][2][2]; float rs[4];
#pragma unroll
            for (int m = 0; m < 4; ++m) {
                rs[m] = RSUM[(u.pm * 256 + ai * 128 + wr * 64 + m * 16 + fr) * 4 + u.pn];
#pragma unroll
                for (int bj = 0; bj < 2; ++bj)
#pragma unroll
                    for (int n = 0; n < 2; ++n) z[m][bj][n] = __builtin_nontemporal_load((const u32x2*)SZXN + native_slot(u.pm, u.pn, w4, ai, m, bj, n, lane));
            }
#pragma unroll
            for (int m = 0; m < 4; ++m) {
                const int row = u.pm * 256 + ai * 128 + wr * 64 + m * 16 + fr; const float inv = __builtin_amdgcn_rcpf(rs[m]);
#pragma unroll
                for (int bj = 0; bj < 2; ++bj)
#pragma unroll
                    for (int n = 0; n < 2; ++n)
                        *(u32x2*)(HX + (size_t)row * 1024 + u.pn * 256 + bj * 128 + wc * 32 + n * 16 + fq * 4) = pk4(unpk4(z[m][bj][n]) * (acc[ai][bj][m][n] * inv));
            }
        }
    }
};
__device__ __forceinline__ void ld8(u32x2 (&d)[8], const u32x2* p) {
    asm volatile("global_load_dwordx2 %0, %1, off"             : "=v"(d[0]) : "v"(p) : "memory");
    asm volatile("global_load_dwordx2 %0, %1, off offset:512"  : "=v"(d[1]) : "v"(p) : "memory");
    asm volatile("global_load_dwordx2 %0, %1, off offset:1024" : "=v"(d[2]) : "v"(p) : "memory");
    asm volatile("global_load_dwordx2 %0, %1, off offset:1536" : "=v"(d[3]) : "v"(p) : "memory");
    asm volatile("global_load_dwordx2 %0, %1, off offset:2048" : "=v"(d[4]) : "v"(p) : "memory");
    asm volatile("global_load_dwordx2 %0, %1, off offset:2560" : "=v"(d[5]) : "v"(p) : "memory");
    asm volatile("global_load_dwordx2 %0, %1, off offset:3072" : "=v"(d[6]) : "v"(p) : "memory");
    asm volatile("global_load_dwordx2 %0, %1, off offset:3584" : "=v"(d[7]) : "v"(p) : "memory");
}
__device__ __forceinline__ void ld4(u32x2 (&d)[4], const u32x2* p) {
    asm volatile("global_load_dwordx2 %0, %1, off nt"          : "=v"(d[0]) : "v"(p) : "memory");
    asm volatile("global_load_dwordx2 %0, %1, off offset:512 nt" : "=v"(d[1]) : "v"(p) : "memory");
    asm volatile("global_load_dwordx2 %0, %1, off offset:1024 nt" : "=v"(d[2]) : "v"(p) : "memory");
    asm volatile("global_load_dwordx2 %0, %1, off offset:1536 nt" : "=v"(d[3]) : "v"(p) : "memory");
}
__device__ __forceinline__ void tie4(u32x2 (&d)[4]) { asm volatile("" : "+v"(d[0]), "+v"(d[1]), "+v"(d[2]), "+v"(d[3])); }
__device__ __forceinline__ void tie8(u32x2 (&d)[8]) { asm volatile("" : "+v"(d[0]), "+v"(d[1]), "+v"(d[2]), "+v"(d[3]), "+v"(d[4]), "+v"(d[5]), "+v"(d[6]), "+v"(d[7])); }

struct EpiOut {
    const bf16_t *F1, *F2, *F3; bf16_t* MERGED;
    template <int POS> __device__ __forceinline__ void run(f32x4 (&acc)[2][2][4][2], const Unit& u, const bf16_t* F, int wr, int wc, int fr, int fq) const {
        const int w4 = wr * 4 + wc, lane = fq * 16 + fr;
        const u32x2* s0 = (const u32x2*)F + native_slot(u.pm, u.pn, w4, 0, 0, 0, 0, lane);
        u32x2 ga[2][4];
        ld4(ga[0], s0); ld4(ga[1], s0 + 256);
#pragma unroll
        for (int e = 0; e < 8; ++e) {
            if (POS < 2) { if (e < 7) asm volatile("s_waitcnt vmcnt(4)" ::: "memory"); else asm volatile("s_waitcnt vmcnt(0)" ::: "memory"); }
            else { if (e == 0) asm volatile("s_waitcnt vmcnt(4)" ::: "memory"); else if (e < 7) asm volatile("s_waitcnt vmcnt(8)" ::: "memory"); else asm volatile("s_waitcnt vmcnt(4)" ::: "memory"); }
            tie4(ga[e & 1]);
            const int ai = e >> 2, m = e & 3;
#pragma unroll
            for (int k = 0; k < 4; ++k) { const int bj = k >> 1, n = k & 1;
                const f32x4 f = unpk4(ga[e & 1][k]);
                if (POS < 2) acc[ai][bj][m][n] *= f;
                else *(u32x2*)(MERGED + (size_t)(u.pm * 256 + ai * 128 + wr * 64 + m * 16 + fr) * 1024 + u.pn * 256 + bj * 128 + wc * 32 + n * 16 + fq * 4) = pk4(f * acc[ai][bj][m][n]);
            }
            if (e + 2 < 8) ld4(ga[e & 1], s0 + (e + 2) * 256);
        }
    }
    __device__ __forceinline__ void operator()(f32x4 (&acc)[2][2][4][2], const Unit& u, int wr, int wc, int fr, int fq) const {
        if (u.kind < 2) run<0>(acc, u, F1 + ((size_t)u.kind << 25)  , wr, wc, fr, fq);
        else run<2>(acc, u, F3, wr, wc, fr, fq);
    }
};
struct EpiWo {
    const float* X; bf16_t* HN; float* ROWSS;
    __device__ __forceinline__ void operator()(const f32x4 (&acc)[2][2][4][2], const Unit& u, int wr, int wc, int fr, int fq) const {
        const int w4 = wr * 4 + wc, lane = fq * 16 + fr;
#pragma unroll
        for (int ai = 0; ai < 2; ++ai) {
            f32x4 xv[4][2][2];
#pragma unroll
            for (int m = 0; m < 4; ++m)
#pragma unroll
                for (int bj = 0; bj < 2; ++bj)
#pragma unroll
                    for (int n = 0; n < 2; ++n)
                        xv[m][bj][n] = __builtin_nontemporal_load((const f32x4*)(X + (size_t)(u.pm * 256 + ai * 128 + wr * 64 + m * 16 + fr) * 1024 + u.pn * 256 + bj * 128 + wc * 32 + n * 16 + fq * 4));
#pragma unroll
            for (int m = 0; m < 4; ++m) {
                const int row = u.pm * 256 + ai * 128 + wr * 64 + m * 16 + fr; float ss = 0.f;
#pragma unroll
                for (int bj = 0; bj < 2; ++bj)
#pragma unroll
                    for (int n = 0; n < 2; ++n) {
                        const u32x2 hw = pk4(xv[m][bj][n] + acc[ai][bj][m][n]); const f32x4 h = unpk4(hw);
                        ((u32x2*)HN)[native_slot(u.pm, u.pn, w4, ai, m, bj, n, lane)] = hw; ss += (h[0] * h[0] + h[1] * h[1]) + (h[2] * h[2] + h[3] * h[3]);
                    }
                ss += __shfl_xor(ss, 16); ss += __shfl_xor(ss, 32);
                if (fq == 0) unsafeAtomicAdd(ROWSS + row, ss);
            }
        }
    }
};

__device__ __forceinline__ int win_src_col(int R) {
    const int unit = R >> 8, rho = R & 255, kind = unit >> 4, cu = unit & 15;
    const int fqb = (rho >> 2) & 3;
    const int gi = ((rho >> 7) & 1) * 2 + ((rho >> 4) & 1), chl = ((rho >> 5) & 3) * 16 + (((fqb >> 1) | ((fqb & 1) << 1)) << 2) + (rho & 3);
    int base;
    if (kind == 0) base = gi * 1024;
    else if (kind == 1) base = (gi < 3) ? 4096 + gi * 1024 : 8192;
    else base = (gi == 0) ? 7168 : 9216 + (gi - 1) * 1024;
    return base + cu * 64 + chl;
}
__device__ __forceinline__ void p0_transpose_item(const float* W, int ldw, bf16_t* WT, int dst_row0, int k0, bool perm, LAS float* scr, int lane) {
    const int li = lane & 31; const int drow = dst_row0 + (perm ? ((li & 15) + ((li >> 4) << 5)) : li); const int scol = perm ? win_src_col(drow) : drow;
#pragma unroll
    for (int i = 0; i < 32; ++i) { const int kk = 2 * i + (lane >> 5); scr[kk * 33 + (lane & 31)] = __builtin_nontemporal_load(W + (size_t)(k0 + kk) * ldw + scol); }
    asm volatile("s_waitcnt lgkmcnt(0)" ::: "memory");
    const int c = lane & 7;
#pragma unroll
    for (int j = 0; j < 4; ++j) { const int n = (lane >> 3) + 8 * j; const LAS float* s = scr + (8 * c) * 33 + n;
        u32x4 o; o.x = pk_bf16(s[0 * 33], s[1 * 33]); o.y = pk_bf16(s[2 * 33], s[3 * 33]); o.z = pk_bf16(s[4 * 33], s[5 * 33]); o.w = pk_bf16(s[6 * 33], s[7 * 33]);
        const int orow = dst_row0 + (perm ? ((n & 15) + ((n >> 4) << 5)) : n);
        *(u32x4*)(WT + (size_t)orow * 1024 + k0 + 8 * c) = o; }
    asm volatile("s_waitcnt lgkmcnt(0)" ::: "memory");
}
__device__ __forceinline__ void rms_row_to_bf16(const float* xrow, const float* g, bf16_t* orow, int lane) {
    const f32x4* xr = (const f32x4*)xrow + lane; const f32x4* gr = (const f32x4*)g + lane;
    f32x4 v[4]; float s = 0.f;
#pragma unroll
    for (int j = 0; j < 4; ++j) { v[j] = xr[64 * j]; s += (v[j][0] * v[j][0] + v[j][1] * v[j][1]) + (v[j][2] * v[j][2] + v[j][3] * v[j][3]); }
    const float rstd = 1.0f / sqrtf(wave_sum(s) * (1.f / 1024.f) + EPS);
    u32x2* o8 = (u32x2*)orow + lane;
#pragma unroll
    for (int j = 0; j < 4; ++j) { const f32x4 gg = gr[64 * j]; o8[64 * j] = pk4(v[j] * rstd * gg); }
}

template <int PH>
__device__ __forceinline__ void conv31_chunk(LAS unsigned char* lds, LAS float* red, LAS float* stats, const bf16_t* GLU, bf16_t* SZB, const float* cw, const float* cb, const float* lng, const float* lnb,
                                            const int t0, const bool has_next, const int tid_in) {
    int tid_o = tid_in; asm volatile("" : "+v"(tid_o));
    const int tid = tid_o, lane = tid & 63, wid = tid >> 6, c2 = tid * 2;
    u32x4 nx[4];
    if (has_next) {
        int tf = tid; asm volatile("" : "+v"(tf));
#pragma unroll
        for (int q = 0; q < 4; ++q) { const int i = tf + q * 512; nx[q] = *(const u32x4*)(GLU + (size_t)(t0 + 16 + (i >> 7)) * 1024 + (i & 127) * 8); }
    }
    const f32x2 bias = *(const f32x2*)(cb + c2);
    f32x2 outv[16];
#pragma unroll
    for (int t = 0; t < 16; ++t) outv[t] = bias;
#pragma unroll
    for (int ps = 0; ps < 2; ++ps) {
        const int kb = ps * 16, ntap = ps == 0 ? 16 : 15;
        f32x2 w[16];
#pragma unroll
        for (int k = 0; k < 16; ++k) if (k < ntap) w[k] = *(const f32x2*)(cw + (kb + k) * 1024 + c2);
#pragma unroll
        for (int r = 0; r < 31; ++r) if (r < ntap + 15) {
            const unsigned v = *(const LAS unsigned*)(lds + ((34 + 16 * PH + kb + r) & 63) * 2048 + tid * 4);
            const f32x2 x = (f32x2){bf_lo(v), bf_hi(v)};
#pragma unroll
            for (int t = 0; t < 16; ++t) { const int k = r - t; if (k >= 0 && k < ntap) outv[t] = __builtin_elementwise_fma(w[k], x, outv[t]); }
            if ((r & 7) == 7) asm volatile("" ::: "memory");
        }
    }
    {
        float s[16], q[16];
#pragma unroll
        for (int t = 0; t < 16; ++t) { s[t] = outv[t][0] + outv[t][1]; q[t] = outv[t][0] * outv[t][0] + outv[t][1] * outv[t][1]; }
#pragma unroll
        for (int lvl = 0; lvl < 4; ++lvl) {
            const int half = 8 >> lvl, off = 32 >> lvl; const bool hi = (lane & off) != 0;
#pragma unroll
            for (int i = 0; i < half; ++i) {
                const float ks = hi ? s[i + half] : s[i], ss = hi ? s[i] : s[i + half]; s[i] = ks + __shfl_xor(ss, off);
                const float kq = hi ? q[i + half] : q[i], sq = hi ? q[i] : q[i + half]; q[i] = kq + __shfl_xor(sq, off);
            }
        }
        s[0] += __shfl_xor(s[0], 2); q[0] += __shfl_xor(q[0], 2);
        s[0] += __shfl_xor(s[0], 1); q[0] += __shfl_xor(q[0], 1);
        if ((lane & 3) == 0) *(LAS f32x2*)(red + ((lane >> 2) * 8 + wid) * 2) = (f32x2){s[0], q[0]};
    }
    __syncthreads();
    if (has_next) {
#pragma unroll
        for (int q = 0; q < 4; ++q) { const int i = tid + q * 512; *(LAS u32x4*)(lds + ((34 + 16 * PH + 46 + (i >> 7)) & 63) * 2048 + (i & 127) * 16) = nx[q]; }
    }
    if (tid < 16) {
        float S = 0.f, Q2 = 0.f;
#pragma unroll
        for (int wv = 0; wv < 8; ++wv) { const f32x2 t = *(const LAS f32x2*)(red + (tid * 8 + wv) * 2); S += t[0]; Q2 += t[1]; }
        const float mean = S * (1.f / 1024.f), var = fmaxf(Q2 * (1.f / 1024.f) - mean * mean, 0.f);
        *(LAS f32x2*)(stats + tid * 2) = (f32x2){mean, 1.0f / sqrtf(var + EPS)};
    }
    __syncthreads();
    const f32x2 lg = *(const f32x2*)(lng + c2), lb = *(const f32x2*)(lnb + c2);
    unsigned zz[16];
#pragma unroll
    for (int t = 0; t < 16; ++t) zz[t] = __builtin_nontemporal_load((const unsigned*)(SZB + (size_t)(t0 + t) * 1024 + c2));
#pragma unroll
    for (int t = 0; t < 16; ++t) {
        const f32x2 st = *(const LAS f32x2*)(stats + t * 2);
        const float y0 = (outv[t][0] - st[0]) * st[1] * lg[0] + lb[0], y1 = (outv[t][1] - st[0]) * st[1] * lg[1] + lb[1];
        *(unsigned*)(SZB + (size_t)(t0 + t) * 1024 + c2) = pk_bf16(bf_lo(zz[t]) * siluf_(y0), bf_hi(zz[t]) * siluf_(y1));
    }
}
__device__ __forceinline__ void conv31_phase(LAS unsigned char* lds, const bf16_t* GLU, bf16_t* SZB, const float* cw, const float* cb, const float* lng, const float* lnb, int G, int c, const int widx) {
    int tid_ = tid_of(widx); asm volatile("" : "+v"(tid_));
    const int tid = tid_;
    LAS float* red = (LAS float*)(lds + 131072 + 1024);
    LAS float* stats = (LAS float*)(lds + 131072 + 3072);
    for (int run = c; run < NTOK / 128; run += G) {
        const int T0 = run * 128, tpos = T0 & (SEQ - 1);
        __syncthreads();
#pragma unroll
        for (int h = 0; h < 2; ++h) {
            int tf = tid; asm volatile("" : "+v"(tf));
            u32x4 tv[6];
#pragma unroll
            for (int q = 0; q < 6; ++q) { const int i = tf + (h * 6 + q) * 512, r = (i >> 7) < 46 ? (i >> 7) : 45; const int gr = (tpos - 30 + r >= 0) ? (T0 - 30 + r) : T0;
                tv[q] = *(const u32x4*)(GLU + (size_t)gr * 1024 + (i & 127) * 8); }
#pragma unroll
            for (int q = 0; q < 6; ++q) { const int i = tf + (h * 6 + q) * 512, r = i >> 7;
                if (r < 46) *(LAS u32x4*)(lds + ((34 + r) & 63) * 2048 + (i & 127) * 16) = (tpos - 30 + r >= 0) ? tv[q] : (u32x4){0u, 0u, 0u, 0u}; }
        }
        __syncthreads();
        conv31_chunk<0>(lds, red, stats, GLU, SZB, cw, cb, lng, lnb, T0, true, tid);
        conv31_chunk<1>(lds, red, stats, GLU, SZB, cw, cb, lng, lnb, T0 + 16, true, tid);
        conv31_chunk<2>(lds, red, stats, GLU, SZB, cw, cb, lng, lnb, T0 + 32, true, tid);
        conv31_chunk<3>(lds, red, stats, GLU, SZB, cw, cb, lng, lnb, T0 + 48, true, tid);
        conv31_chunk<0>(lds, red, stats, GLU, SZB, cw, cb, lng, lnb, T0 + 64, true, tid);
        conv31_chunk<1>(lds, red, stats, GLU, SZB, cw, cb, lng, lnb, T0 + 80, true, tid);
        conv31_chunk<2>(lds, red, stats, GLU, SZB, cw, cb, lng, lnb, T0 + 96, true, tid);
        conv31_chunk<3>(lds, red, stats, GLU, SZB, cw, cb, lng, lnb, T0 + 112, false, tid);
    }
    __syncthreads();
}

__global__ void __launch_bounds__(512, 2) fwd_megakernel(Params p) {
    extern __shared__ __attribute__((aligned(16))) unsigned char lds_raw[];
    LAS unsigned char* lds = (LAS unsigned char*)lds_raw;
    const int G = gridDim.x, bx = blockIdx.x;
    unsigned char* ws = p.ws; unsigned char* ob = (unsigned char*)p.out;
    const float *x = p.in[0], *mem = p.in[1], *norm_g = p.in[2], *w_in = p.in[3], *conv_a_w = p.in[4], *w_out_a = p.in[5], *conv_b_w = p.in[6], *conv_b_b = p.in[7],
                *ln_b_g = p.in[8], *ln_b_b = p.in[9], *w_out_b = p.in[10], *mem_norm_g = p.in[11], *w_kv = p.in[12], *w_out_x = p.in[13], *w_o = p.in[14], *final_g = p.in[15];
    bf16_t *WIN = (bf16_t*)(ws + WS_WIN), *WOUT = (bf16_t*)(ws + WS_WOUT), *WO = (bf16_t*)(ws + WS_WO), *WKV = (bf16_t*)(ws + WS_WKV), *MEMN = (bf16_t*)(ws + WS_MEMN),
           *KB = (bf16_t*)(ws + WS_KB), *VT = (bf16_t*)(ws + WS_VT), *PAT = (bf16_t*)(ws + WS_PAT), *GAH = (bf16_t*)(ws + WS_GAH), *HA = (bf16_t*)(ws + WS_HA), *SZB = (bf16_t*)(ws + WS_SZB),
           *SZX = (bf16_t*)(ws + WS_SZX), *GLU = (bf16_t*)(ws + WS_GLU), *Q = (bf16_t*)(ws + WS_Q), *SGA = (bf16_t*)(ws + WS_SGA), *SGB = (bf16_t*)(ws + WS_SGB),
           *U = (bf16_t*)(ob + OUT_U), *SGX = (bf16_t*)(ob + OUT_SGX);
    float *ROWSS = (float*)(ws + WS_ROWSS), *RSUM = (float*)(ws + WS_RSUM);
    bf16_t* MERGED = GLU;
    volatile LAS unsigned* xst = (volatile LAS unsigned*)(lds + 131072 + 512);
    const int widx = __builtin_amdgcn_readfirstlane((int)threadIdx.x >> 6);
    if (threadIdx.x < 4) xst[threadIdx.x] = 0u;
    __syncthreads();
    XcdBarrier xb = xcd_barrier_post((unsigned*)(ws + WS_BAR), xst, threadIdx.x == 0);

    {
        int tid_ = tid_of(widx); asm volatile("" : "+v"(tid_)); const int tid = tid_, lane = tid & 63, wave = tid >> 6;
        LAS float* scr = (LAS float*)(lds + wave * 16384);
        const int gw = bx * 8 + wave, NGW = G * 8;
        for (int it = gw; it < 9216; it += NGW) {
            int r = it;
            if (r < 6144) { const int g = r % 384; p0_transpose_item(w_in, 12288, WIN, (g >> 1) * 64 + (g & 1) * 16, (r / 384) * 64, true, scr, lane); continue; } r -= 6144;
            if (r < 512) { p0_transpose_item(w_out_a, 1024, WOUT, (r & 31) * 32, (r >> 5) * 64, false, scr, lane); continue; } r -= 512;
            if (r < 512) { p0_transpose_item(w_out_b, 1024, WOUT + (size_t)1024 * 1024, (r & 31) * 32, (r >> 5) * 64, false, scr, lane); continue; } r -= 512;
            if (r < 512) { p0_transpose_item(w_out_x, 1024, WOUT + (size_t)2048 * 1024, (r & 31) * 32, (r >> 5) * 64, false, scr, lane); continue; } r -= 512;
            if (r < 512) { p0_transpose_item(w_o, 1024, WO, (r & 31) * 32, (r >> 5) * 64, false, scr, lane); continue; } r -= 512;
            p0_transpose_item(w_kv, 2048, WKV, (r & 63) * 32, (r >> 6) * 64, false, scr, lane);
        }
        {
            const f32x4* gr = (const f32x4*)norm_g + lane; f32x4 gg[4];
#pragma unroll
            for (int j = 0; j < 4; ++j) gg[j] = gr[64 * j];
            for (int m = gw; m < NTOK; m += 4 * NGW) {
                f32x4 v[4][4];
#pragma unroll
                for (int r = 0; r < 4; ++r) { const f32x4* xr = (const f32x4*)(x + (size_t)(m + r * NGW) * 1024) + lane;
#pragma unroll
                    for (int j = 0; j < 4; ++j) v[r][j] = __builtin_nontemporal_load(xr + 64 * j); }
#pragma unroll
                for (int r = 0; r < 4; ++r) {
                    float sq = 0.f;
#pragma unroll
                    for (int j = 0; j < 4; ++j) sq += (v[r][j][0] * v[r][j][0] + v[r][j][1] * v[r][j][1]) + (v[r][j][2] * v[r][j][2] + v[r][j][3] * v[r][j][3]);
                    const float rstd = 1.0f / sqrtf(wave_sum(sq) * (1.f / 1024.f) + EPS);
                    u32x2* o8 = (u32x2*)(U + (size_t)(m + r * NGW) * 1024) + lane;
#pragma unroll
                    for (int j = 0; j < 4; ++j) o8[64 * j] = pk4(v[r][j] * rstd * gg[j]);
                }
            }
        }
        for (int m = gw; m < 1024; m += NGW) rms_row_to_bf16(mem + (size_t)m * 1024, mem_norm_g, MEMN + (size_t)m * 1024, lane);
        for (int i = bx * 512 + tid; i < NTOK * 5; i += G * 512) ROWSS[i] = 0.f;
    }
    GRID_SYNC();

    {
        SchedP1 S{(const char*)U, (const char*)WIN, (const char*)MEMN, (const char*)WKV, G, bx};
        EpiP1 E{HA, GLU, SZB, SZX, Q, SGA, SGB, SGX, KB, VT, PAT, GAH, conv_a_w};
        gemm_phase(lds, 1024, 1024, 1024, S, E, widx);
    }
    GRID_SYNC();

    {
        int tid_ = tid_of(widx); asm volatile("" : "+v"(tid_)); const int tid = tid_;
        for (int i = bx * 512 + tid; i < 512 * 256; i += G * 512) {
            const int blk = i >> 8, ch = (i & 255) * 4;
            if ((blk & 127) != 0) {
                const f32x4 w0 = *(const f32x4*)(conv_a_w + ch), w1 = *(const f32x4*)(conv_a_w + 1024 + ch);
                const f32x4 pt0 = unpk4(*(const u32x2*)(PAT + (size_t)((blk - 1) * 2 + 0) * 1024 + ch)), pt1 = unpk4(*(const u32x2*)(PAT + (size_t)((blk - 1) * 2 + 1) * 1024 + ch));
                const f32x4 g0 = unpk4(*(const u32x2*)(GAH + (size_t)(blk * 2 + 0) * 1024 + ch)), g1 = unpk4(*(const u32x2*)(GAH + (size_t)(blk * 2 + 1) * 1024 + ch));
                u32x2* h0 = (u32x2*)(HA + (size_t)(blk * 64) * 1024 + ch); u32x2* h1 = (u32x2*)(HA + (size_t)(blk * 64 + 1) * 1024 + ch);
                *h0 = pk4(unpk4(*h0) + g0 * (w1 * pt1 + w0 * pt0));
                *h1 = pk4(unpk4(*h1) + g1 * (w0 * pt1));
            }
        }
        { SchedAttn S{(const char*)Q, (const char*)KB, TILE, (size_t)512, G, bx}; EpiS E{Q, RSUM}; gemm_phase(lds, 1024, 1024, 256, S, E, widx); }
        conv31_phase(lds, GLU, SZB, conv_b_w, conv_b_b, ln_b_g, ln_b_b, G, bx, widx);
    }
    asm volatile("s_waitcnt vmcnt(0) lgkmcnt(0)" ::: "memory"); __syncthreads();
    __builtin_amdgcn_fence(__ATOMIC_ACQUIRE, "agent"); asm volatile("s_waitcnt vmcnt(0)" ::: "memory"); __syncthreads();

    { SchedAttn S{(const char*)Q, (const char*)VT, (size_t)1024 * 256 * 2, (size_t)256 * 256 * 2, G, bx}; EpiPV E{SZX, U  , RSUM}; gemm_phase(lds, 1024, 256, 256, S, E, widx); }
    GRID_SYNC();

    { SchedOut S{(const char*)HA, (const char*)U, (const char*)WOUT, G, bx}; EpiOut E{SGA, SGB, SGX, MERGED}; gemm_phase(lds, 1024, 1024, 1024, S, E, widx); }
    GRID_SYNC();

    { SchedWo S{(const char*)MERGED, (const char*)WO, G, bx}; EpiWo E{x, HA  , ROWSS}; gemm_phase(lds, 1024, 1024, 1024, S, E, widx); }
    GRID_SYNC();

    {
        int tid_ = tid_of(widx); asm volatile("" : "+v"(tid_)); const int lane = tid_ & 63, w4 = tid_ >> 6, wr = w4 >> 2, wc = w4 & 3, fr = lane & 15, fq = lane >> 4;
        for (int L = bx; L < 512; L += G) {
            int pm, pn; remap_tile(L, 128, 4, pm, pn);
#pragma unroll
            for (int ai = 0; ai < 2; ++ai) {
                u32x2 hv[4][2][2]; float rs[4]; f32x4 gg[2][2];
#pragma unroll
                for (int m = 0; m < 4; ++m) {
                    rs[m] = ROWSS[pm * 256 + ai * 128 + wr * 64 + m * 16 + fr];
#pragma unroll
                    for (int bj = 0; bj < 2; ++bj)
#pragma unroll
                        for (int n = 0; n < 2; ++n) hv[m][bj][n] = ((const u32x2*)HA)[native_slot(pm, pn, w4, ai, m, bj, n, fq * 16 + fr)];
                }
#pragma unroll
                for (int bj = 0; bj < 2; ++bj)
#pragma unroll
                    for (int n = 0; n < 2; ++n) gg[bj][n] = *(const f32x4*)(final_g + pn * 256 + bj * 128 + wc * 32 + n * 16 + fq * 4);
#pragma unroll
                for (int m = 0; m < 4; ++m) {
                    const float rstd = 1.0f / sqrtf(rs[m] * (1.f / 1024.f) + EPS);
#pragma unroll
                    for (int bj = 0; bj < 2; ++bj)
#pragma unroll
                        for (int n = 0; n < 2; ++n)
                            *(f32x4*)(p.out + (size_t)(pm * 256 + ai * 128 + wr * 64 + m * 16 + fr) * 1024 + pn * 256 + bj * 128 + wc * 32 + n * 16 + fq * 4) = unpk4(hv[m][bj][n]) * rstd * gg[bj][n];
                }
            }
        }
    }
}

extern "C" void kernel_launch(void* const* d_in, const int* in_sizes, int n_in, void* d_out, int out_size, void* d_ws, size_t ws_size, hipStream_t stream) {
    static int grid_blocks = 0;
    if (!grid_blocks) {
        int dev = 0, cus = 0, per_cu = 0;
        hipGetDevice(&dev);
        hipDeviceGetAttribute(&cus, hipDeviceAttributeMultiprocessorCount, dev);
        hipFuncSetAttribute((const void*)fwd_megakernel, hipFuncAttributeMaxDynamicSharedMemorySize, LDS_BYTES);
        hipOccupancyMaxActiveBlocksPerMultiprocessor(&per_cu, (const void*)fwd_megakernel, 512, LDS_BYTES);
        if (per_cu < 1) { fprintf(stderr, "kernel_launch: occupancy query reports %d blocks per CU\n", per_cu); per_cu = 1; }
        if (per_cu > 1) per_cu = 1;
        grid_blocks = cus * per_cu;
        if (ws_size < WS_END) fprintf(stderr, "kernel_launch: workspace too small: %zu < %zu\n", ws_size, (size_t)WS_END);
    }
    (void)hipMemsetAsync((char*)d_ws + WS_BAR, 0, XCD_BAR_WORDS * 4, stream);
    if (ws_size < WS_END) return;
    Params p{};
    for (int i = 0; i < 16; ++i) p.in[i] = (const float*)d_in[i];
    p.out = (float*)d_out; p.ws = (unsigned char*)d_ws;
    void* args[] = {&p};
    hipError_t e = hipLaunchCooperativeKernel((const void*)fwd_megakernel, dim3(grid_blocks), dim3(512), args, LDS_BYTES, stream);
    if (e != hipSuccess) fprintf(stderr, "cooperative launch failed: %s (grid %d)\n", hipGetErrorString(e), grid_blocks);
}
```

```cpp
#include <hip/hip_runtime.h>
#include <cstdio>

#define LAS __attribute__((address_space(3)))
typedef unsigned short bf16_t;
typedef short bf16x8 __attribute__((ext_vector_type(8)));
typedef float f32x4 __attribute__((ext_vector_type(4)));
typedef float f32x2 __attribute__((ext_vector_type(2)));
typedef unsigned u32x4 __attribute__((ext_vector_type(4)));
typedef unsigned u32x2 __attribute__((ext_vector_type(2)));

constexpr int BM = 256, BK = 64, HALF = 128, HTB = HALF * BK * 2, STAGE_BYTES = 8 * HTB;
constexpr int LDS_BYTES = 147456;
constexpr int NTOK = 32768, DM = 1024, SEQ = 8192;
constexpr float EPS = 1e-6f;
constexpr size_t MiB = 1u << 20;
constexpr size_t TILE = (size_t)256 * 1024 * 2;
constexpr size_t WS_WIN = 0, WS_WOUT = 24 * MiB, WS_WO = 30 * MiB, WS_WKV = 32 * MiB, WS_MEMN = 36 * MiB, WS_KB = 38 * MiB, WS_VT = 40 * MiB;
constexpr size_t WS_ROWSS = 42 * MiB, WS_RSUM = 42 * MiB + 131072, WS_PAT = 43 * MiB, WS_GAH = 45 * MiB;
constexpr size_t WS_BAR = 47 * MiB;
constexpr size_t WS_HA = 48 * MiB, WS_SZB = 112 * MiB, WS_SZX = 176 * MiB, WS_GLU = 240 * MiB, WS_Q = 304 * MiB, WS_SGA = 368 * MiB, WS_SGB = 432 * MiB, WS_END = 496 * MiB;
constexpr size_t OUT_U = 0, OUT_SGX = 64 * MiB;

#define XB_TMO      128
#define XB_XCNT(j)  (256  + 64 * (j))
#define XB_XSUB(j)  (1280 + 64 * (j))
#define XB_XGEN(j)  (2304 + 64 * (j))
#define XB_TOP      3328
#define XB_TOPGEN   3392
#define XCD_BAR_WORDS 3456
#define XB_SPIN_CAP (1u << 18)

__device__ __forceinline__ unsigned xb_ld(unsigned* p)              { return __hip_atomic_load(p, __ATOMIC_RELAXED, __HIP_MEMORY_SCOPE_AGENT); }
__device__ __forceinline__ unsigned xb_add(unsigned* p, unsigned v) { return __hip_atomic_fetch_add(p, v, __ATOMIC_RELAXED, __HIP_MEMORY_SCOPE_AGENT); }
__device__ __forceinline__ unsigned xb_xcc_id() { return (unsigned)__builtin_amdgcn_s_getreg((3 << 11) | 20) & 0xFu; }
#define XB_SPIN(cond, bar) do { unsigned _sp = 0; while (cond) { __builtin_amdgcn_s_sleep(1); \
    if ((++_sp & 255u) == 0u) { if (xb_ld(&(bar)[XB_TMO])) break; if (_sp > XB_SPIN_CAP) { atomicAdd(&(bar)[XB_TMO], 1u); break; } } } } while (0)

struct XcdBarrier {
    unsigned* bar; unsigned x;
    volatile LAS unsigned* st;
};

__device__ __forceinline__ XcdBarrier xcd_barrier_post(unsigned* bar, volatile LAS unsigned* st, bool leader) {
    XcdBarrier b; b.bar = bar; b.x = xb_xcc_id(); b.st = st;
    if (leader) (void)xb_add(&bar[XB_XCNT(b.x)], 1u);
    return b;
}
__device__ __forceinline__ void xcd_barrier_complete(unsigned* bar, unsigned x, unsigned& nloc, unsigned& nx) {
    const unsigned G = gridDim.x * gridDim.y * gridDim.z;
    unsigned sum, cnt, mine, sp = 0u;
    for (;;) {
        sum = 0u; cnt = 0u; mine = 0u;
#pragma unroll
        for (unsigned j = 0; j < 16; ++j) { const unsigned c = xb_ld(&bar[XB_XCNT(j)]); sum += c; cnt += (c > 0u) ? 1u : 0u; mine = (j == x) ? c : mine; }
        if (sum == G) break;
        __builtin_amdgcn_s_sleep(1);
        if ((++sp & 255u) == 0u) { if (xb_ld(&bar[XB_TMO])) break; if (sp > XB_SPIN_CAP) { atomicAdd(&bar[XB_TMO], 1u); break; } }
    }
    nloc = mine > 0u ? mine : 1u; nx = cnt > 0u ? cnt : 1u;
}

__device__ __forceinline__ void xcd_barrier(const XcdBarrier& b, bool leader) {
    asm volatile("s_waitcnt vmcnt(0)" ::: "memory");
    __syncthreads();
    if (leader) {
        unsigned* bar = b.bar;
        __builtin_amdgcn_s_waitcnt(0);
        unsigned nloc = b.st[0], nx = b.st[1];
        if (nloc == 0u) { xcd_barrier_complete(bar, b.x, nloc, nx); b.st[0] = nloc; b.st[1] = nx; }
        const unsigned old = xb_add(&bar[XB_XSUB(b.x)], 1u);
        const unsigned gen = old / nloc;
        if (old + 1u == (gen + 1u) * nloc) {
            __builtin_amdgcn_fence(__ATOMIC_RELEASE, "agent");
            asm volatile("s_waitcnt vmcnt(0)" ::: "memory");
            const unsigned og = xb_add(&bar[XB_TOP], 1u);
            const unsigned tg = og / nx;
            if (og + 1u == (tg + 1u) * nx) xb_add(&bar[XB_TOPGEN], 1u);
            else XB_SPIN(xb_ld(&bar[XB_TOPGEN]) == tg, bar);
            __builtin_amdgcn_fence(__ATOMIC_ACQUIRE, "agent");
            xb_add(&bar[XB_XGEN(b.x)], 1u);
            asm volatile("s_waitcnt vmcnt(0)" ::: "memory");
        } else {
            XB_SPIN(xb_ld(&bar[XB_XGEN(b.x)]) == gen, bar);
            __builtin_amdgcn_fence(__ATOMIC_ACQUIRE, "agent");
            asm volatile("s_waitcnt vmcnt(0)" ::: "memory");
        }
    }
    __syncthreads();
}

#define GRID_SYNC() xcd_barrier(xb, tid_of(widx) == 0)

struct Params { const float* in[16]; float* out; unsigned char* ws; };

typedef __bf16 bf16x2_t __attribute__((ext_vector_type(2)));
__device__ __forceinline__ unsigned pk_bf16(float lo, float hi) { const f32x2 v = {lo, hi}; return __builtin_bit_cast(unsigned, __builtin_convertvector(v, bf16x2_t)); }
__device__ __forceinline__ float bf_lo(unsigned u) { return __uint_as_float(u << 16); }
__device__ __forceinline__ float bf_hi(unsigned u) { return __uint_as_float(u & 0xffff0000u); }
__device__ __forceinline__ float sigmoidf_(float x) { return __builtin_amdgcn_rcpf(1.0f + __builtin_amdgcn_exp2f(-1.44269504089f * x)); }
__device__ __forceinline__ float siluf_(float x) { return x * sigmoidf_(x); }
__device__ __forceinline__ u32x2 pk4(f32x4 v) { u32x2 r; r.x = pk_bf16(v[0], v[1]); r.y = pk_bf16(v[2], v[3]); return r; }
__device__ __forceinline__ f32x4 unpk4(u32x2 v) { return (f32x4){bf_lo(v.x), bf_hi(v.x), bf_lo(v.y), bf_hi(v.y)}; }
template <int CTRL> __device__ __forceinline__ float dppf(float old, float v) { return __int_as_float(__builtin_amdgcn_update_dpp(__float_as_int(old), __float_as_int(v), CTRL, 0xf, 0xf, false)); }
__device__ __forceinline__ float wave_sum(float v) {
#pragma unroll
    for (int o = 1; o < 64; o <<= 1) v += __shfl_xor(v, o);
    return v;
}

__device__ __forceinline__ int lds_byte(int r, int c) { const int st = (r >> 4) * 2 + (c >> 5), rr = r & 15, cc = c & 31, ob = rr * 64 + cc * 2; return st * 1024 + (ob ^ (((ob >> 9) & 1) << 5)); }
__device__ __forceinline__ void stage_rc(int b, int& R, int& C) { const int st = b / 1024, sb = b % 1024, swz = sb ^ (((sb >> 9) & 1) << 5); R = (st >> 1) * 16 + swz / 64; C = (st & 1) * 32 + (swz % 64) / 2; }

__device__ __forceinline__ int tid_of(int widx) { int l; asm volatile("v_mbcnt_lo_u32_b32 %0, -1, 0\n\tv_mbcnt_hi_u32_b32 %0, -1, %0" : "=v"(l)); return widx * 64 + l; }
struct Unit { const char* A; const char* B; int pm, pn, kind; };
__device__ __forceinline__ size_t native_slot(int pm, int pn4, int w4, int ai, int m, int bj, int n, int lane) {
    return ((((size_t)(pm * 4 + pn4) * 8 + w4) * 32 + (((ai * 4 + m) * 2 + bj) * 2 + n)) * 64 + lane);
}

template <int WG = 8> __device__ __forceinline__ void remap_tile(int L, int nM, int nN, int& pm, int& pn) {
    const int nwg = nM * nN; int wgid = L;
    { const int q = nwg / 8, r = nwg % 8, xcd = wgid % 8, off = wgid / 8; wgid = (xcd < r ? xcd * (q + 1) : r * (q + 1) + (xcd - r) * q) + off; }
    const int nig = WG * nN, gid = wgid / nig, fm = gid * WG, gsz = (nM - fm) < WG ? (nM - fm) : WG;
    pm = fm + ((wgid % nig) % gsz); pn = (wgid % nig) / gsz;
}

struct EpiOut;
template <class Epi> __device__ __forceinline__ bool epi_keeps(const Epi&, const Unit&) { return false; }
__device__ __forceinline__ bool epi_keeps(const EpiOut&, const Unit& u) { return u.kind < 2; }
template <class Epi, class Sched>
__device__ __forceinline__ void gemm_phase(LAS unsigned char* lds, const int lda, const int ldb, const int K, const Sched& S, const Epi& E, const int widx) {
    int tid_ = tid_of(widx); asm volatile("" : "+v"(tid_));
    const int tid = tid_, wid = __builtin_amdgcn_readfirstlane(tid >> 6), lane = tid & 63, wr = wid >> 2, wc = wid & 3, fr = lane & 15, fq = lane >> 4;
    const int nt = K / BK;
    unsigned voffA[2], voffB[2];
#pragma unroll
    for (int i = 0; i < 2; ++i) { int R, C; stage_rc(tid * 16 + i * 8192, R, C); voffA[i] = (unsigned)(R * lda + C) * 2u; voffB[i] = (unsigned)(R * ldb + C) * 2u; }
    const size_t kstep = (size_t)(BK * 2);
    const size_t hstepA = (size_t)HALF * lda * 2, hstepB = (size_t)HALF * ldb * 2;
    const unsigned ldsw = (unsigned)wid * 1024u;
    const int aoff = lds_byte(wr * 64 + fr, fq * 8), boff = lds_byte(wc * 32 + fr, fq * 8);
#define GP_SA(b, h) (((b) * 2 + (h)) * HTB)
#define GP_SB(b, h) ((4 + (b) * 2 + (h)) * HTB)
#define GP_STAGE(bufoff, gbase, voff) do { _Pragma("unroll") for (int _i = 0; _i < 2; ++_i) \
        __builtin_amdgcn_global_load_lds((const unsigned*)((const char*)(gbase) + (voff)[_i]), (LAS unsigned*)(lds + (bufoff) + ldsw + _i * 8192), 16, 0, 0); } while (0)
#define GP_LDA(dst, b, h) do { _Pragma("unroll") for (int m = 0; m < 4; ++m) _Pragma("unroll") for (int k = 0; k < 2; ++k) dst[m][k] = *(const LAS bf16x8*)(lds + GP_SA(b, h) + aoff + m * 2048 + k * 1024); } while (0)
#define GP_LDB(dst, b, h) do { _Pragma("unroll") for (int n = 0; n < 2; ++n) _Pragma("unroll") for (int k = 0; k < 2; ++k) dst[n][k] = *(const LAS bf16x8*)(lds + GP_SB(b, h) + boff + n * 2048 + k * 1024); } while (0)
#define GP_MMA(ai, bj, At, Bt) do { __builtin_amdgcn_s_setprio(1); _Pragma("unroll") for (int m = 0; m < 4; ++m) _Pragma("unroll") for (int n = 0; n < 2; ++n) _Pragma("unroll") for (int k = 0; k < 2; ++k) \
        acc[ai][bj][m][n] = __builtin_amdgcn_mfma_f32_16x16x32_bf16(Bt[n][k], At[m][k], acc[ai][bj][m][n], 0, 0, 0); __builtin_amdgcn_s_setprio(0); } while (0)
#define GP_WAIT_V(n) asm volatile("s_waitcnt vmcnt(" #n ")" ::: "memory")
#define GP_WAIT_L(n) asm volatile("s_waitcnt lgkmcnt(" #n ")" ::: "memory")
#define GP_BAR __builtin_amdgcn_s_barrier()
#define GP_SCHED __builtin_amdgcn_sched_barrier(0)
    Unit cur, nxt; int ui = 0;
    if (!S.next(0, cur)) return;
    f32x4 acc[2][2][4][2];
#pragma unroll
    for (int a = 0; a < 2; ++a)
#pragma unroll
        for (int b = 0; b < 2; ++b)
#pragma unroll
            for (int m = 0; m < 4; ++m)
#pragma unroll
                for (int n = 0; n < 2; ++n) acc[a][b][m][n] = (f32x4){0.f, 0.f, 0.f, 0.f};
    bf16x8 At[4][2], B0[2][2], B1[2][2];
    const char* cA = cur.A; const char* cB = cur.B;
    GP_STAGE(GP_SB(0, 0), cB, voffB); GP_STAGE(GP_SB(0, 1), cB + hstepB, voffB); GP_STAGE(GP_SA(0, 0), cA, voffA); GP_STAGE(GP_SA(0, 1), cA + hstepA, voffA);
    if (wr == 1) GP_BAR;
    GP_WAIT_V(2); GP_BAR;
    GP_STAGE(GP_SB(1, 0), cB + kstep, voffB); GP_STAGE(GP_SA(1, 0), cA + kstep, voffA); GP_STAGE(GP_SB(1, 1), cB + hstepB + kstep, voffB);
    GP_WAIT_V(6); GP_BAR;
    for (;;) {
        const bool has_next = S.next(ui + 1, nxt);
        const char* nA = has_next ? nxt.A : cA; const char* nB = has_next ? nxt.B : cB;
        for (int t = 0; t < nt; t += 2) {
            const bool last = (t == nt - 2);
            const char* a1 = cA + (size_t)(t + 1) * kstep;
            const char* a2 = last ? nA : cA + (size_t)(t + 2) * kstep; const char* b2 = last ? nB : cB + (size_t)(t + 2) * kstep;
            const char* a3 = a2 + kstep; const char* b3 = b2 + kstep;
            GP_LDB(B0, 0, 0); GP_LDB(B1, 0, 1); GP_SCHED; GP_LDA(At, 0, 0); GP_STAGE(GP_SA(1, 1), a1 + hstepA, voffA);
            GP_WAIT_V(8); GP_WAIT_L(0); GP_BAR; GP_MMA(0, 0, At, B0); GP_MMA(0, 1, At, B1); GP_BAR; GP_SCHED;
            GP_LDA(At, 0, 1); GP_STAGE(GP_SB(0, 0), b2, voffB); GP_STAGE(GP_SB(0, 1), b2 + hstepB, voffB); GP_STAGE(GP_SA(0, 0), a2, voffA);
            GP_WAIT_V(8); GP_WAIT_L(0); GP_BAR; GP_MMA(1, 0, At, B0); GP_MMA(1, 1, At, B1); GP_BAR; GP_SCHED;
            GP_LDB(B0, 1, 0); GP_LDB(B1, 1, 1); GP_SCHED; GP_LDA(At, 1, 0); GP_STAGE(GP_SA(0, 1), a2 + hstepA, voffA);
            GP_WAIT_V(8); GP_WAIT_L(0); GP_BAR; GP_MMA(0, 0, At, B0); GP_MMA(0, 1, At, B1); GP_BAR; GP_SCHED;
            GP_LDA(At, 1, 1); GP_STAGE(GP_SB(1, 0), b3, voffB); GP_STAGE(GP_SB(1, 1), b3 + hstepB, voffB); GP_STAGE(GP_SA(1, 0), a3, voffA);
            GP_WAIT_V(8); GP_WAIT_L(0); GP_BAR; GP_MMA(1, 0, At, B0); GP_MMA(1, 1, At, B1); GP_BAR; GP_SCHED;
        }
        if (wr == 0) GP_BAR;
        E(acc, cur, wr, wc, fr, fq);
        if (!has_next) break;
        if (!epi_keeps(E, cur)) {
#pragma unroll
        for (int a = 0; a < 2; ++a)
#pragma unroll
            for (int b = 0; b < 2; ++b)
#pragma unroll
                for (int m = 0; m < 4; ++m)
#pragma unroll
                    for (int n = 0; n < 2; ++n) acc[a][b][m][n] = (f32x4){0.f, 0.f, 0.f, 0.f};
        }
        cur = nxt; cA = nA; cB = nB; ++ui;
        if (wr == 1) GP_BAR;
    }
    GP_WAIT_V(0);
    GP_BAR;
#undef GP_SA
#undef GP_SB
#undef GP_STAGE
#undef GP_LDA
#undef GP_LDB
#undef GP_MMA
#undef GP_WAIT_V
#undef GP_WAIT_L
#undef GP_BAR
#undef GP_SCHED
}

struct SchedP1 {
    const char *U, *Win, *Memn, *Wkv; int G, c;
    __device__ __forceinline__ bool next(int i, Unit& u) const {
        if (G == 256) {
            if (i < 24) { const int l = i * 32 + (c >> 3); int pm = l / 6, pn = 6 * (c & 7) + l % 6; pn = (pn % 3) * 16 + pn / 3;
                u.pm = pm; u.pn = pn; u.kind = pn >> 4; u.A = U + (size_t)pm * TILE; u.B = Win + (size_t)pn * TILE; return true; }
            if (i > 24 || c >= 32) return false;
            int L = c;
            if (L < 16) { u.pm = L >> 2; u.pn = L & 3; u.kind = 3; u.A = Memn + (size_t)u.pm * TILE; u.B = Wkv + (size_t)u.pn * TILE; }
            else { L -= 16; u.pm = L >> 2; u.pn = L & 3; u.kind = 4; u.A = Wkv + (size_t)(4 + u.pm) * TILE; u.B = Memn + (size_t)u.pn * TILE; }
            return true;
        }
        int L = i * G + c;
        if (L < 6144) { int pm, pn; remap_tile<4>(L, 128, 48, pm, pn); pn = (pn % 3) * 16 + pn / 3; u.pm = pm; u.pn = pn; u.kind = pn >> 4; u.A = U + (size_t)pm * TILE; u.B = Win + (size_t)pn * TILE; return true; }
        L -= 6144; if (L >= 32) return false;
        if (L < 16) { u.pm = L >> 2; u.pn = L & 3; u.kind = 3; u.A = Memn + (size_t)u.pm * TILE; u.B = Wkv + (size_t)u.pn * TILE; }
        else { L -= 16; u.pm = L >> 2; u.pn = L & 3; u.kind = 4; u.A = Wkv + (size_t)(4 + u.pm) * TILE; u.B = Memn + (size_t)u.pn * TILE; }
        return true;
    }
};
struct SchedAttn {
    const char *Aq, *Bm; size_t bstride_b, bstride_h; int G, c;
    __device__ __forceinline__ bool next(int i, Unit& u) const {
        const int L = i * G + c; if (L >= 512) return false;
        u.pm = L >> 2; u.pn = L & 3; u.kind = 0;
        u.A = Aq + (size_t)u.pm * TILE + (size_t)u.pn * 512; u.B = Bm + (size_t)(u.pm >> 5) * bstride_b + (size_t)u.pn * bstride_h; return true;
    }
};
struct SchedOut {
    const char *H, *HXp, *W; int G, c;
    __device__ __forceinline__ bool next(int i, Unit& u) const {
        const int ti = i / 3, g = i - 3 * ti; const int L = ti * G + c; if (L >= 512) return false;
        int pm, pn; remap_tile(L, 128, 4, pm, pn); u.pm = pm; u.pn = pn; u.kind = g;
        if (g == 2) u.A = HXp + (size_t)pm * TILE; else u.A = H + ((size_t)g * 128 + pm) * TILE;
        u.B = W + ((size_t)g * 4 + pn) * TILE; return true;
    }
};
struct SchedWo {
    const char *A, *W; int G, c;
    __device__ __forceinline__ bool next(int i, Unit& u) const {
        const int L = i * G + c; if (L >= 512) return false;
        int pm, pn; remap_tile(L, 128, 4, pm, pn); u.pm = pm; u.pn = pn; u.kind = 0; u.A = A + (size_t)pm * TILE; u.B = W + (size_t)pn * TILE; return true;
    }
};

__device__ __forceinline__ int pf(int fq) { return (fq >> 1) | ((fq & 1) << 1); }
__device__ __forceinline__ void store_pair16(bf16_t* rowbase  , u32x2 a  , u32x2 b  , int fq) {
    const auto rx = __builtin_amdgcn_permlane32_swap(a.x, b.x, false, false), ry = __builtin_amdgcn_permlane32_swap(a.y, b.y, false, false);
    *(u32x4*)(rowbase + (size_t)((fq >> 1) * 16) * 1024 + (fq & 1) * 8) = (u32x4){rx[0], ry[0], rx[1], ry[1]};
}
struct EpiP1 {
    bf16_t *HA, *GLU, *SZB, *SZX, *Q, *SGA, *SGB, *SGX, *KB, *VT, *PAT, *GAH; const float* convw;
    __device__ __forceinline__ void operator()(const f32x4 (&acc)[2][2][4][2], const Unit& u, int wr, int wc, int fr, int fq) const {
        if (u.kind <= 2) {
            const int chw = (u.pn & 15) * 64 + wc * 16, ch = chw + pf(fq) * 4;
            const int rowb = u.pm * 256 + wr * 64 + fr;
            if (u.kind == 0) {
                const f32x4 w0 = *(const f32x4*)(convw + ch), w1 = *(const f32x4*)(convw + 1024 + ch), w2 = *(const f32x4*)(convw + 2048 + ch);
#pragma unroll
                for (int ai = 0; ai < 2; ++ai) {
                    const int blk = u.pm * 4 + ai * 2 + wr;
                    f32x4 pprev = (f32x4){0.f, 0.f, 0.f, 0.f}; u32x2 hv[4];
#pragma unroll
                    for (int m = 0; m < 4; ++m) {
                        const f32x4 Bv = acc[ai][0][m][0], Cv = acc[ai][0][m][1], Xv = acc[ai][1][m][0], Zv = acc[ai][1][m][1];
                        const f32x4 p = Cv * Xv; f32x4 ga, p1, p2;
#pragma unroll
                        for (int j = 0; j < 4; ++j) {
                            ga[j] = siluf_(Zv[j]) * Bv[j];
                            const float r1 = (m > 0) ? dppf<0x121>(0.f, pprev[j]) : 0.f, r2 = (m > 0) ? dppf<0x122>(0.f, pprev[j]) : 0.f;
                            p1[j] = dppf<0x111>(r1, p[j]); p2[j] = dppf<0x112>(r2, p[j]);
                        }
                        const f32x4 cv = w2 * p + w1 * p1 + w0 * p2;
                        hv[m] = pk4(ga * cv);
                        if (m == 3 && fr >= 14) *(u32x2*)(PAT + (size_t)(blk * 2 + (fr - 14)) * 1024 + ch) = pk4(p);
                        if (m == 0 && fr < 2) *(u32x2*)(GAH + (size_t)(blk * 2 + fr) * 1024 + ch) = pk4(ga);
                        pprev = p;
                    }
#pragma unroll
                    for (int pr = 0; pr < 2; ++pr) store_pair16(HA + (size_t)(rowb + ai * 128 + pr * 32) * 1024 + chw, hv[2 * pr], hv[2 * pr + 1], fq);
                }
            } else if (u.kind == 1) {
#pragma unroll
                for (int ai = 0; ai < 2; ++ai) {
                    u32x2 gv[4], zv[4];
#pragma unroll
                    for (int m = 0; m < 4; ++m) {
                        const f32x4 Vv = acc[ai][0][m][0], Gv = acc[ai][0][m][1], Zb = acc[ai][1][m][0], Zx = acc[ai][1][m][1]; f32x4 o0, o1, o2;
#pragma unroll
                        for (int j = 0; j < 4; ++j) { o0[j] = Vv[j] * sigmoidf_(Gv[j]); o1[j] = siluf_(Zb[j]); o2[j] = siluf_(Zx[j]); }
                        gv[m] = pk4(o0); zv[m] = pk4(o1);
                        { const int c = (u.pn & 3) * 64 + wc * 16;
                          __builtin_nontemporal_store(pk4(o2), (u32x2*)SZX + native_slot(u.pm, (u.pn & 15) >> 2, wr * 4 + ((c >> 5) & 3), ai, m, c >> 7, (c >> 4) & 1, pf(fq) * 16 + fr)); }
                    }
#pragma unroll
                    for (int pr = 0; pr < 2; ++pr) {
                        store_pair16(GLU + (size_t)(rowb + ai * 128 + pr * 32) * 1024 + chw, gv[2 * pr], gv[2 * pr + 1], fq);
                        store_pair16(SZB + (size_t)(rowb + ai * 128 + pr * 32) * 1024 + chw, zv[2 * pr], zv[2 * pr + 1], fq);
                    }
                }
            } else {
#pragma unroll
                for (int ai = 0; ai < 2; ++ai) {
                    u32x2 qv[4];
#pragma unroll
                    for (int m = 0; m < 4; ++m) {
                        const f32x4 Qv = acc[ai][0][m][0], Ga = acc[ai][0][m][1], Gb = acc[ai][1][m][0], Gx = acc[ai][1][m][1]; f32x4 o1, o2, o3;
#pragma unroll
                        for (int j = 0; j < 4; ++j) { const float sa = sigmoidf_(Ga[j]), sb = sigmoidf_(Gb[j]), sx = sigmoidf_(Gx[j]);
                            o1[j] = sa * __builtin_amdgcn_rcpf(fmaxf(sb, 1e-30f)); o2[j] = sb * __builtin_amdgcn_rcpf(fmaxf(sx, 1e-30f)); o3[j] = sx; }
                        qv[m] = pk4(Qv * 0.0625f);
                        const int c = (u.pn & 3) * 64 + wc * 16;
                        const size_t ns = native_slot(u.pm, (u.pn & 15) >> 2, wr * 4 + ((c >> 5) & 3), ai, m, c >> 7, (c >> 4) & 1, pf(fq) * 16 + fr);
                        __builtin_nontemporal_store(pk4(o1), (u32x2*)SGA + ns); __builtin_nontemporal_store(pk4(o2), (u32x2*)SGB + ns); __builtin_nontemporal_store(pk4(o3), (u32x2*)SGX + ns);
                    }
#pragma unroll
                    for (int pr = 0; pr < 2; ++pr) store_pair16(Q + (size_t)(rowb + ai * 128 + pr * 32) * 1024 + chw, qv[2 * pr], qv[2 * pr + 1], fq);
                }
            }
        } else {
            const int r0 = wr * 64 + fr, c0 = wc * 32 + fq * 4;
#pragma unroll
            for (int ai = 0; ai < 2; ++ai)
#pragma unroll
                for (int m = 0; m < 4; ++m)
#pragma unroll
                    for (int bj = 0; bj < 2; ++bj)
#pragma unroll
                        for (int n = 0; n < 2; ++n) {
                            const int r = r0 + ai * 128 + m * 16, c = c0 + bj * 128 + n * 16;
                            if (u.kind == 3) *(u32x2*)(KB + (size_t)(u.pm * 256 + r) * 1024 + u.pn * 256 + c) = pk4(acc[ai][bj][m][n]);
                            else             *(u32x2*)(VT + ((size_t)u.pn * 1024 + u.pm * 256 + r) * 256 + c) = pk4(acc[ai][bj][m][n]);
                        }
        }
    }
};
struct EpiS {
    bf16_t* Q; float* RSUM;
    __device__ __forceinline__ void operator()(const f32x4 (&acc)[2][2][4][2], const Unit& u, int wr, int wc, int fr, int fq) const {
#pragma unroll
        for (int ai = 0; ai < 2; ++ai)
#pragma unroll
            for (int m = 0; m < 4; ++m) {
                const int row = u.pm * 256 + ai * 128 + wr * 64 + m * 16 + fr; float rs = 0.f;
#pragma unroll
                for (int bj = 0; bj < 2; ++bj)
#pragma unroll
                    for (int n = 0; n < 2; ++n) {
                        const f32x4 s = acc[ai][bj][m][n]; f32x4 e;
#pragma unroll
                        for (int j = 0; j < 4; ++j) e[j] = __builtin_amdgcn_exp2f(1.44269504089f * s[j]);
                        const u32x2 w = pk4(e); const f32x4 er = unpk4(w); rs += (er[0] + er[1]) + (er[2] + er[3]);
                        *(u32x2*)(Q + (size_t)row * 1024 + u.pn * 256 + bj * 128 + wc * 32 + n * 16 + fq * 4) = w;
                    }
                rs += __shfl_xor(rs, 16); rs += __shfl_xor(rs, 32);
                if (fq == 0) unsafeAtomicAdd(RSUM + row * 4 + u.pn, rs);
            }
    }
};
struct EpiPV {
    const bf16_t* SZXN; bf16_t* HX; const float* RSUM;
    __device__ __forceinline__ void operator()(const f32x4 (&acc)[2][2][4][2], const Unit& u, int wr, int wc, int fr_in, int fq_in) const {
        int fr = fr_in, fq = fq_in; asm volatile("" : "+v"(fr), "+v"(fq));
        const int w4 = wr * 4 + wc, lane = fq * 16 + fr;
#pragma unroll
        for (int ai = 0; ai < 2; ++ai) {
            u32x2 z[4][2][2]; float rs[4];
#pragma unroll
            for (int m = 0; m < 4; ++m) {
                rs[m] = RSUM[(u.pm * 256 + ai * 128 + wr * 64 + m * 16 + fr) * 4 + u.pn];
#pragma unroll
                for (int bj = 0; bj < 2; ++bj)
#pragma unroll
                    for (int n = 0; n < 2; ++n) z[m][bj][n] = __builtin_nontemporal_load((const u32x2*)SZXN + native_slot(u.pm, u.pn, w4, ai, m, bj, n, lane));
            }
#pragma unroll
            for (int m = 0; m < 4; ++m) {
                const int row = u.pm * 256 + ai * 128 + wr * 64 + m * 16 + fr; const float inv = __builtin_amdgcn_rcpf(rs[m]);
#pragma unroll
                for (int bj = 0; bj < 2; ++bj)
#pragma unroll
                    for (int n = 0; n < 2; ++n)
                        *(u32x2*)(HX + (size_t)row * 1024 + u.pn * 256 + bj * 128 + wc * 32 + n * 16 + fq * 4) = pk4(unpk4(z[m][bj][n]) * (acc[ai][bj][m][n] * inv));
            }
        }
    }
};
__device__ __forceinline__ void ld8(u32x2 (&d)[8], const u32x2* p) {
    asm volatile("global_load_dwordx2 %0, %1, off"             : "=v"(d[0]) : "v"(p) : "memory");
    asm volatile("global_load_dwordx2 %0, %1, off offset:512"  : "=v"(d[1]) : "v"(p) : "memory");
    asm volatile("global_load_dwordx2 %0, %1, off offset:1024" : "=v"(d[2]) : "v"(p) : "memory");
    asm volatile("global_load_dwordx2 %0, %1, off offset:1536" : "=v"(d[3]) : "v"(p) : "memory");
    asm volatile("global_load_dwordx2 %0, %1, off offset:2048" : "=v"(d[4]) : "v"(p) : "memory");
    asm volatile("global_load_dwordx2 %0, %1, off offset:2560" : "=v"(d[5]) : "v"(p) : "memory");
    asm volatile("global_load_dwordx2 %0, %1, off offset:3072" : "=v"(d[6]) : "v"(p) : "memory");
    asm volatile("global_load_dwordx2 %0, %1, off offset:3584" : "=v"(d[7]) : "v"(p) : "memory");
}
__device__ __forceinline__ void ld4(u32x2 (&d)[4], const u32x2* p) {
    asm volatile("global_load_dwordx2 %0, %1, off nt"          : "=v"(d[0]) : "v"(p) : "memory");
    asm volatile("global_load_dwordx2 %0, %1, off offset:512 nt" : "=v"(d[1]) : "v"(p) : "memory");
    asm volatile("global_load_dwordx2 %0, %1, off offset:1024 nt" : "=v"(d[2]) : "v"(p) : "memory");
    asm volatile("global_load_dwordx2 %0, %1, off offset:1536 nt" : "=v"(d[3]) : "v"(p) : "memory");
}
__device__ __forceinline__ void tie4(u32x2 (&d)[4]) { asm volatile("" : "+v"(d[0]), "+v"(d[1]), "+v"(d[2]), "+v"(d[3])); }
__device__ __forceinline__ void tie8(u32x2 (&d)[8]) { asm volatile("" : "+v"(d[0]), "+v"(d[1]), "+v"(d[2]), "+v"(d[3]), "+v"(d[4]), "+v"(d[5]), "+v"(d[6]), "+v"(d[7])); }

struct EpiOut {
    const bf16_t *F1, *F2, *F3; bf16_t* MERGED;
    template <int POS> __device__ __forceinline__ void run(f32x4 (&acc)[2][2][4][2], const Unit& u, const bf16_t* F, int wr, int wc, int fr, int fq) const {
        const int w4 = wr * 4 + wc, lane = fq * 16 + fr;
        const u32x2* s0 = (const u32x2*)F + native_slot(u.pm, u.pn, w4, 0, 0, 0, 0, lane);
        u32x2 ga[2][4];
        ld4(ga[0], s0); ld4(ga[1], s0 + 256);
#pragma unroll
        for (int e = 0; e < 8; ++e) {
            if (POS < 2) { if (e < 7) asm volatile("s_waitcnt vmcnt(4)" ::: "memory"); else asm volatile("s_waitcnt vmcnt(0)" ::: "memory"); }
            else { if (e == 0) asm volatile("s_waitcnt vmcnt(4)" ::: "memory"); else if (e < 7) asm volatile("s_waitcnt vmcnt(8)" ::: "memory"); else asm volatile("s_waitcnt vmcnt(4)" ::: "memory"); }
            tie4(ga[e & 1]);
            const int ai = e >> 2, m = e & 3;
#pragma unroll
            for (int k = 0; k < 4; ++k) { const int bj = k >> 1, n = k & 1;
                const f32x4 f = unpk4(ga[e & 1][k]);
                if (POS < 2) acc[ai][bj][m][n] *= f;
                else *(u32x2*)(MERGED + (size_t)(u.pm * 256 + ai * 128 + wr * 64 + m * 16 + fr) * 1024 + u.pn * 256 + bj * 128 + wc * 32 + n * 16 + fq * 4) = pk4(f * acc[ai][bj][m][n]);
            }
            if (e + 2 < 8) ld4(ga[e & 1], s0 + (e + 2) * 256);
        }
    }
    __device__ __forceinline__ void operator()(f32x4 (&acc)[2][2][4][2], const Unit& u, int wr, int wc, int fr, int fq) const {
        if (u.kind < 2) run<0>(acc, u, F1 + ((size_t)u.kind << 25)  , wr, wc, fr, fq);
        else run<2>(acc, u, F3, wr, wc, fr, fq);
    }
};
struct EpiWo {
    const float* X; bf16_t* HN; float* ROWSS;
    __device__ __forceinline__ void operator()(const f32x4 (&acc)[2][2][4][2], const Unit& u, int wr, int wc, int fr, int fq) const {
        const int w4 = wr * 4 + wc, lane = fq * 16 + fr;
#pragma unroll
        for (int ai = 0; ai < 2; ++ai) {
            f32x4 xv[4][2][2];
#pragma unroll
            for (int m = 0; m < 4; ++m)
#pragma unroll
                for (int bj = 0; bj < 2; ++bj)
#pragma unroll
                    for (int n = 0; n < 2; ++n)
                        xv[m][bj][n] = __builtin_nontemporal_load((const f32x4*)(X + (size_t)(u.pm * 256 + ai * 128 + wr * 64 + m * 16 + fr) * 1024 + u.pn * 256 + bj * 128 + wc * 32 + n * 16 + fq * 4));
#pragma unroll
            for (int m = 0; m < 4; ++m) {
                const int row = u.pm * 256 + ai * 128 + wr * 64 + m * 16 + fr; float ss = 0.f;
#pragma unroll
                for (int bj = 0; bj < 2; ++bj)
#pragma unroll
                    for (int n = 0; n < 2; ++n) {
                        const u32x2 hw = pk4(xv[m][bj][n] + acc[ai][bj][m][n]); const f32x4 h = unpk4(hw);
                        ((u32x2*)HN)[native_slot(u.pm, u.pn, w4, ai, m, bj, n, lane)] = hw; ss += (h[0] * h[0] + h[1] * h[1]) + (h[2] * h[2] + h[3] * h[3]);
                    }
                ss += __shfl_xor(ss, 16); ss += __shfl_xor(ss, 32);
                if (fq == 0) unsafeAtomicAdd(ROWSS + row, ss);
            }
        }
    }
};

__device__ __forceinline__ int win_src_col(int R) {
    const int unit = R >> 8, rho = R & 255, kind = unit >> 4, cu = unit & 15;
    const int fqb = (rho >> 2) & 3;
    const int gi = ((rho >> 7) & 1) * 2 + ((rho >> 4) & 1), chl = ((rho >> 5) & 3) * 16 + (((fqb >> 1) | ((fqb & 1) << 1)) << 2) + (rho & 3);
    int base;
    if (kind == 0) base = gi * 1024;
    else if (kind == 1) base = (gi < 3) ? 4096 + gi * 1024 : 8192;
    else base = (gi == 0) ? 7168 : 9216 + (gi - 1) * 1024;
    return base + cu * 64 + chl;
}
__device__ __forceinline__ void p0_transpose_item(const float* W, int ldw, bf16_t* WT, int dst_row0, int k0, bool perm, LAS float* scr, int lane) {
    const int li = lane & 31; const int drow = dst_row0 + (perm ? ((li & 15) + ((li >> 4) << 5)) : li); const int scol = perm ? win_src_col(drow) : drow;
#pragma unroll
    for (int i = 0; i < 32; ++i) { const int kk = 2 * i + (lane >> 5); scr[kk * 33 + (lane & 31)] = __builtin_nontemporal_load(W + (size_t)(k0 + kk) * ldw + scol); }
    asm volatile("s_waitcnt lgkmcnt(0)" ::: "memory");
    const int c = lane & 7;
#pragma unroll
    for (int j = 0; j < 4; ++j) { const int n = (lane >> 3) + 8 * j; const LAS float* s = scr + (8 * c) * 33 + n;
        u32x4 o; o.x = pk_bf16(s[0 * 33], s[1 * 33]); o.y = pk_bf16(s[2 * 33], s[3 * 33]); o.z = pk_bf16(s[4 * 33], s[5 * 33]); o.w = pk_bf16(s[6 * 33], s[7 * 33]);
        const int orow = dst_row0 + (perm ? ((n & 15) + ((n >> 4) << 5)) : n);
        *(u32x4*)(WT + (size_t)orow * 1024 + k0 + 8 * c) = o; }
    asm volatile("s_waitcnt lgkmcnt(0)" ::: "memory");
}
__device__ __forceinline__ void rms_row_to_bf16(const float* xrow, const float* g, bf16_t* orow, int lane) {
    const f32x4* xr = (const f32x4*)xrow + lane; const f32x4* gr = (const f32x4*)g + lane;
    f32x4 v[4]; float s = 0.f;
#pragma unroll
    for (int j = 0; j < 4; ++j) { v[j] = xr[64 * j]; s += (v[j][0] * v[j][0] + v[j][1] * v[j][1]) + (v[j][2] * v[j][2] + v[j][3] * v[j][3]); }
    const float rstd = 1.0f / sqrtf(wave_sum(s) * (1.f / 1024.f) + EPS);
    u32x2* o8 = (u32x2*)orow + lane;
#pragma unroll
    for (int j = 0; j < 4; ++j) { const f32x4 gg = gr[64 * j]; o8[64 * j] = pk4(v[j] * rstd * gg); }
}

template <int PH>
__device__ __forceinline__ void conv31_chunk(LAS unsigned char* lds, LAS float* red, LAS float* stats, const bf16_t* GLU, bf16_t* SZB, const float* cw, const float* cb, const float* lng, const float* lnb,
                                            const int t0, const bool has_next, const int tid_in) {
    int tid_o = tid_in; asm volatile("" : "+v"(tid_o));
    const int tid = tid_o, lane = tid & 63, wid = tid >> 6, c2 = tid * 2;
    u32x4 nx[4];
    if (has_next) {
        int tf = tid; asm volatile("" : "+v"(tf));
#pragma unroll
        for (int q = 0; q < 4; ++q) { const int i = tf + q * 512; nx[q] = __builtin_nontemporal_load((const u32x4*)(GLU + (size_t)(t0 + 16 + (i >> 7)) * 1024 + (i & 127) * 8)); }
    }
    const f32x2 bias = *(const f32x2*)(cb + c2);
    f32x2 outv[16];
#pragma unroll
    for (int t = 0; t < 16; ++t) outv[t] = bias;
#pragma unroll
    for (int ps = 0; ps < 2; ++ps) {
        const int kb = ps * 16, ntap = ps == 0 ? 16 : 15;
        f32x2 w[16];
#pragma unroll
        for (int k = 0; k < 16; ++k) if (k < ntap) w[k] = *(const f32x2*)(cw + (kb + k) * 1024 + c2);
#pragma unroll
        for (int r = 0; r < 31; ++r) if (r < ntap + 15) {
            const unsigned v = *(const LAS unsigned*)(lds + ((34 + 16 * PH + kb + r) & 63) * 2048 + tid * 4);
            const f32x2 x = (f32x2){bf_lo(v), bf_hi(v)};
#pragma unroll
            for (int t = 0; t < 16; ++t) { const int k = r - t; if (k >= 0 && k < ntap) outv[t] = __builtin_elementwise_fma(w[k], x, outv[t]); }
            if ((r & 7) == 7) asm volatile("" ::: "memory");
        }
    }
    {
        float s[16], q[16];
#pragma unroll
        for (int t = 0; t < 16; ++t) { s[t] = outv[t][0] + outv[t][1]; q[t] = outv[t][0] * outv[t][0] + outv[t][1] * outv[t][1]; }
#pragma unroll
        for (int lvl = 0; lvl < 4; ++lvl) {
            const int half = 8 >> lvl, off = 32 >> lvl; const bool hi = (lane & off) != 0;
#pragma unroll
            for (int i = 0; i < half; ++i) {
                const float ks = hi ? s[i + half] : s[i], ss = hi ? s[i] : s[i + half]; s[i] = ks + __shfl_xor(ss, off);
                const float kq = hi ? q[i + half] : q[i], sq = hi ? q[i] : q[i + half]; q[i] = kq + __shfl_xor(sq, off);
            }
        }
        s[0] += __shfl_xor(s[0], 2); q[0] += __shfl_xor(q[0], 2);
        s[0] += __shfl_xor(s[0], 1); q[0] += __shfl_xor(q[0], 1);
        if ((lane & 3) == 0) *(LAS f32x2*)(red + ((lane >> 2) * 8 + wid) * 2) = (f32x2){s[0], q[0]};
    }
    __syncthreads();
    if (has_next) {
#pragma unroll
        for (int q = 0; q < 4; ++q) { const int i = tid + q * 512; *(LAS u32x4*)(lds + ((34 + 16 * PH + 46 + (i >> 7)) & 63) * 2048 + (i & 127) * 16) = nx[q]; }
    }
    if (tid < 16) {
        float S = 0.f, Q2 = 0.f;
#pragma unroll
        for (int wv = 0; wv < 8; ++wv) { const f32x2 t = *(const LAS f32x2*)(red + (tid * 8 + wv) * 2); S += t[0]; Q2 += t[1]; }
        const float mean = S * (1.f / 1024.f), var = fmaxf(Q2 * (1.f / 1024.f) - mean * mean, 0.f);
        *(LAS f32x2*)(stats + tid * 2) = (f32x2){mean, 1.0f / sqrtf(var + EPS)};
    }
    __syncthreads();
    const f32x2 lg = *(const f32x2*)(lng + c2), lb = *(const f32x2*)(lnb + c2);
    unsigned zz[16];
#pragma unroll
    for (int t = 0; t < 16; ++t) zz[t] = __builtin_nontemporal_load((const unsigned*)(SZB + (size_t)(t0 + t) * 1024 + c2));
#pragma unroll
    for (int t = 0; t < 16; ++t) {
        const f32x2 st = *(const LAS f32x2*)(stats + t * 2);
        const float y0 = (outv[t][0] - st[0]) * st[1] * lg[0] + lb[0], y1 = (outv[t][1] - st[0]) * st[1] * lg[1] + lb[1];
        *(unsigned*)(SZB + (size_t)(t0 + t) * 1024 + c2) = pk_bf16(bf_lo(zz[t]) * siluf_(y0), bf_hi(zz[t]) * siluf_(y1));
    }
}
__device__ __forceinline__ void conv31_phase(LAS unsigned char* lds, const bf16_t* GLU, bf16_t* SZB, const float* cw, const float* cb, const float* lng, const float* lnb, int G, int c, const int widx) {
    int tid_ = tid_of(widx); asm volatile("" : "+v"(tid_));
    const int tid = tid_;
    LAS float* red = (LAS float*)(lds + 131072 + 1024);
    LAS float* stats = (LAS float*)(lds + 131072 + 3072);
    for (int run = c; run < NTOK / 128; run += G) {
        const int T0 = run * 128, tpos = T0 & (SEQ - 1);
        __syncthreads();
#pragma unroll
        for (int h = 0; h < 2; ++h) {
            int tf = tid; asm volatile("" : "+v"(tf));
            u32x4 tv[6];
#pragma unroll
            for (int q = 0; q < 6; ++q) { const int i = tf + (h * 6 + q) * 512, r = (i >> 7) < 46 ? (i >> 7) : 45; const int gr = (tpos - 30 + r >= 0) ? (T0 - 30 + r) : T0;
                tv[q] = *(const u32x4*)(GLU + (size_t)gr * 1024 + (i & 127) * 8); }
#pragma unroll
            for (int q = 0; q < 6; ++q) { const int i = tf + (h * 6 + q) * 512, r = i >> 7;
                if (r < 46) *(LAS u32x4*)(lds + ((34 + r) & 63) * 2048 + (i & 127) * 16) = (tpos - 30 + r >= 0) ? tv[q] : (u32x4){0u, 0u, 0u, 0u}; }
        }
        __syncthreads();
        conv31_chunk<0>(lds, red, stats, GLU, SZB, cw, cb, lng, lnb, T0, true, tid);
        conv31_chunk<1>(lds, red, stats, GLU, SZB, cw, cb, lng, lnb, T0 + 16, true, tid);
        conv31_chunk<2>(lds, red, stats, GLU, SZB, cw, cb, lng, lnb, T0 + 32, true, tid);
        conv31_chunk<3>(lds, red, stats, GLU, SZB, cw, cb, lng, lnb, T0 + 48, true, tid);
        conv31_chunk<0>(lds, red, stats, GLU, SZB, cw, cb, lng, lnb, T0 + 64, true, tid);
        conv31_chunk<1>(lds, red, stats, GLU, SZB, cw, cb, lng, lnb, T0 + 80, true, tid);
        conv31_chunk<2>(lds, red, stats, GLU, SZB, cw, cb, lng, lnb, T0 + 96, true, tid);
        conv31_chunk<3>(lds, red, stats, GLU, SZB, cw, cb, lng, lnb, T0 + 112, false, tid);
    }
    __syncthreads();
}

__global__ void __launch_bounds__(512, 2) fwd_megakernel(Params p) {
    extern __shared__ __attribute__((aligned(16))) unsigned char lds_raw[];
    LAS unsigned char* lds = (LAS unsigned char*)lds_raw;
    const int G = gridDim.x, bx = blockIdx.x;
    unsigned char* ws = p.ws; unsigned char* ob = (unsigned char*)p.out;
    const float *x = p.in[0], *mem = p.in[1], *norm_g = p.in[2], *w_in = p.in[3], *conv_a_w = p.in[4], *w_out_a = p.in[5], *conv_b_w = p.in[6], *conv_b_b = p.in[7],
                *ln_b_g = p.in[8], *ln_b_b = p.in[9], *w_out_b = p.in[10], *mem_norm_g = p.in[11], *w_kv = p.in[12], *w_out_x = p.in[13], *w_o = p.in[14], *final_g = p.in[15];
    bf16_t *WIN = (bf16_t*)(ws + WS_WIN), *WOUT = (bf16_t*)(ws + WS_WOUT), *WO = (bf16_t*)(ws + WS_WO), *WKV = (bf16_t*)(ws + WS_WKV), *MEMN = (bf16_t*)(ws + WS_MEMN),
           *KB = (bf16_t*)(ws + WS_KB), *VT = (bf16_t*)(ws + WS_VT), *PAT = (bf16_t*)(ws + WS_PAT), *GAH = (bf16_t*)(ws + WS_GAH), *HA = (bf16_t*)(ws + WS_HA), *SZB = (bf16_t*)(ws + WS_SZB),
           *SZX = (bf16_t*)(ws + WS_SZX), *GLU = (bf16_t*)(ws + WS_GLU), *Q = (bf16_t*)(ws + WS_Q), *SGA = (bf16_t*)(ws + WS_SGA), *SGB = (bf16_t*)(ws + WS_SGB),
           *U = (bf16_t*)(ob + OUT_U), *SGX = (bf16_t*)(ob + OUT_SGX);
    float *ROWSS = (float*)(ws + WS_ROWSS), *RSUM = (float*)(ws + WS_RSUM);
    bf16_t* MERGED = GLU;
    volatile LAS unsigned* xst = (volatile LAS unsigned*)(lds + 131072 + 512);
    const int widx = __builtin_amdgcn_readfirstlane((int)threadIdx.x >> 6);
    if (threadIdx.x < 4) xst[threadIdx.x] = 0u;
    __syncthreads();
    XcdBarrier xb = xcd_barrier_post((unsigned*)(ws + WS_BAR), xst, threadIdx.x == 0);

    {
        int tid_ = tid_of(widx); asm volatile("" : "+v"(tid_)); const int tid = tid_, lane = tid & 63, wave = tid >> 6;
        LAS float* scr = (LAS float*)(lds + wave * 16384);
        const int gw = bx * 8 + wave, NGW = G * 8;
        for (int it = gw; it < 9216; it += NGW) {
            int r = it;
            if (r < 6144) { const int g = r % 384; p0_transpose_item(w_in, 12288, WIN, (g >> 1) * 64 + (g & 1) * 16, (r / 384) * 64, true, scr, lane); continue; } r -= 6144;
            if (r < 512) { p0_transpose_item(w_out_a, 1024, WOUT, (r & 31) * 32, (r >> 5) * 64, false, scr, lane); continue; } r -= 512;
            if (r < 512) { p0_transpose_item(w_out_b, 1024, WOUT + (size_t)1024 * 1024, (r & 31) * 32, (r >> 5) * 64, false, scr, lane); continue; } r -= 512;
            if (r < 512) { p0_transpose_item(w_out_x, 1024, WOUT + (size_t)2048 * 1024, (r & 31) * 32, (r >> 5) * 64, false, scr, lane); continue; } r -= 512;
            if (r < 512) { p0_transpose_item(w_o, 1024, WO, (r & 31) * 32, (r >> 5) * 64, false, scr, lane); continue; } r -= 512;
            p0_transpose_item(w_kv, 2048, WKV, (r & 63) * 32, (r >> 6) * 64, false, scr, lane);
        }
        {
            const f32x4* gr = (const f32x4*)norm_g + lane; f32x4 gg[4];
#pragma unroll
            for (int j = 0; j < 4; ++j) gg[j] = gr[64 * j];
            for (int m = gw; m < NTOK; m += 4 * NGW) {
                f32x4 v[4][4];
#pragma unroll
                for (int r = 0; r < 4; ++r) { const f32x4* xr = (const f32x4*)(x + (size_t)(m + r * NGW) * 1024) + lane;
#pragma unroll
                    for (int j = 0; j < 4; ++j) v[r][j] = __builtin_nontemporal_load(xr + 64 * j); }
#pragma unroll
                for (int r = 0; r < 4; ++r) {
                    float sq = 0.f;
#pragma unroll
                    for (int j = 0; j < 4; ++j) sq += (v[r][j][0] * v[r][j][0] + v[r][j][1] * v[r][j][1]) + (v[r][j][2] * v[r][j][2] + v[r][j][3] * v[r][j][3]);
                    const float rstd = 1.0f / sqrtf(wave_sum(sq) * (1.f / 1024.f) + EPS);
                    u32x2* o8 = (u32x2*)(U + (size_t)(m + r * NGW) * 1024) + lane;
#pragma unroll
                    for (int j = 0; j < 4; ++j) o8[64 * j] = pk4(v[r][j] * rstd * gg[j]);
                }
            }
        }
        for (int m = gw; m < 1024; m += NGW) rms_row_to_bf16(mem + (size_t)m * 1024, mem_norm_g, MEMN + (size_t)m * 1024, lane);
        for (int i = bx * 512 + tid; i < NTOK * 5; i += G * 512) ROWSS[i] = 0.f;
    }
    GRID_SYNC();

    {
        SchedP1 S{(const char*)U, (const char*)WIN, (const char*)MEMN, (const char*)WKV, G, bx};
        EpiP1 E{HA, GLU, SZB, SZX, Q, SGA, SGB, SGX, KB, VT, PAT, GAH, conv_a_w};
        gemm_phase(lds, 1024, 1024, 1024, S, E, widx);
    }
    GRID_SYNC();

    {
        int tid_ = tid_of(widx); asm volatile("" : "+v"(tid_)); const int tid = tid_;
        for (int i = bx * 512 + tid; i < 512 * 256; i += G * 512) {
            const int blk = i >> 8, ch = (i & 255) * 4;
            if ((blk & 127) != 0) {
                const f32x4 w0 = *(const f32x4*)(conv_a_w + ch), w1 = *(const f32x4*)(conv_a_w + 1024 + ch);
                const f32x4 pt0 = unpk4(*(const u32x2*)(PAT + (size_t)((blk - 1) * 2 + 0) * 1024 + ch)), pt1 = unpk4(*(const u32x2*)(PAT + (size_t)((blk - 1) * 2 + 1) * 1024 + ch));
                const f32x4 g0 = unpk4(*(const u32x2*)(GAH + (size_t)(blk * 2 + 0) * 1024 + ch)), g1 = unpk4(*(const u32x2*)(GAH + (size_t)(blk * 2 + 1) * 1024 + ch));
                u32x2* h0 = (u32x2*)(HA + (size_t)(blk * 64) * 1024 + ch); u32x2* h1 = (u32x2*)(HA + (size_t)(blk * 64 + 1) * 1024 + ch);
                *h0 = pk4(unpk4(*h0) + g0 * (w1 * pt1 + w0 * pt0));
                *h1 = pk4(unpk4(*h1) + g1 * (w0 * pt1));
            }
        }
        { SchedAttn S{(const char*)Q, (const char*)KB, TILE, (size_t)512, G, bx}; EpiS E{Q, RSUM}; gemm_phase(lds, 1024, 1024, 256, S, E, widx); }
        conv31_phase(lds, GLU, SZB, conv_b_w, conv_b_b, ln_b_g, ln_b_b, G, bx, widx);
    }
    asm volatile("s_waitcnt vmcnt(0) lgkmcnt(0)" ::: "memory"); __syncthreads();
    __builtin_amdgcn_fence(__ATOMIC_ACQUIRE, "agent"); asm volatile("s_waitcnt vmcnt(0)" ::: "memory"); __syncthreads();

    { SchedAttn S{(const char*)Q, (const char*)VT, (size_t)1024 * 256 * 2, (size_t)256 * 256 * 2, G, bx}; EpiPV E{SZX, U  , RSUM}; gemm_phase(lds, 1024, 256, 256, S, E, widx); }
    GRID_SYNC();

    { SchedOut S{(const char*)HA, (const char*)U, (const char*)WOUT, G, bx}; EpiOut E{SGA, SGB, SGX, MERGED}; gemm_phase(lds, 1024, 1024, 1024, S, E, widx); }
    GRID_SYNC();

    { SchedWo S{(const char*)MERGED, (const char*)WO, G, bx}; EpiWo E{x, HA  , ROWSS}; gemm_phase(lds, 1024, 1024, 1024, S, E, widx); }
    GRID_SYNC();

    {
        int tid_ = tid_of(widx); asm volatile("" : "+v"(tid_)); const int lane = tid_ & 63, w4 = tid_ >> 6, wr = w4 >> 2, wc = w4 & 3, fr = lane & 15, fq = lane >> 4;
        for (int L = bx; L < 512; L += G) {
            int pm, pn; remap_tile(L, 128, 4, pm, pn);
#pragma unroll
            for (int ai = 0; ai < 2; ++ai) {
                u32x2 hv[4][2][2]; float rs[4]; f32x4 gg[2][2];
#pragma unroll
                for (int m = 0; m < 4; ++m) {
                    rs[m] = ROWSS[pm * 256 + ai * 128 + wr * 64 + m * 16 + fr];
#pragma unroll
                    for (int bj = 0; bj < 2; ++bj)
#pragma unroll
                        for (int n = 0; n < 2; ++n) hv[m][bj][n] = ((const u32x2*)HA)[native_slot(pm, pn, w4, ai, m, bj, n, fq * 16 + fr)];
                }
#pragma unroll
                for (int bj = 0; bj < 2; ++bj)
#pragma unroll
                    for (int n = 0; n < 2; ++n) gg[bj][n] = *(const f32x4*)(final_g + pn * 256 + bj * 128 + wc * 32 + n * 16 + fq * 4);
#pragma unroll
                for (int m = 0; m < 4; ++m) {
                    const float rstd = 1.0f / sqrtf(rs[m] * (1.f / 1024.f) + EPS);
#pragma unroll
                    for (int bj = 0; bj < 2; ++bj)
#pragma unroll
                        for (int n = 0; n < 2; ++n)
                            *(f32x4*)(p.out + (size_t)(pm * 256 + ai * 128 + wr * 64 + m * 16 + fr) * 1024 + pn * 256 + bj * 128 + wc * 32 + n * 16 + fq * 4) = unpk4(hv[m][bj][n]) * rstd * gg[bj][n];
                }
            }
        }
    }
}

extern "C" void kernel_launch(void* const* d_in, const int* in_sizes, int n_in, void* d_out, int out_size, void* d_ws, size_t ws_size, hipStream_t stream) {
    static int grid_blocks = 0;
    if (!grid_blocks) {
        int dev = 0, cus = 0, per_cu = 0;
        hipGetDevice(&dev);
        hipDeviceGetAttribute(&cus, hipDeviceAttributeMultiprocessorCount, dev);
        hipFuncSetAttribute((const void*)fwd_megakernel, hipFuncAttributeMaxDynamicSharedMemorySize, LDS_BYTES);
        hipOccupancyMaxActiveBlocksPerMultiprocessor(&per_cu, (const void*)fwd_megakernel, 512, LDS_BYTES);
        if (per_cu < 1) { fprintf(stderr, "kernel_launch: occupancy query reports %d blocks per CU\n", per_cu); per_cu = 1; }
        if (per_cu > 1) per_cu = 1;
        grid_blocks = cus * per_cu;
        if (ws_size < WS_END) fprintf(stderr, "kernel_launch: workspace too small: %zu < %zu\n", ws_size, (size_t)WS_END);
    }
    (void)hipMemsetAsync((char*)d_ws + WS_BAR, 0, XCD_BAR_WORDS * 4, stream);
    if (ws_size < WS_END) return;
    Params p{};
    for (int i = 0; i < 16; ++i) p.in[i] = (const float*)d_in[i];
    p.out = (float*)d_out; p.ws = (unsigned char*)d_ws;
    void* args[] = {&p};
    hipError_t e = hipLaunchCooperativeKernel((const void*)fwd_megakernel, dim3(grid_blocks), dim3(512), args, LDS_BYTES, stream);
    if (e != hipSuccess) fprintf(stderr, "cooperative launch failed: %s (grid %d)\n", hipGetErrorString(e), grid_blocks);
}
```

```cpp
#include <hip/hip_runtime.h>
#include <cstdio>

#define LAS __attribute__((address_space(3)))
typedef unsigned short bf16_t;
typedef short bf16x8 __attribute__((ext_vector_type(8)));
typedef float f32x4 __attribute__((ext_vector_type(4)));
typedef float f32x2 __attribute__((ext_vector_type(2)));
typedef unsigned u32x4 __attribute__((ext_vector_type(4)));
typedef unsigned u32x2 __attribute__((ext_vector_type(2)));

constexpr int BM = 256, BK = 64, HALF = 128, HTB = HALF * BK * 2, STAGE_BYTES = 8 * HTB;
constexpr int LDS_BYTES = 147456;
constexpr int NTOK = 32768, DM = 1024, SEQ = 8192;
constexpr float EPS = 1e-6f;
constexpr size_t MiB = 1u << 20;
constexpr size_t TILE = (size_t)256 * 1024 * 2;
constexpr size_t WS_WIN = 0, WS_WOUT = 24 * MiB, WS_WO = 30 * MiB, WS_WKV = 32 * MiB, WS_MEMN = 36 * MiB, WS_KB = 38 * MiB, WS_VT = 40 * MiB;
constexpr size_t WS_ROWSS = 42 * MiB, WS_RSUM = 42 * MiB + 131072, WS_PAT = 43 * MiB, WS_GAH = 45 * MiB;
constexpr size_t WS_BAR = 47 * MiB;
constexpr size_t WS_HA = 48 * MiB, WS_SZB = 112 * MiB, WS_SZX = 176 * MiB, WS_GLU = 240 * MiB, WS_Q = 304 * MiB, WS_SGA = 368 * MiB, WS_SGB = 432 * MiB, WS_END = 496 * MiB;
constexpr size_t OUT_U = 0, OUT_SGX = 64 * MiB;

#define XB_TMO      128
#define XB_XCNT(j)  (256  + 64 * (j))
#define XB_XSUB(j)  (1280 + 64 * (j))
#define XB_XGEN(j)  (2304 + 64 * (j))
#define XB_TOP      3328
#define XB_TOPGEN   3392
#define XCD_BAR_WORDS 3456
#define XB_SPIN_CAP (1u << 18)

__device__ __forceinline__ unsigned xb_ld(unsigned* p)              { return __hip_atomic_load(p, __ATOMIC_RELAXED, __HIP_MEMORY_SCOPE_AGENT); }
__device__ __forceinline__ unsigned xb_add(unsigned* p, unsigned v) { return __hip_atomic_fetch_add(p, v, __ATOMIC_RELAXED, __HIP_MEMORY_SCOPE_AGENT); }
__device__ __forceinline__ unsigned xb_xcc_id() { return (unsigned)__builtin_amdgcn_s_getreg((3 << 11) | 20) & 0xFu; }
#define XB_SPIN(cond, bar) do { unsigned _sp = 0; while (cond) { __builtin_amdgcn_s_sleep(1); \
    if ((++_sp & 255u) == 0u) { if (xb_ld(&(bar)[XB_TMO])) break; if (_sp > XB_SPIN_CAP) { atomicAdd(&(bar)[XB_TMO], 1u); break; } } } } while (0)

struct XcdBarrier {
    unsigned* bar; unsigned x;
    volatile LAS unsigned* st;
};

__device__ __forceinline__ XcdBarrier xcd_barrier_post(unsigned* bar, volatile LAS unsigned* st, bool leader) {
    XcdBarrier b; b.bar = bar; b.x = xb_xcc_id(); b.st = st;
    if (leader) (void)xb_add(&bar[XB_XCNT(b.x)], 1u);
    return b;
}
__device__ __forceinline__ void xcd_barrier_complete(unsigned* bar, unsigned x, unsigned& nloc, unsigned& nx) {
    const unsigned G = gridDim.x * gridDim.y * gridDim.z;
    unsigned sum, cnt, mine, sp = 0u;
    for (;;) {
        sum = 0u; cnt = 0u; mine = 0u;
#pragma unroll
        for (unsigned j = 0; j < 16; ++j) { const unsigned c = xb_ld(&bar[XB_XCNT(j)]); sum += c; cnt += (c > 0u) ? 1u : 0u; mine = (j == x) ? c : mine; }
        if (sum == G) break;
        __builtin_amdgcn_s_sleep(1);
        if ((++sp & 255u) == 0u) { if (xb_ld(&bar[XB_TMO])) break; if (sp > XB_SPIN_CAP) { atomicAdd(&bar[XB_TMO], 1u); break; } }
    }
    nloc = mine > 0u ? mine : 1u; nx = cnt > 0u ? cnt : 1u;
}

__device__ __forceinline__ void xcd_barrier(const XcdBarrier& b, bool leader) {
    asm volatile("s_waitcnt vmcnt(0)" ::: "memory");
    __syncthreads();
    if (leader) {
        unsigned* bar = b.bar;
        __builtin_amdgcn_s_waitcnt(0);
        unsigned nloc = b.st[0], nx = b.st[1];
        if (nloc == 0u) { xcd_barrier_complete(bar, b.x, nloc, nx); b.st[0] = nloc; b.st[1] = nx; }
        const unsigned old = xb_add(&bar[XB_XSUB(b.x)], 1u);
        const unsigned gen = old / nloc;
        if (old + 1u == (gen + 1u) * nloc) {
            __builtin_amdgcn_fence(__ATOMIC_RELEASE, "agent");
            asm volatile("s_waitcnt vmcnt(0)" ::: "memory");
            const unsigned og = xb_add(&bar[XB_TOP], 1u);
            const unsigned tg = og / nx;
            if (og + 1u == (tg + 1u) * nx) xb_add(&bar[XB_TOPGEN], 1u);
            else XB_SPIN(xb_ld(&bar[XB_TOPGEN]) == tg, bar);
            __builtin_amdgcn_fence(__ATOMIC_ACQUIRE, "agent");
            xb_add(&bar[XB_XGEN(b.x)], 1u);
            asm volatile("s_waitcnt vmcnt(0)" ::: "memory");
        } else {
            XB_SPIN(xb_ld(&bar[XB_XGEN(b.x)]) == gen, bar);
            __builtin_amdgcn_fence(__ATOMIC_ACQUIRE, "agent");
            asm volatile("s_waitcnt vmcnt(0)" ::: "memory");
        }
    }
    __syncthreads();
}

#define GRID_SYNC() xcd_barrier(xb, tid_of(widx) == 0)

struct Params { const float* in[16]; float* out; unsigned char* ws; };

typedef __bf16 bf16x2_t __attribute__((ext_vector_type(2)));
__device__ __forceinline__ unsigned pk_bf16(float lo, float hi) { const f32x2 v = {lo, hi}; return __builtin_bit_cast(unsigned, __builtin_convertvector(v, bf16x2_t)); }
__device__ __forceinline__ float bf_lo(unsigned u) { return __uint_as_float(u << 16); }
__device__ __forceinline__ float bf_hi(unsigned u) { return __uint_as_float(u & 0xffff0000u); }
__device__ __forceinline__ float sigmoidf_(float x) { return __builtin_amdgcn_rcpf(1.0f + __builtin_amdgcn_exp2f(-1.44269504089f * x)); }
__device__ __forceinline__ float siluf_(float x) { return x * sigmoidf_(x); }
__device__ __forceinline__ u32x2 pk4(f32x4 v) { u32x2 r; r.x = pk_bf16(v[0], v[1]); r.y = pk_bf16(v[2], v[3]); return r; }
__device__ __forceinline__ f32x4 unpk4(u32x2 v) { return (f32x4){bf_lo(v.x), bf_hi(v.x), bf_lo(v.y), bf_hi(v.y)}; }
template <int CTRL> __device__ __forceinline__ float dppf(float old, float v) { return __int_as_float(__builtin_amdgcn_update_dpp(__float_as_int(old), __float_as_int(v), CTRL, 0xf, 0xf, false)); }
__device__ __forceinline__ float wave_sum(float v) {
#pragma unroll
    for (int o = 1; o < 64; o <<= 1) v += __shfl_xor(v, o);
    return v;
}

__device__ __forceinline__ int lds_byte(int r, int c) { const int st = (r >> 4) * 2 + (c >> 5), rr = r & 15, cc = c & 31, ob = rr * 64 + cc * 2; return st * 1024 + (ob ^ (((ob >> 9) & 1) << 5)); }
__device__ __forceinline__ void stage_rc(int b, int& R, int& C) { const int st = b / 1024, sb = b % 1024, swz = sb ^ (((sb >> 9) & 1) << 5); R = (st >> 1) * 16 + swz / 64; C = (st & 1) * 32 + (swz % 64) / 2; }

__device__ __forceinline__ int tid_of(int widx) { int l; asm volatile("v_mbcnt_lo_u32_b32 %0, -1, 0\n\tv_mbcnt_hi_u32_b32 %0, -1, %0" : "=v"(l)); return widx * 64 + l; }
struct Unit { const char* A; const char* B; int pm, pn, kind; };
__device__ __forceinline__ size_t native_slot(int pm, int pn4, int w4, int ai, int m, int bj, int n, int lane) {
    return ((((size_t)(pm * 4 + pn4) * 8 + w4) * 32 + (((ai * 4 + m) * 2 + bj) * 2 + n)) * 64 + lane);
}

template <int WG = 8> __device__ __forceinline__ void remap_tile(int L, int nM, int nN, int& pm, int& pn) {
    const int nwg = nM * nN; int wgid = L;
    { const int q = nwg / 8, r = nwg % 8, xcd = wgid % 8, off = wgid / 8; wgid = (xcd < r ? xcd * (q + 1) : r * (q + 1) + (xcd - r) * q) + off; }
    const int nig = WG * nN, gid = wgid / nig, fm = gid * WG, gsz = (nM - fm) < WG ? (nM - fm) : WG;
    pm = fm + ((wgid % nig) % gsz); pn = (wgid % nig) / gsz;
}

struct EpiOut;
template <class Epi> __device__ __forceinline__ bool epi_keeps(const Epi&, const Unit&) { return false; }
__device__ __forceinline__ bool epi_keeps(const EpiOut&, const Unit& u) { return u.kind < 2; }
template <class Epi, class Sched>
__device__ __forceinline__ void gemm_phase(LAS unsigned char* lds, const int lda, const int ldb, const int K, const Sched& S, const Epi& E, const int widx) {
    int tid_ = tid_of(widx); asm volatile("" : "+v"(tid_));
    const int tid = tid_, wid = __builtin_amdgcn_readfirstlane(tid >> 6), lane = tid & 63, wr = wid >> 2, wc = wid & 3, fr = lane & 15, fq = lane >> 4;
    const int nt = K / BK;
    unsigned voffA[2], voffB[2];
#pragma unroll
    for (int i = 0; i < 2; ++i) { int R, C; stage_rc(tid * 16 + i * 8192, R, C); voffA[i] = (unsigned)(R * lda + C) * 2u; voffB[i] = (unsigned)(R * ldb + C) * 2u; }
    const size_t kstep = (size_t)(BK * 2);
    const size_t hstepA = (size_t)HALF * lda * 2, hstepB = (size_t)HALF * ldb * 2;
    const unsigned ldsw = (unsigned)wid * 1024u;
    const int aoff = lds_byte(wr * 64 + fr, fq * 8), boff = lds_byte(wc * 32 + fr, fq * 8);
#define GP_SA(b, h) (((b) * 2 + (h)) * HTB)
#define GP_SB(b, h) ((4 + (b) * 2 + (h)) * HTB)
#define GP_STAGE(bufoff, gbase, voff) do { _Pragma("unroll") for (int _i = 0; _i < 2; ++_i) \
        __builtin_amdgcn_global_load_lds((const unsigned*)((const char*)(gbase) + (voff)[_i]), (LAS unsigned*)(lds + (bufoff) + ldsw + _i * 8192), 16, 0, 0); } while (0)
#define GP_LDA(dst, b, h) do { _Pragma("unroll") for (int m = 0; m < 4; ++m) _Pragma("unroll") for (int k = 0; k < 2; ++k) dst[m][k] = *(const LAS bf16x8*)(lds + GP_SA(b, h) + aoff + m * 2048 + k * 1024); } while (0)
#define GP_LDB(dst, b, h) do { _Pragma("unroll") for (int n = 0; n < 2; ++n) _Pragma("unroll") for (int k = 0; k < 2; ++k) dst[n][k] = *(const LAS bf16x8*)(lds + GP_SB(b, h) + boff + n * 2048 + k * 1024); } while (0)
#define GP_MMA(ai, bj, At, Bt) do { __builtin_amdgcn_s_setprio(1); _Pragma("unroll") for (int m = 0; m < 4; ++m) _Pragma("unroll") for (int n = 0; n < 2; ++n) _Pragma("unroll") for (int k = 0; k < 2; ++k) \
        acc[ai][bj][m][n] = __builtin_amdgcn_mfma_f32_16x16x32_bf16(Bt[n][k], At[m][k], acc[ai][bj][m][n], 0, 0, 0); __builtin_amdgcn_s_setprio(0); } while (0)
#define GP_WAIT_V(n) asm volatile("s_waitcnt vmcnt(" #n ")" ::: "memory")
#define GP_WAIT_L(n) asm volatile("s_waitcnt lgkmcnt(" #n ")" ::: "memory")
#define GP_BAR __builtin_amdgcn_s_barrier()
#define GP_SCHED __builtin_amdgcn_sched_barrier(0)
    Unit cur, nxt; int ui = 0;
    if (!S.next(0, cur)) return;
    f32x4 acc[2][2][4][2];
#pragma unroll
    for (int a = 0; a < 2; ++a)
#pragma unroll
        for (int b = 0; b < 2; ++b)
#pragma unroll
            for (int m = 0; m < 4; ++m)
#pragma unroll
                for (int n = 0; n < 2; ++n) acc[a][b][m][n] = (f32x4){0.f, 0.f, 0.f, 0.f};
    bf16x8 At[4][2], B0[2][2], B1[2][2];
    const char* cA = cur.A; const char* cB = cur.B;
    GP_STAGE(GP_SB(0, 0), cB, voffB); GP_STAGE(GP_SB(0, 1), cB + hstepB, voffB); GP_STAGE(GP_SA(0, 0), cA, voffA); GP_STAGE(GP_SA(0, 1), cA + hstepA, voffA);
    if (wr == 1) GP_BAR;
    GP_WAIT_V(2); GP_BAR;
    GP_STAGE(GP_SB(1, 0), cB + kstep, voffB); GP_STAGE(GP_SA(1, 0), cA + kstep, voffA); GP_STAGE(GP_SB(1, 1), cB + hstepB + kstep, voffB);
    GP_WAIT_V(6); GP_BAR;
    for (;;) {
        const bool has_next = S.next(ui + 1, nxt);
        const char* nA = has_next ? nxt.A : cA; const char* nB = has_next ? nxt.B : cB;
        for (int t = 0; t < nt; t += 2) {
            const bool last = (t == nt - 2);
            const char* a1 = cA + (size_t)(t + 1) * kstep;
            const char* a2 = last ? nA : cA + (size_t)(t + 2) * kstep; const char* b2 = last ? nB : cB + (size_t)(t + 2) * kstep;
            const char* a3 = a2 + kstep; const char* b3 = b2 + kstep;
            GP_LDB(B0, 0, 0); GP_LDB(B1, 0, 1); GP_SCHED; GP_LDA(At, 0, 0); GP_STAGE(GP_SA(1, 1), a1 + hstepA, voffA);
            GP_WAIT_V(8); GP_WAIT_L(0); GP_BAR; GP_MMA(0, 0, At, B0); GP_MMA(0, 1, At, B1); GP_BAR; GP_SCHED;
            GP_LDA(At, 0, 1); GP_STAGE(GP_SB(0, 0), b2, voffB); GP_STAGE(GP_SB(0, 1), b2 + hstepB, voffB); GP_STAGE(GP_SA(0, 0), a2, voffA);
            GP_WAIT_V(8); GP_WAIT_L(0); GP_BAR; GP_MMA(1, 0, At, B0); GP_MMA(1, 1, At, B1); GP_BAR; GP_SCHED;
            GP_LDB(B0, 1, 0); GP_LDB(B1, 1, 1); GP_SCHED; GP_LDA(At, 1, 0); GP_STAGE(GP_SA(0, 1), a2 + hstepA, voffA);
            GP_WAIT_V(8); GP_WAIT_L(0); GP_BAR; GP_MMA(0, 0, At, B0); GP_MMA(0, 1, At, B1); GP_BAR; GP_SCHED;
            GP_LDA(At, 1, 1); GP_STAGE(GP_SB(1, 0), b3, voffB); GP_STAGE(GP_SB(1, 1), b3 + hstepB, voffB); GP_STAGE(GP_SA(1, 0), a3, voffA);
            GP_WAIT_V(8); GP_WAIT_L(0); GP_BAR; GP_MMA(1, 0, At, B0); GP_MMA(1, 1, At, B1); GP_BAR; GP_SCHED;
        }
        if (wr == 0) GP_BAR;
        E(acc, cur, wr, wc, fr, fq);
        if (!has_next) break;
        if (!epi_keeps(E, cur)) {
#pragma unroll
        for (int a = 0; a < 2; ++a)
#pragma unroll
            for (int b = 0; b < 2; ++b)
#pragma unroll
                for (int m = 0; m < 4; ++m)
#pragma unroll
                    for (int n = 0; n < 2; ++n) acc[a][b][m][n] = (f32x4){0.f, 0.f, 0.f, 0.f};
        }
        cur = nxt; cA = nA; cB = nB; ++ui;
        if (wr == 1) GP_BAR;
    }
    GP_WAIT_V(0);
    GP_BAR;
#undef GP_SA
#undef GP_SB
#undef GP_STAGE
#undef GP_LDA
#undef GP_LDB
#undef GP_MMA
#undef GP_WAIT_V
#undef GP_WAIT_L
#undef GP_BAR
#undef GP_SCHED
}

struct SchedP1 {
    const char *U, *Win, *Memn, *Wkv; int G, c;
    __device__ __forceinline__ bool next(int i, Unit& u) const {
        if (G == 256) {
            if (i < 24) { const int l = i * 32 + (c >> 3); int pm = l / 6, pn = 6 * (c & 7) + l % 6; pn = (pn % 3) * 16 + pn / 3;
                u.pm = pm; u.pn = pn; u.kind = pn >> 4; u.A = U + (size_t)pm * TILE; u.B = Win + (size_t)pn * TILE; return true; }
            if (i > 24 || c >= 32) return false;
            int L = c;
            if (L < 16) { u.pm = L >> 2; u.pn = L & 3; u.kind = 3; u.A = Memn + (size_t)u.pm * TILE; u.B = Wkv + (size_t)u.pn * TILE; }
            else { L -= 16; u.pm = L >> 2; u.pn = L & 3; u.kind = 4; u.A = Wkv + (size_t)(4 + u.pm) * TILE; u.B = Memn + (size_t)u.pn * TILE; }
            return true;
        }
        int L = i * G + c;
        if (L < 6144) { int pm, pn; remap_tile<4>(L, 128, 48, pm, pn); pn = (pn % 3) * 16 + pn / 3; u.pm = pm; u.pn = pn; u.kind = pn >> 4; u.A = U + (size_t)pm * TILE; u.B = Win + (size_t)pn * TILE; return true; }
        L -= 6144; if (L >= 32) return false;
        if (L < 16) { u.pm = L >> 2; u.pn = L & 3; u.kind = 3; u.A = Memn + (size_t)u.pm * TILE; u.B = Wkv + (size_t)u.pn * TILE; }
        else { L -= 16; u.pm = L >> 2; u.pn = L & 3; u.kind = 4; u.A = Wkv + (size_t)(4 + u.pm) * TILE; u.B = Memn + (size_t)u.pn * TILE; }
        return true;
    }
};
struct SchedAttn {
    const char *Aq, *Bm; size_t bstride_b, bstride_h; int G, c;
    __device__ __forceinline__ bool next(int i, Unit& u) const {
        const int L = i * G + c; if (L >= 512) return false;
        u.pm = L >> 2; u.pn = L & 3; u.kind = 0;
        u.A = Aq + (size_t)u.pm * TILE + (size_t)u.pn * 512; u.B = Bm + (size_t)(u.pm >> 5) * bstride_b + (size_t)u.pn * bstride_h; return true;
    }
};
struct SchedOut {
    const char *H, *HXp, *W; int G, c;
    __device__ __forceinline__ bool next(int i, Unit& u) const {
        const int ti = i / 3, g = i - 3 * ti; const int L = ti * G + c; if (L >= 512) return false;
        int pm, pn; remap_tile(L, 128, 4, pm, pn); u.pm = pm; u.pn = pn; u.kind = g;
        if (g == 2) u.A = HXp + (size_t)pm * TILE; else u.A = H + ((size_t)g * 128 + pm) * TILE;
        u.B = W + ((size_t)g * 4 + pn) * TILE; return true;
    }
};
struct SchedWo {
    const char *A, *W; int G, c;
    __device__ __forceinline__ bool next(int i, Unit& u) const {
        const int L = i * G + c; if (L >= 512) return false;
        int pm, pn; remap_tile(L, 128, 4, pm, pn); u.pm = pm; u.pn = pn; u.kind = 0; u.A = A + (size_t)pm * TILE; u.B = W + (size_t)pn * TILE; return true;
    }
};

__device__ __forceinline__ int pf(int fq) { return (fq >> 1) | ((fq & 1) << 1); }
__device__ __forceinline__ void store_pair16(bf16_t* rowbase  , u32x2 a  , u32x2 b  , int fq) {
    const auto rx = __builtin_amdgcn_permlane32_swap(a.x, b.x, false, false), ry = __builtin_amdgcn_permlane32_swap(a.y, b.y, false, false);
    *(u32x4*)(rowbase + (size_t)((fq >> 1) * 16) * 1024 + (fq & 1) * 8) = (u32x4){rx[0], ry[0], rx[1], ry[1]};
}
struct EpiP1 {
    bf16_t *HA, *GLU, *SZB, *SZX, *Q, *SGA, *SGB, *SGX, *KB, *VT, *PAT, *GAH; const float* convw;
    __device__ __forceinline__ void operator()(const f32x4 (&acc)[2][2][4][2], const Unit& u, int wr, int wc, int fr, int fq) const {
        if (u.kind <= 2) {
            const int chw = (u.pn & 15) * 64 + wc * 16, ch = chw + pf(fq) * 4;
            const int rowb = u.pm * 256 + wr * 64 + fr;
            if (u.kind == 0) {
                const f32x4 w0 = *(const f32x4*)(convw + ch), w1 = *(const f32x4*)(convw + 1024 + ch), w2 = *(const f32x4*)(convw + 2048 + ch);
#pragma unroll
                for (int ai = 0; ai < 2; ++ai) {
                    const int blk = u.pm * 4 + ai * 2 + wr;
                    f32x4 pprev = (f32x4){0.f, 0.f, 0.f, 0.f}; u32x2 hv[4];
#pragma unroll
                    for (int m = 0; m < 4; ++m) {
                        const f32x4 Bv = acc[ai][0][m][0], Cv = acc[ai][0][m][1], Xv = acc[ai][1][m][0], Zv = acc[ai][1][m][1];
                        const f32x4 p = Cv * Xv; f32x4 ga, p1, p2;
#pragma unroll
                        for (int j = 0; j < 4; ++j) {
                            ga[j] = siluf_(Zv[j]) * Bv[j];
                            const float r1 = (m > 0) ? dppf<0x121>(0.f, pprev[j]) : 0.f, r2 = (m > 0) ? dppf<0x122>(0.f, pprev[j]) : 0.f;
                            p1[j] = dppf<0x111>(r1, p[j]); p2[j] = dppf<0x112>(r2, p[j]);
                        }
                        const f32x4 cv = w2 * p + w1 * p1 + w0 * p2;
                        hv[m] = pk4(ga * cv);
                        if (m == 3 && fr >= 14) *(u32x2*)(PAT + (size_t)(blk * 2 + (fr - 14)) * 1024 + ch) = pk4(p);
                        if (m == 0 && fr < 2) *(u32x2*)(GAH + (size_t)(blk * 2 + fr) * 1024 + ch) = pk4(ga);
                        pprev = p;
                    }
#pragma unroll
                    for (int pr = 0; pr < 2; ++pr) store_pair16(HA + (size_t)(rowb + ai * 128 + pr * 32) * 1024 + chw, hv[2 * pr], hv[2 * pr + 1], fq);
                }
            } else if (u.kind == 1) {
#pragma unroll
                for (int ai = 0; ai < 2; ++ai) {
                    u32x2 gv[4], zv[4];
#pragma unroll
                    for (int m = 0; m < 4; ++m) {
                        const f32x4 Vv = acc[ai][0][m][0], Gv = acc[ai][0][m][1], Zb = acc[ai][1][m][0], Zx = acc[ai][1][m][1]; f32x4 o0, o1, o2;
#pragma unroll
                        for (int j = 0; j < 4; ++j) { o0[j] = Vv[j] * sigmoidf_(Gv[j]); o1[j] = siluf_(Zb[j]); o2[j] = siluf_(Zx[j]); }
                        gv[m] = pk4(o0); zv[m] = pk4(o1);
                        { const int c = (u.pn & 3) * 64 + wc * 16;
                          __builtin_nontemporal_store(pk4(o2), (u32x2*)SZX + native_slot(u.pm, (u.pn & 15) >> 2, wr * 4 + ((c >> 5) & 3), ai, m, c >> 7, (c >> 4) & 1, pf(fq) * 16 + fr)); }
                    }
#pragma unroll
                    for (int pr = 0; pr < 2; ++pr) {
                        store_pair16(GLU + (size_t)(rowb + ai * 128 + pr * 32) * 1024 + chw, gv[2 * pr], gv[2 * pr + 1], fq);
                        store_pair16(SZB + (size_t)(rowb + ai * 128 + pr * 32) * 1024 + chw, zv[2 * pr], zv[2 * pr + 1], fq);
                    }
                }
            } else {
#pragma unroll
                for (int ai = 0; ai < 2; ++ai) {
                    u32x2 qv[4];
#pragma unroll
                    for (int m = 0; m < 4; ++m) {
                        const f32x4 Qv = acc[ai][0][m][0], Ga = acc[ai][0][m][1], Gb = acc[ai][1][m][0], Gx = acc[ai][1][m][1]; f32x4 o1, o2, o3;
#pragma unroll
                        for (int j = 0; j < 4; ++j) { const float sa = sigmoidf_(Ga[j]), sb = sigmoidf_(Gb[j]), sx = sigmoidf_(Gx[j]);
                            o1[j] = sa * __builtin_amdgcn_rcpf(fmaxf(sb, 1e-30f)); o2[j] = sb * __builtin_amdgcn_rcpf(fmaxf(sx, 1e-30f)); o3[j] = sx; }
                        qv[m] = pk4(Qv * 0.0625f);
                        const int c = (u.pn & 3) * 64 + wc * 16;
                        const size_t ns = native_slot(u.pm, (u.pn & 15) >> 2, wr * 4 + ((c >> 5) & 3), ai, m, c >> 7, (c >> 4) & 1, pf(fq) * 16 + fr);
                        __builtin_nontemporal_store(pk4(o1), (u32x2*)SGA + ns); __builtin_nontemporal_store(pk4(o2), (u32x2*)SGB + ns); __builtin_nontemporal_store(pk4(o3), (u32x2*)SGX + ns);
                    }
#pragma unroll
                    for (int pr = 0; pr < 2; ++pr) store_pair16(Q + (size_t)(rowb + ai * 128 + pr * 32) * 1024 + chw, qv[2 * pr], qv[2 * pr + 1], fq);
                }
            }
        } else {
            const int r0 = wr * 64 + fr, c0 = wc * 32 + fq * 4;
#pragma unroll
            for (int ai = 0; ai < 2; ++ai)
#pragma unroll
                for (int m = 0; m < 4; ++m)
#pragma unroll
                    for (int bj = 0; bj < 2; ++bj)
#pragma unroll
                        for (int n = 0; n < 2; ++n) {
                            const int r = r0 + ai * 128 + m * 16, c = c0 + bj * 128 + n * 16;
                            if (u.kind == 3) *(u32x2*)(KB + (size_t)(u.pm * 256 + r) * 1024 + u.pn * 256 + c) = pk4(acc[ai][bj][m][n]);
                            else             *(u32x2*)(VT + ((size_t)u.pn * 1024 + u.pm * 256 + r) * 256 + c) = pk4(acc[ai][bj][m][n]);
                        }
        }
    }
};
struct EpiS {
    bf16_t* Q; float* RSUM;
    __device__ __forceinline__ void operator()(const f32x4 (&acc)[2][2][4][2], const Unit& u, int wr, int wc, int fr, int fq) const {
#pragma unroll
        for (int ai = 0; ai < 2; ++ai)
#pragma unroll
            for (int m = 0; m < 4; ++m) {
                const int row = u.pm * 256 + ai * 128 + wr * 64 + m * 16 + fr; float rs = 0.f;
#pragma unroll
                for (int bj = 0; bj < 2; ++bj)
#pragma unroll
                    for (int n = 0; n < 2; ++n) {
                        const f32x4 s = acc[ai][bj][m][n]; f32x4 e;
#pragma unroll
                        for (int j = 0; j < 4; ++j) e[j] = __builtin_amdgcn_exp2f(1.44269504089f * s[j]);
                        const u32x2 w = pk4(e); const f32x4 er = unpk4(w); rs += (er[0] + er[1]) + (er[2] + er[3]);
                        *(u32x2*)(Q + (size_t)row * 1024 + u.pn * 256 + bj * 128 + wc * 32 + n * 16 + fq * 4) = w;
                    }
                rs += __shfl_xor(rs, 16); rs += __shfl_xor(rs, 32);
                if (fq == 0) unsafeAtomicAdd(RSUM + row * 4 + u.pn, rs);
            }
    }
};
struct EpiPV {
    const bf16_t* SZXN; bf16_t* HX; const float* RSUM;
    __device__ __forceinline__ void operator()(const f32x4 (&acc)[2][2][4][2], const Unit& u, int wr, int wc, int fr_in, int fq_in) const {
        int fr = fr_in, fq = fq_in; asm volatile("" : "+v"(fr), "+v"(fq));
        const int w4 = wr * 4 + wc, lane = fq * 16 + fr;
#pragma unroll
        for (int ai = 0; ai < 2; ++ai) {
            u32x2 z[4][2][2]; float rs[4];
#pragma unroll
            for (int m = 0; m < 4; ++m) {
                rs[m] = RSUM[(u.pm * 256 + ai * 128 + wr * 64 + m * 16 + fr) * 4 + u.pn];
#pragma unroll
                for (int bj = 0; bj < 2; ++bj)
#pragma unroll
                    for (int n = 0; n < 2; ++n) z[m][bj][n] = __builtin_nontemporal_load((const u32x2*)SZXN + native_slot(u.pm, u.pn, w4, ai, m, bj, n, lane));
            }
#pragma unroll
            for (int m = 0; m < 4; ++m) {
                const int row = u.pm * 256 + ai * 128 + wr * 64 + m * 16 + fr; const float inv = __builtin_amdgcn_rcpf(rs[m]);
#pragma unroll
                for (int bj = 0; bj < 2; ++bj)
#pragma unroll
                    for (int n = 0; n < 2; ++n)
                        *(u32x2*)(HX + (size_t)row * 1024 + u.pn * 256 + bj * 128 + wc * 32 + n * 16 + fq * 4) = pk4(unpk4(z[m][bj][n]) * (acc[ai][bj][m][n] * inv));
            }
        }
    }
};
__device__ __forceinline__ void ld8(u32x2 (&d)[8], const u32x2* p) {
    asm volatile("global_load_dwordx2 %0, %1, off"             : "=v"(d[0]) : "v"(p) : "memory");
    asm volatile("global_load_dwordx2 %0, %1, off offset:512"  : "=v"(d[1]) : "v"(p) : "memory");
    asm volatile("global_load_dwordx2 %0, %1, off offset:1024" : "=v"(d[2]) : "v"(p) : "memory");
    asm volatile("global_load_dwordx2 %0, %1, off offset:1536" : "=v"(d[3]) : "v"(p) : "memory");
    asm volatile("global_load_dwordx2 %0, %1, off offset:2048" : "=v"(d[4]) : "v"(p) : "memory");
    asm volatile("global_load_dwordx2 %0, %1, off offset:2560" : "=v"(d[5]) : "v"(p) : "memory");
    asm volatile("global_load_dwordx2 %0, %1, off offset:3072" : "=v"(d[6]) : "v"(p) : "memory");
    asm volatile("global_load_dwordx2 %0, %1, off offset:3584" : "=v"(d[7]) : "v"(p) : "memory");
}
__device__ __forceinline__ void ld4(u32x2 (&d)[4], const u32x2* p) {
    asm volatile("global_load_dwordx2 %0, %1, off nt"          : "=v"(d[0]) : "v"(p) : "memory");
    asm volatile("global_load_dwordx2 %0, %1, off offset:512 nt" : "=v"(d[1]) : "v"(p) : "memory");
    asm volatile("global_load_dwordx2 %0, %1, off offset:1024 nt" : "=v"(d[2]) : "v"(p) : "memory");
    asm volatile("global_load_dwordx2 %0, %1, off offset:1536 nt" : "=v"(d[3]) : "v"(p) : "memory");
}
__device__ __forceinline__ void tie4(u32x2 (&d)[4]) { asm volatile("" : "+v"(d[0]), "+v"(d[1]), "+v"(d[2]), "+v"(d[3])); }
__device__ __forceinline__ void tie8(u32x2 (&d)[8]) { asm volatile("" : "+v"(d[0]), "+v"(d[1]), "+v"(d[2]), "+v"(d[3]), "+v"(d[4]), "+v"(d[5]), "+v"(d[6]), "+v"(d[7])); }

struct EpiOut {
    const bf16_t *F1, *F2, *F3; bf16_t* MERGED;
    template <int POS> __device__ __forceinline__ void run(f32x4 (&acc)[2][2][4][2], const Unit& u, const bf16_t* F, int wr, int wc, int fr, int fq) const {
        const int w4 = wr * 4 + wc, lane = fq * 16 + fr;
        const u32x2* s0 = (const u32x2*)F + native_slot(u.pm, u.pn, w4, 0, 0, 0, 0, lane);
        u32x2 ga[2][4];
        ld4(ga[0], s0); ld4(ga[1], s0 + 256);
#pragma unroll
        for (int e = 0; e < 8; ++e) {
            if (POS < 2) { if (e < 7) asm volatile("s_waitcnt vmcnt(4)" ::: "memory"); else asm volatile("s_waitcnt vmcnt(0)" ::: "memory"); }
            else { if (e == 0) asm volatile("s_waitcnt vmcnt(4)" ::: "memory"); else if (e < 7) asm volatile("s_waitcnt vmcnt(8)" ::: "memory"); else asm volatile("s_waitcnt vmcnt(4)" ::: "memory"); }
            tie4(ga[e & 1]);
            const int ai = e >> 2, m = e & 3;
#pragma unroll
            for (int k = 0; k < 4; ++k) { const int bj = k >> 1, n = k & 1;
                const f32x4 f = unpk4(ga[e & 1][k]);
                if (POS < 2) acc[ai][bj][m][n] *= f;
                else *(u32x2*)(MERGED + (size_t)(u.pm * 256 + ai * 128 + wr * 64 + m * 16 + fr) * 1024 + u.pn * 256 + bj * 128 + wc * 32 + n * 16 + fq * 4) = pk4(f * acc[ai][bj][m][n]);
            }
            if (e + 2 < 8) ld4(ga[e & 1], s0 + (e + 2) * 256);
        }
    }
    __device__ __forceinline__ void operator()(f32x4 (&acc)[2][2][4][2], const Unit& u, int wr, int wc, int fr, int fq) const {
        if (u.kind < 2) run<0>(acc, u, F1 + ((size_t)u.kind << 25)  , wr, wc, fr, fq);
        else run<2>(acc, u, F3, wr, wc, fr, fq);
    }
};
struct EpiWo {
    const float* X; bf16_t* HN; float* ROWSS;
    __device__ __forceinline__ void operator()(const f32x4 (&acc)[2][2][4][2], const Unit& u, int wr, int wc, int fr, int fq) const {
        const int w4 = wr * 4 + wc, lane = fq * 16 + fr;
#pragma unroll
        for (int ai = 0; ai < 2; ++ai) {
            f32x4 xv[4][2][2];
#pragma unroll
            for (int m = 0; m < 4; ++m)
#pragma unroll
                for (int bj = 0; bj < 2; ++bj)
#pragma unroll
                    for (int n = 0; n < 2; ++n)
                        xv[m][bj][n] = __builtin_nontemporal_load((const f32x4*)(X + (size_t)(u.pm * 256 + ai * 128 + wr * 64 + m * 16 + fr) * 1024 + u.pn * 256 + bj * 128 + wc * 32 + n * 16 + fq * 4));
#pragma unroll
            for (int m = 0; m < 4; ++m) {
                const int row = u.pm * 256 + ai * 128 + wr * 64 + m * 16 + fr; float ss = 0.f;
#pragma unroll
                for (int bj = 0; bj < 2; ++bj)
#pragma unroll
                    for (int n = 0; n < 2; ++n) {
                        const u32x2 hw = pk4(xv[m][bj][n] + acc[ai][bj][m][n]); const f32x4 h = unpk4(hw);
                        ((u32x2*)HN)[native_slot(u.pm, u.pn, w4, ai, m, bj, n, lane)] = hw; ss += (h[0] * h[0] + h[1] * h[1]) + (h[2] * h[2] + h[3] * h[3]);
                    }
                ss += __shfl_xor(ss, 16); ss += __shfl_xor(ss, 32);
                if (fq == 0) unsafeAtomicAdd(ROWSS + row, ss);
            }
        }
    }
};

__device__ __forceinline__ int win_src_col(int R) {
    const int unit = R >> 8, rho = R & 255, kind = unit >> 4, cu = unit & 15;
    const int fqb = (rho >> 2) & 3;
    const int gi = ((rho >> 7) & 1) * 2 + ((rho >> 4) & 1), chl = ((rho >> 5) & 3) * 16 + (((fqb >> 1) | ((fqb & 1) << 1)) << 2) + (rho & 3);
    int base;
    if (kind == 0) base = gi * 1024;
    else if (kind == 1) base = (gi < 3) ? 4096 + gi * 1024 : 8192;
    else base = (gi == 0) ? 7168 : 9216 + (gi - 1) * 1024;
    return base + cu * 64 + chl;
}
__device__ __forceinline__ void p0_transpose_item(const float* W, int ldw, bf16_t* WT, int dst_row0, int k0, bool perm, LAS float* scr, int lane) {
    const int li = lane & 31; const int drow = dst_row0 + (perm ? ((li & 15) + ((li >> 4) << 5)) : li); const int scol = perm ? win_src_col(drow) : drow;
#pragma unroll
    for (int i = 0; i < 32; ++i) { const int kk = 2 * i + (lane >> 5); scr[kk * 33 + (lane & 31)] = __builtin_nontemporal_load(W + (size_t)(k0 + kk) * ldw + scol); }
    asm volatile("s_waitcnt lgkmcnt(0)" ::: "memory");
    const int c = lane & 7;
#pragma unroll
    for (int j = 0; j < 4; ++j) { const int n = (lane >> 3) + 8 * j; const LAS float* s = scr + (8 * c) * 33 + n;
        u32x4 o; o.x = pk_bf16(s[0 * 33], s[1 * 33]); o.y = pk_bf16(s[2 * 33], s[3 * 33]); o.z = pk_bf16(s[4 * 33], s[5 * 33]); o.w = pk_bf16(s[6 * 33], s[7 * 33]);
        const int orow = dst_row0 + (perm ? ((n & 15) + ((n >> 4) << 5)) : n);
        *(u32x4*)(WT + (size_t)orow * 1024 + k0 + 8 * c) = o; }
    asm volatile("s_waitcnt lgkmcnt(0)" ::: "memory");
}
__device__ __forceinline__ void rms_row_to_bf16(const float* xrow, const float* g, bf16_t* orow, int lane) {
    const f32x4* xr = (const f32x4*)xrow + lane; const f32x4* gr = (const f32x4*)g + lane;
    f32x4 v[4]; float s = 0.f;
#pragma unroll
    for (int j = 0; j < 4; ++j) { v[j] = xr[64 * j]; s += (v[j][0] * v[j][0] + v[j][1] * v[j][1]) + (v[j][2] * v[j][2] + v[j][3] * v[j][3]); }
    const float rstd = 1.0f / sqrtf(wave_sum(s) * (1.f / 1024.f) + EPS);
    u32x2* o8 = (u32x2*)orow + lane;
#pragma unroll
    for (int j = 0; j < 4; ++j) { const f32x4 gg = gr[64 * j]; o8[64 * j] = pk4(v[j] * rstd * gg); }
}

template <int PH>
__device__ __forceinline__ void conv31_chunk(LAS unsigned char* lds, LAS float* red, LAS float* stats, const bf16_t* GLU, bf16_t* SZB, const float* cw, const float* cb, const float* lng, const float* lnb,
                                            const int t0, const bool has_next, const int tid_in) {
    int tid_o = tid_in; asm volatile("" : "+v"(tid_o));
    const int tid = tid_o, lane = tid & 63, wid = tid >> 6, c2 = tid * 2;
    u32x4 nx[4];
    if (has_next) {
        int tf = tid; asm volatile("" : "+v"(tf));
#pragma unroll
        for (int q = 0; q < 4; ++q) { const int i = tf + q * 512; nx[q] = __builtin_nontemporal_load((const u32x4*)(GLU + (size_t)(t0 + 16 + (i >> 7)) * 1024 + (i & 127) * 8)); }
    }
    const f32x2 bias = *(const f32x2*)(cb + c2);
    f32x2 outv[16];
#pragma unroll
    for (int t = 0; t < 16; ++t) outv[t] = bias;
#pragma unroll
    for (int ps = 0; ps < 2; ++ps) {
        const int kb = ps * 16, ntap = ps == 0 ? 16 : 15;
        f32x2 w[16];
#pragma unroll
        for (int k = 0; k < 16; ++k) if (k < ntap) w[k] = *(const f32x2*)(cw + (kb + k) * 1024 + c2);
#pragma unroll
        for (int r = 0; r < 31; ++r) if (r < ntap + 15) {
            const unsigned v = *(const LAS unsigned*)(lds + ((34 + 16 * PH + kb + r) & 63) * 2048 + tid * 4);
            const f32x2 x = (f32x2){bf_lo(v), bf_hi(v)};
#pragma unroll
            for (int t = 0; t < 16; ++t) { const int k = r - t; if (k >= 0 && k < ntap) outv[t] = __builtin_elementwise_fma(w[k], x, outv[t]); }
            if ((r & 7) == 7) asm volatile("" ::: "memory");
        }
    }
    {
        float s[16], q[16];
#pragma unroll
        for (int t = 0; t < 16; ++t) { s[t] = outv[t][0] + outv[t][1]; q[t] = outv[t][0] * outv[t][0] + outv[t][1] * outv[t][1]; }
#pragma unroll
        for (int lvl = 0; lvl < 4; ++lvl) {
            const int half = 8 >> lvl, off = 32 >> lvl; const bool hi = (lane & off) != 0;
#pragma unroll
            for (int i = 0; i < half; ++i) {
                const float ks = hi ? s[i + half] : s[i], ss = hi ? s[i] : s[i + half]; s[i] = ks + __shfl_xor(ss, off);
                const float kq = hi ? q[i + half] : q[i], sq = hi ? q[i] : q[i + half]; q[i] = kq + __shfl_xor(sq, off);
            }
        }
        s[0] += __shfl_xor(s[0], 2); q[0] += __shfl_xor(q[0], 2);
        s[0] += __shfl_xor(s[0], 1); q[0] += __shfl_xor(q[0], 1);
        if ((lane & 3) == 0) *(LAS f32x2*)(red + ((lane >> 2) * 8 + wid) * 2) = (f32x2){s[0], q[0]};
    }
    __syncthreads();
    if (has_next) {
#pragma unroll
        for (int q = 0; q < 4; ++q) { const int i = tid + q * 512; *(LAS u32x4*)(lds + ((34 + 16 * PH + 46 + (i >> 7)) & 63) * 2048 + (i & 127) * 16) = nx[q]; }
    }
    if (tid < 16) {
        float S = 0.f, Q2 = 0.f;
#pragma unroll
        for (int wv = 0; wv < 8; ++wv) { const f32x2 t = *(const LAS f32x2*)(red + (tid * 8 + wv) * 2); S += t[0]; Q2 += t[1]; }
        const float mean = S * (1.f / 1024.f), var = fmaxf(Q2 * (1.f / 1024.f) - mean * mean, 0.f);
        *(LAS f32x2*)(stats + tid * 2) = (f32x2){mean, 1.0f / sqrtf(var + EPS)};
    }
    __syncthreads();
    const f32x2 lg = *(const f32x2*)(lng + c2), lb = *(const f32x2*)(lnb + c2);
    unsigned zz[16];
#pragma unroll
    for (int t = 0; t < 16; ++t) zz[t] = __builtin_nontemporal_load((const unsigned*)(SZB + (size_t)(t0 + t) * 1024 + c2));
#pragma unroll
    for (int t = 0; t < 16; ++t) {
        const f32x2 st = *(const LAS f32x2*)(stats + t * 2);
        const float y0 = (outv[t][0] - st[0]) * st[1] * lg[0] + lb[0], y1 = (outv[t][1] - st[0]) * st[1] * lg[1] + lb[1];
        *(unsigned*)(SZB + (size_t)(t0 + t) * 1024 + c2) = pk_bf16(bf_lo(zz[t]) * siluf_(y0), bf_hi(zz[t]) * siluf_(y1));
    }
}
__device__ __forceinline__ void conv31_phase(LAS unsigned char* lds, const bf16_t* GLU, bf16_t* SZB, const float* cw, const float* cb, const float* lng, const float* lnb, int G, int c, const int widx) {
    int tid_ = tid_of(widx); asm volatile("" : "+v"(tid_));
    const int tid = tid_;
    LAS float* red = (LAS float*)(lds + 131072 + 1024);
    LAS float* stats = (LAS float*)(lds + 131072 + 3072);
    for (int run = c; run < NTOK / 128; run += G) {
        const int T0 = run * 128, tpos = T0 & (SEQ - 1);
        __syncthreads();
#pragma unroll
        for (int h = 0; h < 2; ++h) {
            int tf = tid; asm volatile("" : "+v"(tf));
            u32x4 tv[6];
#pragma unroll
            for (int q = 0; q < 6; ++q) { const int i = tf + (h * 6 + q) * 512, r = (i >> 7) < 46 ? (i >> 7) : 45; const int gr = (tpos - 30 + r >= 0) ? (T0 - 30 + r) : T0;
                tv[q] = *(const u32x4*)(GLU + (size_t)gr * 1024 + (i & 127) * 8); }
#pragma unroll
            for (int q = 0; q < 6; ++q) { const int i = tf + (h * 6 + q) * 512, r = i >> 7;
                if (r < 46) *(LAS u32x4*)(lds + ((34 + r) & 63) * 2048 + (i & 127) * 16) = (tpos - 30 + r >= 0) ? tv[q] : (u32x4){0u, 0u, 0u, 0u}; }
        }
        __syncthreads();
        conv31_chunk<0>(lds, red, stats, GLU, SZB, cw, cb, lng, lnb, T0, true, tid);
        conv31_chunk<1>(lds, red, stats, GLU, SZB, cw, cb, lng, lnb, T0 + 16, true, tid);
        conv31_chunk<2>(lds, red, stats, GLU, SZB, cw, cb, lng, lnb, T0 + 32, true, tid);
        conv31_chunk<3>(lds, red, stats, GLU, SZB, cw, cb, lng, lnb, T0 + 48, true, tid);
        conv31_chunk<0>(lds, red, stats, GLU, SZB, cw, cb, lng, lnb, T0 + 64, true, tid);
        conv31_chunk<1>(lds, red, stats, GLU, SZB, cw, cb, lng, lnb, T0 + 80, true, tid);
        conv31_chunk<2>(lds, red, stats, GLU, SZB, cw, cb, lng, lnb, T0 + 96, true, tid);
        conv31_chunk<3>(lds, red, stats, GLU, SZB, cw, cb, lng, lnb, T0 + 112, false, tid);
    }
    __syncthreads();
}

__global__ void __launch_bounds__(512, 2) fwd_megakernel(Params p) {
    extern __shared__ __attribute__((aligned(16))) unsigned char lds_raw[];
    LAS unsigned char* lds = (LAS unsigned char*)lds_raw;
    const int G = gridDim.x, bx = blockIdx.x;
    unsigned char* ws = p.ws; unsigned char* ob = (unsigned char*)p.out;
    const float *x = p.in[0], *mem = p.in[1], *norm_g = p.in[2], *w_in = p.in[3], *conv_a_w = p.in[4], *w_out_a = p.in[5], *conv_b_w = p.in[6], *conv_b_b = p.in[7],
                *ln_b_g = p.in[8], *ln_b_b = p.in[9], *w_out_b = p.in[10], *mem_norm_g = p.in[11], *w_kv = p.in[12], *w_out_x = p.in[13], *w_o = p.in[14], *final_g = p.in[15];
    bf16_t *WIN = (bf16_t*)(ws + WS_WIN), *WOUT = (bf16_t*)(ws + WS_WOUT), *WO = (bf16_t*)(ws + WS_WO), *WKV = (bf16_t*)(ws + WS_WKV), *MEMN = (bf16_t*)(ws + WS_MEMN),
           *KB = (bf16_t*)(ws + WS_KB), *VT = (bf16_t*)(ws + WS_VT), *PAT = (bf16_t*)(ws + WS_PAT), *GAH = (bf16_t*)(ws + WS_GAH), *HA = (bf16_t*)(ws + WS_HA), *SZB = (bf16_t*)(ws + WS_SZB),
           *SZX = (bf16_t*)(ws + WS_SZX), *GLU = (bf16_t*)(ws + WS_GLU), *Q = (bf16_t*)(ws + WS_Q), *SGA = (bf16_t*)(ws + WS_SGA), *SGB = (bf16_t*)(ws + WS_SGB),
           *U = (bf16_t*)(ob + OUT_U), *SGX = (bf16_t*)(ob + OUT_SGX);
    float *ROWSS = (float*)(ws + WS_ROWSS), *RSUM = (float*)(ws + WS_RSUM);
    bf16_t* MERGED = GLU;
    volatile LAS unsigned* xst = (volatile LAS unsigned*)(lds + 131072 + 512);
    const int widx = __builtin_amdgcn_readfirstlane((int)threadIdx.x >> 6);
    if (threadIdx.x < 4) xst[threadIdx.x] = 0u;
    __syncthreads();
    XcdBarrier xb = xcd_barrier_post((unsigned*)(ws + WS_BAR), xst, threadIdx.x == 0);

    {
        int tid_ = tid_of(widx); asm volatile("" : "+v"(tid_)); const int tid = tid_, lane = tid & 63, wave = tid >> 6;
        LAS float* scr = (LAS float*)(lds + wave * 16384);
        const int gw = bx * 8 + wave, NGW = G * 8;
        {
            const f32x4* gr = (const f32x4*)norm_g + lane; f32x4 gg[4];
#pragma unroll
            for (int j = 0; j < 4; ++j) gg[j] = gr[64 * j];
            for (int m = gw; m < NTOK; m += 4 * NGW) {
                f32x4 v[4][4];
#pragma unroll
                for (int r = 0; r < 4; ++r) { const f32x4* xr = (const f32x4*)(x + (size_t)(m + r * NGW) * 1024) + lane;
#pragma unroll
                    for (int j = 0; j < 4; ++j) v[r][j] = __builtin_nontemporal_load(xr + 64 * j); }
#pragma unroll
                for (int r = 0; r < 4; ++r) {
                    float sq = 0.f;
#pragma unroll
                    for (int j = 0; j < 4; ++j) sq += (v[r][j][0] * v[r][j][0] + v[r][j][1] * v[r][j][1]) + (v[r][j][2] * v[r][j][2] + v[r][j][3] * v[r][j][3]);
                    const float rstd = 1.0f / sqrtf(wave_sum(sq) * (1.f / 1024.f) + EPS);
                    u32x2* o8 = (u32x2*)(U + (size_t)(m + r * NGW) * 1024) + lane;
#pragma unroll
                    for (int j = 0; j < 4; ++j) o8[64 * j] = pk4(v[r][j] * rstd * gg[j]);
                }
            }
        }
        for (int it = gw; it < 9216; it += NGW) {
            int r = it;
            if (r < 6144) { const int g = r % 384; p0_transpose_item(w_in, 12288, WIN, (g >> 1) * 64 + (g & 1) * 16, (r / 384) * 64, true, scr, lane); continue; } r -= 6144;
            if (r < 512) { p0_transpose_item(w_out_a, 1024, WOUT, (r & 31) * 32, (r >> 5) * 64, false, scr, lane); continue; } r -= 512;
            if (r < 512) { p0_transpose_item(w_out_b, 1024, WOUT + (size_t)1024 * 1024, (r & 31) * 32, (r >> 5) * 64, false, scr, lane); continue; } r -= 512;
            if (r < 512) { p0_transpose_item(w_out_x, 1024, WOUT + (size_t)2048 * 1024, (r & 31) * 32, (r >> 5) * 64, false, scr, lane); continue; } r -= 512;
            if (r < 512) { p0_transpose_item(w_o, 1024, WO, (r & 31) * 32, (r >> 5) * 64, false, scr, lane); continue; } r -= 512;
            p0_transpose_item(w_kv, 2048, WKV, (r & 63) * 32, (r >> 6) * 64, false, scr, lane);
        }
        for (int m = gw; m < 1024; m += NGW) rms_row_to_bf16(mem + (size_t)m * 1024, mem_norm_g, MEMN + (size_t)m * 1024, lane);
        for (int i = bx * 512 + tid; i < NTOK * 5; i += G * 512) ROWSS[i] = 0.f;
    }
    GRID_SYNC();

    {
        SchedP1 S{(const char*)U, (const char*)WIN, (const char*)MEMN, (const char*)WKV, G, bx};
        EpiP1 E{HA, GLU, SZB, SZX, Q, SGA, SGB, SGX, KB, VT, PAT, GAH, conv_a_w};
        gemm_phase(lds, 1024, 1024, 1024, S, E, widx);
    }
    GRID_SYNC();

    {
        int tid_ = tid_of(widx); asm volatile("" : "+v"(tid_)); const int tid = tid_;
        for (int i = bx * 512 + tid; i < 512 * 256; i += G * 512) {
            const int blk = i >> 8, ch = (i & 255) * 4;
            if ((blk & 127) != 0) {
                const f32x4 w0 = *(const f32x4*)(conv_a_w + ch), w1 = *(const f32x4*)(conv_a_w + 1024 + ch);
                const f32x4 pt0 = unpk4(*(const u32x2*)(PAT + (size_t)((blk - 1) * 2 + 0) * 1024 + ch)), pt1 = unpk4(*(const u32x2*)(PAT + (size_t)((blk - 1) * 2 + 1) * 1024 + ch));
                const f32x4 g0 = unpk4(*(const u32x2*)(GAH + (size_t)(blk * 2 + 0) * 1024 + ch)), g1 = unpk4(*(const u32x2*)(GAH + (size_t)(blk * 2 + 1) * 1024 + ch));
                u32x2* h0 = (u32x2*)(HA + (size_t)(blk * 64) * 1024 + ch); u32x2* h1 = (u32x2*)(HA + (size_t)(blk * 64 + 1) * 1024 + ch);
                *h0 = pk4(unpk4(*h0) + g0 * (w1 * pt1 + w0 * pt0));
                *h1 = pk4(unpk4(*h1) + g1 * (w0 * pt1));
            }
        }
        { SchedAttn S{(const char*)Q, (const char*)KB, TILE, (size_t)512, G, bx}; EpiS E{Q, RSUM}; gemm_phase(lds, 1024, 1024, 256, S, E, widx); }
        conv31_phase(lds, GLU, SZB, conv_b_w, conv_b_b, ln_b_g, ln_b_b, G, bx, widx);
    }
    asm volatile("s_waitcnt vmcnt(0) lgkmcnt(0)" ::: "memory"); __syncthreads();
    __builtin_amdgcn_fence(__ATOMIC_ACQUIRE, "agent"); asm volatile("s_waitcnt vmcnt(0)" ::: "memory"); __syncthreads();

    { SchedAttn S{(const char*)Q, (const char*)VT, (size_t)1024 * 256 * 2, (size_t)256 * 256 * 2, G, bx}; EpiPV E{SZX, U  , RSUM}; gemm_phase(lds, 1024, 256, 256, S, E, widx); }
    GRID_SYNC();

    { SchedOut S{(const char*)HA, (const char*)U, (const char*)WOUT, G, bx}; EpiOut E{SGA, SGB, SGX, MERGED}; gemm_phase(lds, 1024, 1024, 1024, S, E, widx); }
    GRID_SYNC();

    { SchedWo S{(const char*)MERGED, (const char*)WO, G, bx}; EpiWo E{x, HA  , ROWSS}; gemm_phase(lds, 1024, 1024, 1024, S, E, widx); }
    GRID_SYNC();

    {
        int tid_ = tid_of(widx); asm volatile("" : "+v"(tid_)); const int lane = tid_ & 63, w4 = tid_ >> 6, wr = w4 >> 2, wc = w4 & 3, fr = lane & 15, fq = lane >> 4;
        for (int L = bx; L < 512; L += G) {
            int pm, pn; remap_tile(L, 128, 4, pm, pn);
#pragma unroll
            for (int ai = 0; ai < 2; ++ai) {
                u32x2 hv[4][2][2]; float rs[4]; f32x4 gg[2][2];
#pragma unroll
                for (int m = 0; m < 4; ++m) {
                    rs[m] = ROWSS[pm * 256 + ai * 128 + wr * 64 + m * 16 + fr];
#pragma unroll
                    for (int bj = 0; bj < 2; ++bj)
#pragma unroll
                        for (int n = 0; n < 2; ++n) hv[m][bj][n] = ((const u32x2*)HA)[native_slot(pm, pn, w4, ai, m, bj, n, fq * 16 + fr)];
                }
#pragma unroll
                for (int bj = 0; bj < 2; ++bj)
#pragma unroll
                    for (int n = 0; n < 2; ++n) gg[bj][n] = *(const f32x4*)(final_g + pn * 256 + bj * 128 + wc * 32 + n * 16 + fq * 4);
#pragma unroll
                for (int m = 0; m < 4; ++m) {
                    const float rstd = 1.0f / sqrtf(rs[m] * (1.f / 1024.f) + EPS);
#pragma unroll
                    for (int bj = 0; bj < 2; ++bj)
#pragma unroll
                        for (int n = 0; n < 2; ++n)
                            *(f32x4*)(p.out + (size_t)(pm * 256 + ai * 128 + wr * 64 + m * 16 + fr) * 1024 + pn * 256 + bj * 128 + wc * 32 + n * 16 + fq * 4) = unpk4(hv[m][bj][n]) * rstd * gg[bj][n];
                }
            }
        }
    }
}

extern "C" void kernel_launch(void* const* d_in, const int* in_sizes, int n_in, void* d_out, int out_size, void* d_ws, size_t ws_size, hipStream_t stream) {
    static int grid_blocks = 0;
    if (!grid_blocks) {
        int dev = 0, cus = 0, per_cu = 0;
        hipGetDevice(&dev);
        hipDeviceGetAttribute(&cus, hipDeviceAttributeMultiprocessorCount, dev);
        hipFuncSetAttribute((const void*)fwd_megakernel, hipFuncAttributeMaxDynamicSharedMemorySize, LDS_BYTES);
        hipOccupancyMaxActiveBlocksPerMultiprocessor(&per_cu, (const void*)fwd_megakernel, 512, LDS_BYTES);
        if (per_cu < 1) { fprintf(stderr, "kernel_launch: occupancy query reports %d blocks per CU\n", per_cu); per_cu = 1; }
        if (per_cu > 1) per_cu = 1;
        grid_blocks = cus * per_cu;
        if (ws_size < WS_END) fprintf(stderr, "kernel_launch: workspace too small: %zu < %zu\n", ws_size, (size_t)WS_END);
    }
    (void)hipMemsetAsync((char*)d_ws + WS_BAR, 0, XCD_BAR_WORDS * 4, stream);
    if (ws_size < WS_END) return;
    Params p{};
    for (int i = 0; i < 16; ++i) p.in[i] = (const float*)d_in[i];
    p.out = (float*)d_out; p.ws = (unsigned char*)d_ws;
    void* args[] = {&p};
    hipError_t e = hipLaunchCooperativeKernel((const void*)fwd_megakernel, dim3(grid_blocks), dim3(512), args, LDS_BYTES, stream);
    if (e != hipSuccess) fprintf(stderr, "cooperative launch failed: %s (grid %d)\n", hipGetErrorString(e), grid_blocks);
}
```
